# Optimizing an MI355X kernel written in HIP

```python
import math
import jax, jax.numpy as jnp
from jax import lax
import numpy as np

D_MODEL = 2048
BATCH = 32
SEQ = 256
DEPTH = 4
DEC_BATCH = 8
DEC_SEQ = 1024
PAST_LEN = 512

GRID_W = 64
N_MIXERS = 3
N_HYENA = (DEPTH + 2) // 3
N_ATTN = (DEPTH + 1) // 3
N_SSM = DEPTH // 3
D_FF = 4 * D_MODEL
N_MOD = 6
NORM_EPS = 1e-6
HY_PE_BANDS = 16
HY_PE_DIM = 2 * HY_PE_BANDS
HY_PE_MIN_PERIOD = 2.0
HY_PE_MAX_PERIOD = 4096.0
HY_FILTER_W = 64
HY_SHORT = 3
N_HEADS = 8
HEAD_DIM = D_MODEL // N_HEADS // 2
V_DIM = 2 * HEAD_DIM
ROPE_BASE = 10000.0
Q_BLOCK = 128
S5_GROUP = 16
S5_GROUPS = D_MODEL // S5_GROUP
S5_STATE = 64

kernel_name = 'hybrid_diffusion_prefix_step'

F32 = jnp.float32


def rms_norm(x, g):
    xf = x.astype(F32)
    y = xf * lax.rsqrt(jnp.mean(xf * xf, axis=-1, keepdims=True) + NORM_EPS)
    return (y * g.astype(F32)).astype(x.dtype)


def adaln_params(cond, w, b):
    m = (jax.nn.silu(cond) @ w + b).reshape(cond.shape[0], N_MOD, D_MODEL)
    return [m[:, j, None, :] for j in range(N_MOD)]


def pre_mod(x, g, shift, scale):
    return rms_norm(x, g) * (1 + scale) + shift


def post_add(x, o, g, gate):
    return x + gate * rms_norm(o, g)


def sq_relu_mlp(h, w1, w2):
    return jnp.square(jax.nn.relu(h @ w1)) @ w2


def short_conv(x, w, b):
    xp = jnp.pad(x, ((0, 0), (1, 1), (0, 0)))
    return xp[:, :-2] * w[0] + xp[:, 1:-1] * w[1] + xp[:, 2:] * w[2] + b


def hyena_filter(L, w1, b1, fr1, w2, b2, fr2, w3, log_alpha):
    t = jnp.arange(L, dtype=F32)
    periods = HY_PE_MIN_PERIOD * (HY_PE_MAX_PERIOD / HY_PE_MIN_PERIOD) ** (
        jnp.arange(HY_PE_BANDS, dtype=F32) / (HY_PE_BANDS - 1))
    ang = t[:, None] * (2.0 * math.pi / periods)[None]
    pe = jnp.concatenate([jnp.sin(ang), jnp.cos(ang)], axis=-1)
    h = jnp.sin(fr1.astype(F32) * (pe @ w1.astype(F32) + b1.astype(F32)))
    h = jnp.sin(fr2.astype(F32) * (h @ w2.astype(F32) + b2.astype(F32)))
    h = (h @ w3.astype(F32)).reshape(L, 2, D_MODEL)
    h = h * jnp.exp(-jnp.exp(log_alpha.astype(F32))[None, None] * t[:, None, None])
    k = jnp.concatenate([h[:, 0], jnp.zeros((1, D_MODEL), F32), h[:0:-1, 1]], axis=0)
    return k / (jnp.sum(jnp.abs(k), axis=0, keepdims=True) + 1e-6)


def long_conv(u, k):
    L = u.shape[1]
    U = jnp.fft.rfft(u.astype(F32), n=2 * L, axis=1)
    K = jnp.fft.rfft(k, axis=0)
    return jnp.fft.irfft(U * K[None], n=2 * L, axis=1)[:, :L]


def hyena_mixer(h, w_in, b_in, w_sh, b_sh, filt, skip, w_out, b_out):
    L = h.shape[1]
    z = short_conv(h @ w_in + b_in, w_sh, b_sh)
    x0, x1, v = jnp.split(z, 3, axis=-1)
    v = v * x1
    y = long_conv(v, hyena_filter(L, *filt)).astype(h.dtype) + v * skip
    return (x0 * y) @ w_out + b_out


def axial_rope(L):
    rows = L // GRID_W
    row = jnp.repeat(jnp.arange(rows), GRID_W).astype(F32)
    col = jnp.tile(jnp.arange(GRID_W), rows).astype(F32)
    half = HEAD_DIM // 2
    inv = ROPE_BASE ** (-jnp.arange(0, half, 2, dtype=F32) / half)
    ar = row[:, None] * inv
    ac = col[:, None] * inv
    ang = jnp.concatenate([ar, ar, ac, ac], axis=-1)
    return jnp.cos(ang), jnp.sin(ang)


def rotate_half_axial(x):
    a, b, c, d = jnp.split(x, 4, axis=-1)
    return jnp.concatenate([-b, a, -d, c], axis=-1)


def apply_rope(x, cos, sin):
    cos = cos[None, :, None, None]
    sin = sin[None, :, None, None]
    xf = x.astype(F32)
    return (xf * cos + rotate_half_axial(xf) * sin).astype(x.dtype)


def diff_qkv(h, w_qkv):
    B, L, _ = h.shape
    q, k, v = jnp.split(h @ w_qkv, 3, axis=-1)
    return (q.reshape(B, L, N_HEADS, 2, HEAD_DIM), k.reshape(B, L, N_HEADS, 2, HEAD_DIM),
            v.reshape(B, L, N_HEADS, V_DIM))


def diff_lambda(lam_p, lam_init):
    lp = lam_p.astype(F32)
    return jnp.exp(jnp.sum(lp[0] * lp[1])) - jnp.exp(jnp.sum(lp[2] * lp[3])) + lam_init


def diff_attend(q, k, v, lam):
    B, S = q.shape[:2]
    nb = S // Q_BLOCK
    qb = jnp.moveaxis(q.reshape(B, nb, Q_BLOCK, N_HEADS, 2, HEAD_DIM), 1, 0)
    kf = k.astype(F32)
    vf = v.astype(F32)
    scale = HEAD_DIM ** -0.5

    def block(qblk):
        s = jnp.einsum('bqhcd,bkhcd->bhcqk', qblk.astype(F32), kf) * scale
        p = jax.nn.softmax(s, axis=-1)
        w = p[:, :, 0] - lam * p[:, :, 1]
        return jnp.einsum('bhqk,bkhe->bqhe', w, vf)

    o = lax.map(block, qb)
    return jnp.moveaxis(o, 0, 1).reshape(B, S, N_HEADS, V_DIM)


def diff_output(o, g_sub, lam_init, w_o, dtype):
    B, S = o.shape[:2]
    o = rms_norm(o, g_sub) * (1.0 - lam_init)
    return o.reshape(B, S, D_MODEL).astype(dtype) @ w_o


def _lin_combine(e1, e2):
    a1, b1 = e1
    a2, b2 = e2
    return a1 * a2, a2 * b1 + b2


def s5_discretize(lam_re, lam_im, log_dt, b_re, b_im):
    lam = lax.complex(jnp.minimum(lam_re.astype(F32), -1e-4), lam_im.astype(F32))
    lam_dt = lam * jnp.exp(log_dt.astype(F32))[:, None]
    lam_bar = jnp.exp(lam_dt)
    b = lax.complex(b_re.astype(F32), b_im.astype(F32))
    b_bar = ((lam_bar - 1.0) / lam)[..., None] * b
    return lam_dt, lam_bar, b_bar


def s5_scan(u, lam_dt, lam_bar, b_bar, s0, reverse):
    L = u.shape[1]
    bu = jnp.einsum('blgh,gph->blgp', u.astype(jnp.complex64), b_bar)
    if reverse:
        bu = jnp.flip(bu, axis=1)
    a = jnp.broadcast_to(lam_bar, (1, L) + lam_bar.shape)
    _, xs = lax.associative_scan(_lin_combine, (a, bu), axis=1)
    steps = jnp.arange(1, L + 1, dtype=F32)
    xs = xs + jnp.exp(lam_dt[None] * steps[:, None, None])[None] * s0[:, None]
    final = xs[:, -1]
    if reverse:
        xs = jnp.flip(xs, axis=1)
    return xs, final


def s5_mixer(h, s0, lam_re, lam_im, log_dt, b_re, b_im, c_re, c_im, d_skip, w_glu, b_glu):
    B, L, _ = h.shape
    u = h.astype(F32).reshape(B, L, S5_GROUPS, S5_GROUP)
    y = d_skip.astype(F32).reshape(S5_GROUPS, S5_GROUP) * u
    finals = []
    for di in range(2):
        lam_dt, lam_bar, b_bar = s5_discretize(lam_re[di], lam_im[di], log_dt[di], b_re[di], b_im[di])
        xs, fin = s5_scan(u, lam_dt, lam_bar, b_bar, s0[:, di], di == 1)
        cm = lax.complex(c_re[di].astype(F32), c_im[di].astype(F32))
        y = y + jnp.einsum('blgp,ghp->blgh', xs, cm).real
        finals.append(fin)
    y = jax.nn.gelu(y.reshape(B, L, D_MODEL)).astype(h.dtype)
    a, g = jnp.split(y @ w_glu + b_glu, 2, axis=-1)
    return a * jax.nn.sigmoid(g), jnp.stack(finals, axis=1)


def setup_inputs(seed: int = 0) -> dict:
    key = jax.random.key(seed)
    ks = iter(jax.random.split(key, 64))

    def nrm(shape, s=1.0):
        return s * jax.random.normal(next(ks), shape, F32)

    D = D_MODEL
    G, P, H = S5_GROUPS, S5_STATE, S5_GROUP
    n = jnp.arange(P, dtype=F32)
    lengths = jnp.geomspace(8.0, 1024.0, D)
    return {
        'x_prompt': nrm((BATCH, SEQ, D)),
        'x_sample': nrm((DEC_BATCH, DEC_SEQ, D)),
        'cache_attn_k': nrm((DEC_BATCH, N_ATTN, PAST_LEN, N_HEADS, 2, HEAD_DIM)),
        'cache_attn_v': nrm((DEC_BATCH, N_ATTN, PAST_LEN, N_HEADS, V_DIM)),
        'state_s5_re': nrm((DEC_BATCH, N_SSM, 2, G, P), 0.1),
        'state_s5_im': nrm((DEC_BATCH, N_SSM, 2, G, P), 0.1),
        'c': nrm((DEC_BATCH, D)),
        'c_ctx': nrm((D,)),
        'w_mod': nrm((DEPTH, D, N_MOD * D), 0.5 * D ** -0.5),
        'b_mod': nrm((DEPTH, N_MOD * D), 0.02),
        'g_norm': 1.0 + nrm((DEPTH, 4, D), 0.02),
        'w_mlp_in': nrm((DEPTH, D, D_FF), D ** -0.5),
        'w_mlp_out': nrm((DEPTH, D_FF, D), D_FF ** -0.5),
        'hy_w_in': nrm((N_HYENA, D, 3 * D), D ** -0.5),
        'hy_b_in': nrm((N_HYENA, 3 * D), 0.02),
        'hy_w_short': nrm((N_HYENA, HY_SHORT, 3 * D), HY_SHORT ** -0.5),
        'hy_b_short': nrm((N_HYENA, 3 * D), 0.02),
        'hy_f_w1': nrm((N_HYENA, HY_PE_DIM, HY_FILTER_W), HY_PE_DIM ** -0.5),
        'hy_f_b1': nrm((N_HYENA, HY_FILTER_W), 0.1),
        'hy_f_freq1': 1.0 + nrm((N_HYENA, HY_FILTER_W), 0.1),
        'hy_f_w2': nrm((N_HYENA, HY_FILTER_W, HY_FILTER_W), HY_FILTER_W ** -0.5),
        'hy_f_b2': nrm((N_HYENA, HY_FILTER_W), 0.1),
        'hy_f_freq2': 1.0 + nrm((N_HYENA, HY_FILTER_W), 0.1),
        'hy_f_w3': nrm((N_HYENA, HY_FILTER_W, 2 * D), HY_FILTER_W ** -0.5),
        'hy_log_alpha': jnp.log(math.log(100.0) / lengths)[None] + nrm((N_HYENA, D), 0.01),
        'hy_skip': nrm((N_HYENA, D)),
        'hy_w_out': nrm((N_HYENA, D, D), D ** -0.5),
        'hy_b_out': nrm((N_HYENA, D), 0.02),
        'at_w_qkv': nrm((N_ATTN, D, 3 * D), D ** -0.5),
        'at_lam': nrm((N_ATTN, 4, HEAD_DIM), 0.1),
        'at_g_sub': 1.0 + nrm((N_ATTN, V_DIM), 0.02),
        'at_w_o': nrm((N_ATTN, D, D), D ** -0.5),
        's5_lam_re': -0.5 + nrm((N_SSM, 2, G, P), 0.01),
        's5_lam_im': math.pi * n + nrm((N_SSM, 2, G, P), 0.01),
        's5_log_dt': jax.random.uniform(next(ks), (N_SSM, 2, G), F32, math.log(1e-3), math.log(1e-1)),
        's5_b_re': nrm((N_SSM, 2, G, P, H), (2 * H) ** -0.5),
        's5_b_im': nrm((N_SSM, 2, G, P, H), (2 * H) ** -0.5),
        's5_c_re': nrm((N_SSM, 2, G, H, P), P ** -0.5),
        's5_c_im': nrm((N_SSM, 2, G, H, P), P ** -0.5),
        's5_d': nrm((N_SSM, D)),
        's5_w_glu': nrm((N_SSM, D, 2 * D), D ** -0.5),
        's5_b_glu': nrm((N_SSM, 2 * D), 0.02),
    }


def reference(x_prompt, x_sample, cache_attn_k, cache_attn_v, state_s5_re, state_s5_im, c, c_ctx,
              w_mod, b_mod, g_norm, w_mlp_in, w_mlp_out,
              hy_w_in, hy_b_in, hy_w_short, hy_b_short, hy_f_w1, hy_f_b1, hy_f_freq1,
              hy_f_w2, hy_f_b2, hy_f_freq2, hy_f_w3, hy_log_alpha, hy_skip, hy_w_out, hy_b_out,
              at_w_qkv, at_lam, at_g_sub, at_w_o,
              s5_lam_re, s5_lam_im, s5_log_dt, s5_b_re, s5_b_im, s5_c_re, s5_c_im, s5_d,
              s5_w_glu, s5_b_glu):
    xc, xl = x_prompt, x_sample
    cos, sin = axial_rope(x_sample.shape[1])
    new_k, new_v, new_s = [], [], []
    for i in range(DEPTH):
        kind, j = i % N_MIXERS, i // N_MIXERS
        mc = adaln_params(c_ctx[None], w_mod[i], b_mod[i])
        ml = adaln_params(c, w_mod[i], b_mod[i])
        g = g_norm[i]
        hc = pre_mod(xc, g[0], mc[0], mc[1])
        hl = pre_mod(xl, g[0], ml[0], ml[1])
        if kind == 0:
            filt = (hy_f_w1[j], hy_f_b1[j], hy_f_freq1[j], hy_f_w2[j], hy_f_b2[j], hy_f_freq2[j],
                    hy_f_w3[j], hy_log_alpha[j])
            hp = (hy_w_in[j], hy_b_in[j], hy_w_short[j], hy_b_short[j], filt, hy_skip[j],
                  hy_w_out[j], hy_b_out[j])
            oc = hyena_mixer(hc, *hp)
            ol = hyena_mixer(hl, *hp)
        elif kind == 1:
            lam_init = 0.8 - 0.6 * math.exp(-0.3 * i)
            lam = diff_lambda(at_lam[j], lam_init)
            qc, kc, vc = diff_qkv(hc, at_w_qkv[j])
            new_k.append(kc)
            new_v.append(vc)
            oc = diff_output(diff_attend(qc, kc, vc, lam), at_g_sub[j], lam_init, at_w_o[j], xc.dtype)
            ql, kl, vl = diff_qkv(hl, at_w_qkv[j])
            ql = apply_rope(ql, cos, sin)
            kl = apply_rope(kl, cos, sin)
            k_all = jnp.concatenate([cache_attn_k[:, j].astype(kl.dtype), kl], axis=1)
            v_all = jnp.concatenate([cache_attn_v[:, j].astype(vl.dtype), vl], axis=1)
            ol = diff_output(diff_attend(ql, k_all, v_all, lam), at_g_sub[j], lam_init, at_w_o[j], xl.dtype)
        else:
            sp = (s5_lam_re[j], s5_lam_im[j], s5_log_dt[j], s5_b_re[j], s5_b_im[j], s5_c_re[j],
                  s5_c_im[j], s5_d[j], s5_w_glu[j], s5_b_glu[j])
            s0c = jnp.zeros((xc.shape[0], 2, S5_GROUPS, S5_STATE), jnp.complex64)
            oc, fin = s5_mixer(hc, s0c, *sp)
            new_s.append(fin)
            s0l = lax.complex(state_s5_re[:, j].astype(F32), state_s5_im[:, j].astype(F32))
            ol, _ = s5_mixer(hl, s0l, *sp)
        xc = post_add(xc, oc, g[1], mc[2])
        xl = post_add(xl, ol, g[1], ml[2])
        xc = post_add(xc, sq_relu_mlp(pre_mod(xc, g[2], mc[3], mc[4]), w_mlp_in[i], w_mlp_out[i]), g[3], mc[5])
        xl = post_add(xl, sq_relu_mlp(pre_mod(xl, g[2], ml[3], ml[4]), w_mlp_in[i], w_mlp_out[i]), g[3], ml[5])
    new_cache_attn_k = jnp.stack(new_k, axis=1)
    new_cache_attn_v = jnp.stack(new_v, axis=1)
    s_all = jnp.stack(new_s, axis=1)
    return (xc, xl, new_cache_attn_k, new_cache_attn_v, s_all.real, s_all.imag)
```

```cpp
#ifdef HOST_EMU
#include <cstdio>
#include <cstdlib>
#include <cstring>
#include <cmath>
#include <vector>
#define HD
#else
#include <hip/hip_runtime.h>
#include <cstdio>
#define HD __host__ __device__ __forceinline__
#endif

typedef unsigned short bf16;

#ifdef SMALL_CFG
constexpr int D = 256, BATCH = 2, SEQ = 128, DEC_BATCH = 2, DEC_SEQ = 128, PAST = 64;
#else
constexpr int D = 2048, BATCH = 32, SEQ = 256, DEC_BATCH = 8, DEC_SEQ = 1024, PAST = 512;
#endif
constexpr int DEPTH = 4, NHY = 2, NAT = 1, NSS = 1, DFF = 4 * D, GRID_W = 64;
constexpr int NH = 8, HDIM = D / NH / 2, VD = 2 * HDIM, QD = HDIM / 4;
constexpr int SG = 16, SGS = D / SG, SP = 64;
constexpr int MC = BATCH * SEQ, ML = DEC_BATCH * DEC_SEQ, M = MC + ML, NCND = 1 + DEC_BATCH;
constexpr int LMAX = DEC_SEQ > SEQ ? DEC_SEQ : SEQ;
constexpr int FW = 64, PEB = 16;
constexpr int TMAX = PAST + DEC_SEQ;
constexpr float NORM_EPS = 1e-6f;
constexpr int ATT_LAYER = 1;

struct P {
    const float *x_prompt, *x_sample, *cache_k, *cache_v, *st_re, *st_im, *c, *c_ctx, *w_mod, *b_mod, *g_norm, *w_mlp_in, *w_mlp_out,
        *hy_w_in, *hy_b_in, *hy_w_short, *hy_b_short, *hy_f_w1, *hy_f_b1, *hy_f_freq1, *hy_f_w2, *hy_f_b2, *hy_f_freq2, *hy_f_w3, *hy_log_alpha, *hy_skip, *hy_w_out, *hy_b_out,
        *at_w_qkv, *at_lam, *at_g_sub, *at_w_o, *s5_lam_re, *s5_lam_im, *s5_log_dt, *s5_b_re, *s5_b_im, *s5_c_re, *s5_c_im, *s5_d, *s5_w_glu, *s5_b_glu;
    float* out;
    float *X, *MOD, *SCOND, *O, *HRAW, *H1, *H2, *KINV, *X0C, *VV, *YF, *YB;
    bf16 *H, *Z, *HID, *Wt_mlp_in, *Wt_mlp_out, *Wt_hy_in, *Wt_hy_out, *Wt_qkv, *Wt_wo, *Wt_glu;
};
constexpr size_t OUT_YC = 0, OUT_YL = (size_t)MC * D, OUT_K = (size_t)M * D, OUT_V = OUT_K + (size_t)MC * D, OUT_SRE = OUT_V + (size_t)MC * D, OUT_SIM = OUT_SRE + (size_t)BATCH * NSS * 2 * SGS * SP,
                 OUT_END = OUT_SIM + (size_t)BATCH * NSS * 2 * SGS * SP;

HD float bf2f(bf16 b) { unsigned u = ((unsigned)b) << 16; float f; __builtin_memcpy(&f, &u, 4); return f; }
HD bf16 f2bf(float f) { unsigned u; __builtin_memcpy(&u, &f, 4); u += 0x7fffu + ((u >> 16) & 1u); return (bf16)(u >> 16); }
HD float rsq(float x) { return 1.0f / sqrtf(x); }
HD float silu_f(float v) { return v / (1.0f + expf(-v)); }
HD float gelu_tanh_f(float x) { return 0.5f * x * (1.0f + tanhf(0.7978845608028654f * (x + 0.044715f * x * x * x))); }
HD void row_info(int row, int& seq0, int& t, int& L, int& cls, int& b) {
    if (row < MC) { b = row / SEQ; t = row % SEQ; L = SEQ; cls = 0; } else { const int r = row - MC; b = r / DEC_SEQ; t = r % DEC_SEQ; L = DEC_SEQ; cls = 1; }
    seq0 = row - t;
}

#ifdef HOST_EMU
#define WAVE_FOR for (int lane = 0; lane < 64; ++lane)
#define LI lane
#define NL 64
#define WAVE_SYNC() do { } while (0)
static inline void wsum_h(float* v) { float s = 0.f; for (int l = 0; l < 64; ++l) s += v[l]; for (int l = 0; l < 64; ++l) v[l] = s; }
static inline void wmax_h(float* v) { float s = v[0]; for (int l = 1; l < 64; ++l) s = v[l] > s ? v[l] : s; for (int l = 0; l < 64; ++l) v[l] = s; }
#define wsum(a) wsum_h(a)
#define wmax(a) wmax_h(a)
#else
#define WAVE_FOR for (int lane = (int)(threadIdx.x & 63), _once = 1; _once; _once = 0)
#define LI 0
#define NL 1
#define WAVE_SYNC() do { asm volatile("s_waitcnt vmcnt(0) lgkmcnt(0)" ::: "memory"); __builtin_amdgcn_wave_barrier(); } while (0)
__device__ __forceinline__ float wsum_d(float s) {
#pragma unroll
    for (int o = 1; o < 64; o <<= 1) s += __shfl_xor(s, o);
    return s; }
__device__ __forceinline__ float wmax_d(float s) {
#pragma unroll
    for (int o = 1; o < 64; o <<= 1) { const float t = __shfl_xor(s, o); s = t > s ? t : s; }
    return s; }
#define wsum(a) ((a)[0] = wsum_d((a)[0]))
#define wmax(a) ((a)[0] = wmax_d((a)[0]))
#endif

struct E_copyx { static HD void run(const P& p, int, int, size_t i) { p.X[i] = i < (size_t)MC * D ? p.x_prompt[i] : p.x_sample[i - (size_t)MC * D]; } };
struct E_scond { static HD void run(const P& p, int, int, size_t i) { const int r = (int)(i / D), k = (int)(i % D); const float v = r == 0 ? p.c_ctx[k] : p.c[(size_t)(r - 1) * D + k]; p.SCOND[i] = silu_f(v); } };
struct E_mod { static HD void run(const P& p, int, int, size_t i) {
    const int n = (int)(i % (6 * D)), r = (int)((i / (6 * D)) % NCND), l = (int)(i / ((size_t)6 * D * NCND));
    const float* w = p.w_mod + (size_t)l * D * 6 * D + n; const float* s = p.SCOND + (size_t)r * D;
    float acc = 0.f; for (int k = 0; k < D; ++k) acc += s[k] * w[(size_t)k * 6 * D];
    p.MOD[i] = acc + p.b_mod[(size_t)l * 6 * D + n]; } };
struct E_relu2 { static HD void run(const P& p, int, int, size_t i) { float v = bf2f(p.HID[i]); v = v > 0.f ? v : 0.f; p.HID[i] = f2bf(v * v); } };

struct E_filt1 { static HD void run(const P& p, int, int, size_t i) {
    const int w = (int)(i % FW), t = (int)((i / FW) % LMAX), j = (int)(i / ((size_t)FW * LMAX));
    float acc = p.hy_f_b1[j * FW + w];
    for (int k = 0; k < 2 * PEB; ++k) { const int band = k % PEB; const float per = 2.0f * powf(2048.0f, (float)band / (float)(PEB - 1)); const float ang = (float)t * (6.283185307179586f / per);
        const float pe = k < PEB ? sinf(ang) : cosf(ang); acc += pe * p.hy_f_w1[((size_t)j * 2 * PEB + k) * FW + w]; }
    p.H1[i] = sinf(p.hy_f_freq1[j * FW + w] * acc); } };
struct E_filt2 { static HD void run(const P& p, int, int, size_t i) {
    const int w = (int)(i % FW), t = (int)((i / FW) % LMAX), j = (int)(i / ((size_t)FW * LMAX));
    float acc = p.hy_f_b2[j * FW + w]; const float* h1 = p.H1 + ((size_t)j * LMAX + t) * FW;
    for (int v = 0; v < FW; ++v) acc += h1[v] * p.hy_f_w2[((size_t)j * FW + v) * FW + w];
    p.H2[i] = sinf(p.hy_f_freq2[j * FW + w] * acc); } };
struct E_filt3 { static HD void run(const P& p, int, int, size_t i) {
    const int col = (int)(i % (2 * D)), t = (int)((i / (2 * D)) % LMAX), j = (int)(i / ((size_t)2 * D * LMAX)), d = col % D;
    const float* h2 = p.H2 + ((size_t)j * LMAX + t) * FW; float acc = 0.f;
    for (int w = 0; w < FW; ++w) acc += h2[w] * p.hy_f_w3[((size_t)j * FW + w) * 2 * D + col];
    p.HRAW[i] = acc * expf(-expf(p.hy_log_alpha[j * D + d]) * (float)t); } };
struct E_filtnorm { static HD void run(const P& p, int, int, size_t i) {
    const int d = (int)(i % D), cls = (int)((i / D) % 2), j = (int)(i / (2 * D)), L = cls ? DEC_SEQ : SEQ;
    const float* h = p.HRAW + (size_t)j * LMAX * 2 * D; float s = 0.f;
    for (int t = 0; t < L; ++t) { s += fabsf(h[(size_t)t * 2 * D + d]); if (t >= 1) s += fabsf(h[(size_t)t * 2 * D + D + d]); }
    p.KINV[i] = 1.0f / (s + 1e-6f); } };
struct E_hconv1 { static HD void run(const P& p, int j, int, size_t i) {
    const int row = (int)(i / D), c = (int)(i % D); int seq0, t, L, cls, b; row_info(row, seq0, t, L, cls, b);
    float zc[3];
    for (int blk = 0; blk < 3; ++blk) { const int col = blk * D + c; const float* ws = p.hy_w_short + (size_t)j * 3 * 3 * D;
        const float zp = t > 0 ? bf2f(p.Z[(size_t)(row - 1) * 3 * D + col]) : 0.f, z0 = bf2f(p.Z[(size_t)row * 3 * D + col]), zn = t < L - 1 ? bf2f(p.Z[(size_t)(row + 1) * 3 * D + col]) : 0.f;
        zc[blk] = zp * ws[col] + z0 * ws[3 * D + col] + zn * ws[2 * 3 * D + col] + p.hy_b_short[(size_t)j * 3 * D + col]; }
    p.X0C[i] = zc[0]; p.VV[i] = zc[2] * zc[1]; } };
struct E_hconv2 { static HD void run(const P& p, int j, int, size_t i) {
    const int row = (int)(i / D), c = (int)(i % D); int seq0, t, L, cls, b; row_info(row, seq0, t, L, cls, b);
    const float* h = p.HRAW + (size_t)j * LMAX * 2 * D; float y = 0.f;
    for (int s = 0; s < L; ++s) { const int jj = t - s; const float k = jj >= 0 ? h[(size_t)jj * 2 * D + c] : h[(size_t)(-jj) * 2 * D + D + c]; y += k * p.VV[(size_t)(seq0 + s) * D + c]; }
    y *= p.KINV[((size_t)j * 2 + cls) * D + c]; y += p.VV[i] * p.hy_skip[j * D + c];
    p.H[i] = f2bf(p.X0C[i] * y); } };

struct E_newkv { static HD void run(const P& p, int, int, size_t i) { const int row = (int)(i / D), c = (int)(i % D);
    p.out[OUT_K + i] = bf2f(p.Z[(size_t)row * 3 * D + D + c]); p.out[OUT_V + i] = bf2f(p.Z[(size_t)row * 3 * D + 2 * D + c]); } };
struct E_rope { static HD void run(const P& p, int, int, size_t i) {
    size_t r = i; const int e = (int)(r % (2 * QD)); r /= 2 * QD; const int comp = (int)(r % 2); r /= 2; const int h = (int)(r % NH); r /= NH; const int which = (int)(r % 2); r /= 2; const int lrow = (int)r;
    const int grp = e / QD, ii = e % QD, t = lrow % DEC_SEQ, gr = t / GRID_W, gc = t % GRID_W;
    const float inv = powf(10000.0f, -(float)(2 * ii) / (float)(HDIM / 2)), ang = (float)(grp == 0 ? gr : gc) * inv, cs = cosf(ang), sn = sinf(ang);
    bf16* z = p.Z + (size_t)(MC + lrow) * 3 * D + which * D + h * 2 * HDIM + comp * HDIM + grp * 2 * QD + ii;
    const float a = bf2f(z[0]), bb = bf2f(z[QD]); z[0] = f2bf(a * cs - bb * sn); z[QD] = f2bf(bb * cs + a * sn); } };
struct E_s5comb { static HD void run(const P& p, int, int, size_t i) { const int c = (int)(i % D); const float u = bf2f(p.H[i]); p.H[i] = f2bf(gelu_tanh_f(p.s5_d[c] * u + p.YF[i] + p.YB[i])); } };
struct E_glu { static HD void run(const P& p, int, int, size_t i) { const int row = (int)(i / D), c = (int)(i % D); const float a = bf2f(p.Z[(size_t)row * 2 * D + c]), g = bf2f(p.Z[(size_t)row * 2 * D + D + c]);
    p.O[i] = a / (1.0f + expf(-g)); } };

struct W_thin { static constexpr int NITEMS = M; static HD void run(const P& p, int a0, int a1, int row, float*  ) {
    const int midx = row < MC ? 0 : 1 + (row - MC) / DEC_SEQ; const bool fin = a1 < 0; float* xout = fin ? p.out : p.X;
    float ss[NL];
    if (a0 >= 0) { const int l = a0 >> 3, wh = a0 & 7; const float* g = p.g_norm + ((size_t)l * 4 + (wh ? 3 : 1)) * D; const float* gate = p.MOD + (((size_t)l * NCND + midx) * 6 + (wh ? 5 : 2)) * D;
        WAVE_FOR { float s = 0.f; for (int c = lane; c < D; c += 64) { const float o = p.O[(size_t)row * D + c]; s += o * o; } ss[LI] = s; }
        wsum(ss);
        WAVE_FOR { const float rstd = rsq(ss[LI] / (float)D + NORM_EPS); for (int c = lane; c < D; c += 64) xout[(size_t)row * D + c] = p.X[(size_t)row * D + c] + gate[c] * (p.O[(size_t)row * D + c] * rstd * g[c]); } }
    if (a1 >= 0) { const int l = a1 >> 3, wh = a1 & 7; const float* g = p.g_norm + ((size_t)l * 4 + (wh ? 2 : 0)) * D; const float* sh = p.MOD + (((size_t)l * NCND + midx) * 6 + (wh ? 3 : 0)) * D; const float* sc = sh + D;
        WAVE_FOR { float s = 0.f; for (int c = lane; c < D; c += 64) { const float x = p.X[(size_t)row * D + c]; s += x * x; } ss[LI] = s; }
        wsum(ss);
        WAVE_FOR { const float rstd = rsq(ss[LI] / (float)D + NORM_EPS); for (int c = lane; c < D; c += 64) p.H[(size_t)row * D + c] = f2bf(p.X[(size_t)row * D + c] * rstd * g[c] * (1.0f + sc[c]) + sh[c]); } }
} };

constexpr int ATT_LDS_FLOATS = 2 * TMAX + 2 * HDIM + VD;
struct W_attn { static constexpr int NITEMS = M * NH; static HD void run(const P& p, int, int, int item, float* lds) {
    const int row = item / NH, h = item % NH; int seq0, t, L, cls, b; row_info(row, seq0, t, L, cls, b);
    const int T = cls ? PAST + DEC_SEQ : SEQ; const float scale = 1.0f / sqrtf((float)HDIM);
    const float lam_init = 0.8f - 0.6f * expf(-0.3f * (float)ATT_LAYER);
    float s01 = 0.f, s23 = 0.f; for (int d = 0; d < HDIM; ++d) { s01 += p.at_lam[d] * p.at_lam[HDIM + d]; s23 += p.at_lam[2 * HDIM + d] * p.at_lam[3 * HDIM + d]; }
    const float lam = expf(s01) - expf(s23) + lam_init;
    float* s0 = lds; float* s1 = lds + TMAX; float* q = lds + 2 * TMAX; float* ov = q + 2 * HDIM;
    WAVE_FOR { for (int d = lane; d < 2 * HDIM; d += 64) q[d] = bf2f(p.Z[(size_t)row * 3 * D + h * 2 * HDIM + d]); }
    WAVE_SYNC();
    float m0[NL], m1[NL], l0[NL], l1[NL];
    WAVE_FOR { float mx0 = -3.0e38f, mx1 = -3.0e38f;
        for (int kk = lane; kk < T; kk += 64) { float d0 = 0.f, d1 = 0.f;
            if (cls && kk < PAST) { const float* kp = p.cache_k + (((size_t)b * NAT * PAST + kk) * NH + h) * 2 * HDIM; for (int d = 0; d < HDIM; ++d) { d0 += q[d] * kp[d]; d1 += q[HDIM + d] * kp[HDIM + d]; } }
            else { const bf16* kp = p.Z + (size_t)(seq0 + (cls ? kk - PAST : kk)) * 3 * D + D + h * 2 * HDIM; for (int d = 0; d < HDIM; ++d) { d0 += q[d] * bf2f(kp[d]); d1 += q[HDIM + d] * bf2f(kp[HDIM + d]); } }
            d0 *= scale; d1 *= scale; s0[kk] = d0; s1[kk] = d1; mx0 = d0 > mx0 ? d0 : mx0; mx1 = d1 > mx1 ? d1 : mx1; }
        m0[LI] = mx0; m1[LI] = mx1; }
    wmax(m0); wmax(m1);
    WAVE_FOR { float a0 = 0.f, a1 = 0.f; for (int kk = lane; kk < T; kk += 64) { a0 += expf(s0[kk] - m0[LI]); a1 += expf(s1[kk] - m1[LI]); } l0[LI] = a0; l1[LI] = a1; }
    wsum(l0); wsum(l1);
    WAVE_FOR { for (int kk = lane; kk < T; kk += 64) s0[kk] = expf(s0[kk] - m0[LI]) / l0[LI] - lam * expf(s1[kk] - m1[LI]) / l1[LI]; }
    WAVE_SYNC();
    float sq[NL];
    WAVE_FOR { float ssq = 0.f;
        for (int e = lane; e < VD; e += 64) { float o = 0.f;
            for (int kk = 0; kk < T; ++kk) { float v;
                if (cls && kk < PAST) v = p.cache_v[(((size_t)b * NAT * PAST + kk) * NH + h) * VD + e];
                else v = bf2f(p.Z[(size_t)(seq0 + (cls ? kk - PAST : kk)) * 3 * D + 2 * D + h * VD + e]);
                o += s0[kk] * v; }
            ov[e] = o; ssq += o * o; }
        sq[LI] = ssq; }
    wsum(sq);
    WAVE_FOR { const float rstd = rsq(sq[LI] / (float)VD + NORM_EPS); for (int e = lane; e < VD; e += 64) p.H[(size_t)row * D + h * VD + e] = f2bf(ov[e] * rstd * p.at_g_sub[e] * (1.0f - lam_init)); }
    WAVE_SYNC();
} };

struct W_s5 { static constexpr int NITEMS = (BATCH + DEC_BATCH) * SGS * 2; static HD void run(const P& p, int, int, int item, float*  ) {
    const int dir = item & 1, g = (item >> 1) % SGS, sidx = (item >> 1) / SGS; const bool lat = sidx >= BATCH; const int b = lat ? sidx - BATCH : sidx;
    const int L = lat ? DEC_SEQ : SEQ, seq0 = lat ? MC + b * DEC_SEQ : b * SEQ;
    float lbr[NL], lbi[NL], xr[NL], xi[NL], bbr[NL][SG], bbi[NL][SG], cr[NL][SG], ci[NL][SG], part[SG][NL];
    WAVE_FOR { const int pp = lane; const size_t gp = ((size_t)dir * SGS + g) * SP + pp;
        float lre = p.s5_lam_re[gp]; lre = lre < -1e-4f ? lre : -1e-4f; const float lim = p.s5_lam_im[gp], dt = expf(p.s5_log_dt[dir * SGS + g]);
        const float er = expf(lre * dt), br_ = er * cosf(lim * dt), bi_ = er * sinf(lim * dt); lbr[LI] = br_; lbi[LI] = bi_;
        const float nr = br_ - 1.0f, ni = bi_, den = lre * lre + lim * lim, cfr = (nr * lre + ni * lim) / den, cfi = (ni * lre - nr * lim) / den;
#pragma unroll
        for (int h = 0; h < SG; ++h) { const float b_r = p.s5_b_re[gp * SG + h], b_i = p.s5_b_im[gp * SG + h]; bbr[LI][h] = cfr * b_r - cfi * b_i; bbi[LI][h] = cfr * b_i + cfi * b_r;
            cr[LI][h] = p.s5_c_re[(((size_t)dir * SGS + g) * SG + h) * SP + pp]; ci[LI][h] = p.s5_c_im[(((size_t)dir * SGS + g) * SG + h) * SP + pp]; }
        if (lat) { const size_t si = (((size_t)b * NSS) * 2 + dir) * SGS * SP + (size_t)g * SP + pp; xr[LI] = p.st_re[si]; xi[LI] = p.st_im[si]; } else { xr[LI] = 0.f; xi[LI] = 0.f; } }
    float* Y = dir ? p.YB : p.YF;
    for (int step = 0; step < L; ++step) { const int t = dir ? L - 1 - step : step; const size_t ro = (size_t)(seq0 + t) * D + g * SG;
        WAVE_FOR { float bur = 0.f, bui = 0.f;
#pragma unroll
            for (int h = 0; h < SG; ++h) { const float u = bf2f(p.H[ro + h]); bur += bbr[LI][h] * u; bui += bbi[LI][h] * u; }
            const float nxr = lbr[LI] * xr[LI] - lbi[LI] * xi[LI] + bur, nxi = lbr[LI] * xi[LI] + lbi[LI] * xr[LI] + bui; xr[LI] = nxr; xi[LI] = nxi;
#pragma unroll
            for (int h = 0; h < SG; ++h) part[h][LI] = nxr * cr[LI][h] - nxi * ci[LI][h]; }
#pragma unroll
        for (int h = 0; h < SG; ++h) wsum(part[h]);
        WAVE_FOR {
#pragma unroll
            for (int h = 0; h < SG; ++h) if (lane == h) Y[ro + h] = part[h][LI]; } }
    if (!lat) { WAVE_FOR { const size_t so = (((size_t)b * NSS) * 2 + dir) * SGS * SP + (size_t)g * SP + lane; p.out[OUT_SRE + so] = xr[LI]; p.out[OUT_SIM + so] = xi[LI]; } }
} };

#ifdef HOST_EMU
template <class F> static void run_elem(const P& p, int a0, int a1, size_t n) { for (size_t i = 0; i < n; ++i) F::run(p, a0, a1, i); }
template <class F> static void run_wave(const P& p, int a0, int a1) { std::vector<float> lds(65536); for (int it = 0; it < F::NITEMS; ++it) F::run(p, a0, a1, it, lds.data()); }
static void run_wtrans(const float* W, int K, int N, bf16* WT) { for (int n = 0; n < N; ++n) for (int k = 0; k < K; ++k) WT[(size_t)n * K + k] = f2bf(W[(size_t)k * N + n]); }
static void run_gemm(const bf16* A, const bf16* Bt, int M_, int N, int K, float* Cf, bf16* Cb, int ldc, const float* bias) {
    std::vector<float> a((size_t)M_ * K), bt((size_t)N * K); for (size_t i = 0; i < a.size(); ++i) a[i] = bf2f(A[i]); for (size_t i = 0; i < bt.size(); ++i) bt[i] = bf2f(Bt[i]);
    for (int m = 0; m < M_; ++m) for (int n = 0; n < N; ++n) { float acc = 0.f; const float* ar = &a[(size_t)m * K]; const float* br = &bt[(size_t)n * K]; for (int k = 0; k < K; ++k) acc += ar[k] * br[k];
        if (bias) acc += bias[n]; if (Cf) Cf[(size_t)m * ldc + n] = acc; else Cb[(size_t)m * ldc + n] = f2bf(acc); }
}
#define STREAM_ARG
#else
namespace pg8 {
#define PG8_LAS __attribute__((address_space(3)))
typedef unsigned short bf16_t;
typedef short bf16x8 __attribute__((ext_vector_type(8)));
typedef float f32x4 __attribute__((ext_vector_type(4)));
typedef unsigned u32x4 __attribute__((ext_vector_type(4)));
constexpr int BM = 256, BK = 64, HALF = 128, HTB = HALF * BK * 2  , STAGE_BYTES = 8 * HTB, NXCD = 8, WGM = 8;

__host__ __device__ __forceinline__ int lds_byte(int r, int c) { const int st = (r >> 4) * 2 + (c >> 5), rr = r & 15, cc = c & 31, ob = rr * 64 + cc * 2; return st * 1024 + (ob ^ (((ob >> 9) & 1) << 5)); }
__host__ __device__ __forceinline__ void stage_rc(int b, int& R, int& C) { const int st = b / 1024, sb = b % 1024, swz = sb ^ (((sb >> 9) & 1) << 5); R = (st >> 1) * 16 + swz / 64; C = (st & 1) * 32 + (swz % 64) / 2; }
__host__ __device__ __forceinline__ int perm32(int rho) { const int n = rho >> 4, i = rho & 15; return 8 * (i >> 2) + 4 * n + (i & 3); }

struct Unit { int pm, pn; };
struct Gemm { const bf16_t* A; const bf16_t* Bt; int M, N, K, pad; };

struct StaticOrder {
    int nM, nN, nwg, G, c;
    __host__ __device__ void init(int M, int N, int G_, int c_) { nM = M / BM; nN = N / BM; nwg = nM * nN; G = G_; c = c_; }
    __host__ __device__ bool next(int i, Unit& u) const {
        const long L = (long)i * G + c; if (L >= nwg) return false;
        int wgid = (int)L; { const int q = nwg / NXCD, r = nwg % NXCD, xcd = wgid % NXCD, off = wgid / NXCD; wgid = (xcd < r ? xcd * (q + 1) : r * (q + 1) + (xcd - r) * q) + off; }
        const int nig = WGM * nN, gid = wgid / nig, fm = gid * WGM, gsz = (nM - fm) < WGM ? (nM - fm) : WGM;
        u.pm = fm + ((wgid % nig) % gsz); u.pn = (wgid % nig) / gsz; return true;
    }
    __device__ __forceinline__ void a_ready(const Unit&) const {}
    __device__ __forceinline__ void done(const Unit&) const {}
};

__device__ __forceinline__ unsigned cvt_pk_bf16(float lo, float hi) { unsigned r; asm volatile("v_cvt_pk_bf16_f32 %0, %1, %2" : "=v"(r) : "v"(lo), "v"(hi)); return r; }
typedef float f32x2 __attribute__((ext_vector_type(2)));
template <class Epi, class Sched, bool ALIGN_EPI = false, bool SP2 = false>
__device__ __forceinline__ void gemm_phase(PG8_LAS unsigned char* lds, const Gemm g, const Sched& S, const Epi& E) {
    const int tid = threadIdx.x, wid = __builtin_amdgcn_readfirstlane(tid >> 6), lane = tid & 63, wr = wid >> 2, wc = wid & 3, fr = lane & 15, fq = lane >> 4;
    const int K = g.K, nt = K / BK;
    unsigned voffA[2], voffB[2];
#pragma unroll
    for (int i = 0; i < 2; ++i) { int R, C; stage_rc(tid * 16 + i * 8192, R, C); const int Rb = Epi::PERM ? ((R & ~31) + perm32(R & 31)) : R;
        voffA[i] = (unsigned)(R * K + C) * 2u; voffB[i] = (unsigned)(Rb * K + C) * 2u; }
    const size_t kstep = (size_t)(BK * 2);
    const size_t hstep = (size_t)HALF * K * 2;
    const size_t tstep = 2 * hstep;
    const unsigned ldsw = (unsigned)wid * 1024u;
    const int aoff = lds_byte(wr * 64 + fr, fq * 8), boff = lds_byte(wc * 32 + fr, fq * 8);
#define PG8_SA(b, h) (((b) * 2 + (h)) * HTB)
#define PG8_SB(b, h) ((4 + (b) * 2 + (h)) * HTB)
#define PG8_STAGE(bufoff, gbase, voff) do { _Pragma("unroll") for (int _i = 0; _i < 2; ++_i) \
        __builtin_amdgcn_global_load_lds((const unsigned*)((const char*)(gbase) + (voff)[_i]), (PG8_LAS unsigned*)(lds + (bufoff) + ldsw + _i * 8192), 16, 0, 0); } while (0)
#define PG8_LDA(dst, b, h) do { _Pragma("unroll") for (int m = 0; m < 4; ++m) _Pragma("unroll") for (int k = 0; k < 2; ++k) dst[m][k] = *(const PG8_LAS bf16x8*)(lds + PG8_SA(b, h) + aoff + m * 2048 + k * 1024); } while (0)
#define PG8_LDB(dst, b, h) do { _Pragma("unroll") for (int n = 0; n < 2; ++n) _Pragma("unroll") for (int k = 0; k < 2; ++k) dst[n][k] = *(const PG8_LAS bf16x8*)(lds + PG8_SB(b, h) + boff + n * 2048 + k * 1024); } while (0)
#define PG8_MMA(ai, bj, At, Bt) do { __builtin_amdgcn_s_setprio(1); _Pragma("unroll") for (int m = 0; m < 4; ++m) _Pragma("unroll") for (int n = 0; n < 2; ++n) _Pragma("unroll") for (int k = 0; k < 2; ++k) \
        acc[ai][bj][m][n] = __builtin_amdgcn_mfma_f32_16x16x32_bf16(Bt[n][k], At[m][k], acc[ai][bj][m][n], 0, 0, 0); __builtin_amdgcn_s_setprio(0); } while (0)
#define PG8_WAIT_V(n) asm volatile("s_waitcnt vmcnt(" #n ")" ::: "memory")
#define PG8_WAIT_L(n) asm volatile("s_waitcnt lgkmcnt(" #n ")" ::: "memory")
#define PG8_BAR __builtin_amdgcn_s_barrier()
#define PG8_SCHED __builtin_amdgcn_sched_barrier(0)
    Unit cur, nxt; int ui = 0;
    if (!S.next(0, cur)) return;
    f32x4 acc[2][2][4][2];
#pragma unroll
    for (int a = 0; a < 2; ++a)
#pragma unroll
        for (int b = 0; b < 2; ++b)
#pragma unroll
            for (int m = 0; m < 4; ++m)
#pragma unroll
                for (int n = 0; n < 2; ++n) acc[a][b][m][n] = (f32x4){0.f, 0.f, 0.f, 0.f};
    bf16x8 At[4][2], B0[2][2], B1[2][2];
    const char* cA = (const char*)g.A + (size_t)cur.pm * tstep; const char* cB = (const char*)g.Bt + (size_t)cur.pn * tstep;
    S.a_ready(cur);
    if constexpr (SP2) {
        PG8_STAGE(PG8_SB(0, 0), cB, voffB); PG8_STAGE(PG8_SB(0, 1), cB + hstep, voffB); PG8_STAGE(PG8_SA(0, 0), cA, voffA); PG8_STAGE(PG8_SA(0, 1), cA + hstep, voffA);
        if (wr == 1) PG8_BAR;
        PG8_WAIT_V(2); PG8_BAR;
        PG8_STAGE(PG8_SB(1, 0), cB + kstep, voffB); PG8_STAGE(PG8_SA(1, 0), cA + kstep, voffA); PG8_STAGE(PG8_SB(1, 1), cB + hstep + kstep, voffB);
        PG8_WAIT_V(6); PG8_BAR;
    } else {
        PG8_STAGE(PG8_SB(0, 0), cB, voffB); PG8_STAGE(PG8_SA(0, 0), cA, voffA); PG8_STAGE(PG8_SB(0, 1), cB + hstep, voffB); PG8_STAGE(PG8_SA(0, 1), cA + hstep, voffA);
        if (wr == 1) PG8_BAR;
        PG8_WAIT_V(4); PG8_BAR;
        PG8_STAGE(PG8_SB(1, 0), cB + kstep, voffB); PG8_STAGE(PG8_SA(1, 0), cA + kstep, voffA); PG8_STAGE(PG8_SB(1, 1), cB + hstep + kstep, voffB);
        PG8_WAIT_V(6); PG8_BAR;
    }
    for (;;) {
        const bool has_next = S.next(ui + 1, nxt);
        const char* nA = has_next ? (const char*)g.A + (size_t)nxt.pm * tstep : cA; const char* nB = has_next ? (const char*)g.Bt + (size_t)nxt.pn * tstep : cB;
        for (int t = 0; t < nt; t += 2) {
            const bool last = (t == nt - 2);
            const char* a1 = cA + (size_t)(t + 1) * kstep;
            const char* a2 = last ? nA : cA + (size_t)(t + 2) * kstep; const char* b2 = last ? nB : cB + (size_t)(t + 2) * kstep;
            const char* a3 = a2 + kstep; const char* b3 = b2 + kstep;
            if (last && has_next) S.a_ready(nxt);
            if constexpr (SP2) {
            PG8_LDB(B0, 0, 0); PG8_LDB(B1, 0, 1); PG8_SCHED; PG8_LDA(At, 0, 0); PG8_STAGE(PG8_SA(1, 1), a1 + hstep, voffA);
            PG8_WAIT_V(8); PG8_WAIT_L(0); PG8_BAR; PG8_MMA(0, 0, At, B0); PG8_MMA(0, 1, At, B1); PG8_BAR; PG8_SCHED;
            PG8_LDA(At, 0, 1); PG8_STAGE(PG8_SB(0, 0), b2, voffB); PG8_STAGE(PG8_SB(0, 1), b2 + hstep, voffB); PG8_STAGE(PG8_SA(0, 0), a2, voffA);
            PG8_WAIT_V(8); PG8_WAIT_L(0); PG8_BAR; PG8_MMA(1, 0, At, B0); PG8_MMA(1, 1, At, B1); PG8_BAR; PG8_SCHED;
            PG8_LDB(B0, 1, 0); PG8_LDB(B1, 1, 1); PG8_SCHED; PG8_LDA(At, 1, 0); PG8_STAGE(PG8_SA(0, 1), a2 + hstep, voffA);
            PG8_WAIT_V(8); PG8_WAIT_L(0); PG8_BAR; PG8_MMA(0, 0, At, B0); PG8_MMA(0, 1, At, B1); PG8_BAR; PG8_SCHED;
            PG8_LDA(At, 1, 1); PG8_STAGE(PG8_SB(1, 0), b3, voffB); PG8_STAGE(PG8_SB(1, 1), b3 + hstep, voffB); PG8_STAGE(PG8_SA(1, 0), a3, voffA);
            PG8_WAIT_V(8); PG8_WAIT_L(0); PG8_BAR; PG8_MMA(1, 0, At, B0); PG8_MMA(1, 1, At, B1); PG8_BAR; PG8_SCHED;
            } else {
            PG8_LDB(B0, 0, 0); PG8_SCHED; PG8_LDA(At, 0, 0); PG8_STAGE(PG8_SA(1, 1), a1 + hstep, voffA);
            PG8_WAIT_L(8); PG8_BAR; PG8_WAIT_L(0); PG8_MMA(0, 0, At, B0); PG8_BAR; PG8_SCHED;
            PG8_LDB(B1, 0, 1); PG8_STAGE(PG8_SB(0, 0), b2, voffB);
            PG8_BAR; PG8_WAIT_L(0); PG8_MMA(0, 1, At, B1); PG8_BAR;
            PG8_LDA(At, 0, 1); PG8_STAGE(PG8_SA(0, 0), a2, voffA);
            PG8_BAR; PG8_WAIT_L(0); PG8_MMA(1, 0, At, B0); PG8_BAR; PG8_SCHED;
            PG8_STAGE(PG8_SB(0, 1), b2 + hstep, voffB);
            PG8_WAIT_V(6); PG8_BAR; PG8_MMA(1, 1, At, B1); PG8_BAR;
            PG8_LDB(B0, 1, 0); PG8_SCHED; PG8_LDA(At, 1, 0); PG8_STAGE(PG8_SA(0, 1), a2 + hstep, voffA);
            PG8_WAIT_L(8); PG8_BAR; PG8_WAIT_L(0); PG8_MMA(0, 0, At, B0); PG8_BAR; PG8_SCHED;
            PG8_LDB(B1, 1, 1); PG8_STAGE(PG8_SB(1, 0), b3, voffB);
            PG8_BAR; PG8_WAIT_L(0); PG8_MMA(0, 1, At, B1); PG8_BAR;
            PG8_LDA(At, 1, 1); PG8_STAGE(PG8_SA(1, 0), a3, voffA);
            PG8_BAR; PG8_WAIT_L(0); PG8_MMA(1, 0, At, B0); PG8_BAR; PG8_SCHED;
            PG8_STAGE(PG8_SB(1, 1), b3 + hstep, voffB);
            PG8_WAIT_V(6); PG8_BAR; PG8_MMA(1, 1, At, B1); PG8_BAR;
            }
        }
        if constexpr (ALIGN_EPI) { if (wr == 0) PG8_BAR; }
        if constexpr (!Epi::AFTER_DRAIN) { E(acc, cur, wr, wc, fr, fq); S.done(cur); }
        if (!has_next) break;
#pragma unroll
        for (int a = 0; a < 2; ++a)
#pragma unroll
            for (int b = 0; b < 2; ++b)
#pragma unroll
                for (int m = 0; m < 4; ++m)
#pragma unroll
                    for (int n = 0; n < 2; ++n) acc[a][b][m][n] = (f32x4){0.f, 0.f, 0.f, 0.f};
        cur = nxt; cA = nA; cB = nB; ++ui;
        if constexpr (ALIGN_EPI) { if (wr == 1) PG8_BAR; }
    }
    PG8_WAIT_V(0);
    if constexpr (!ALIGN_EPI) { if (wr == 0) PG8_BAR; }
    PG8_BAR;
    if constexpr (Epi::AFTER_DRAIN) { E.fused(acc, cur, wr, wc, fr, fq, lds, wid, lane); S.done(cur); }
#undef PG8_SA
#undef PG8_SB
#undef PG8_STAGE
#undef PG8_LDA
#undef PG8_LDB
#undef PG8_MMA
#undef PG8_WAIT_V
#undef PG8_WAIT_L
#undef PG8_BAR
#undef PG8_SCHED
}
}

namespace pg8 {
struct EpiF32 {
    static constexpr bool PERM = false, AFTER_DRAIN = false;
    float* C; const float* bias; int ldc; int pad;
    __device__ __forceinline__ void operator()(const f32x4 (&acc)[2][2][4][2], const Unit& u, int wr, int wc, int fr, int fq) const {
        const int row0 = u.pm * BM + wr * 64 + fr, col0 = u.pn * BM + wc * 32 + 4 * fq;
        f32x4 bv[2][2];
#pragma unroll
        for (int bj = 0; bj < 2; ++bj)
#pragma unroll
            for (int n = 0; n < 2; ++n) bv[bj][n] = bias ? *(const f32x4*)(bias + col0 + bj * HALF + n * 16) : (f32x4){0.f, 0.f, 0.f, 0.f};
#pragma unroll
        for (int ai = 0; ai < 2; ++ai)
#pragma unroll
            for (int m = 0; m < 4; ++m) { float* rowp = C + (size_t)(row0 + ai * HALF + m * 16) * ldc + col0;
#pragma unroll
                for (int bj = 0; bj < 2; ++bj)
#pragma unroll
                    for (int n = 0; n < 2; ++n) *(f32x4*)(rowp + bj * HALF + n * 16) = acc[ai][bj][m][n] + bv[bj][n]; }
    }
};
struct EpiB16 {
    static constexpr bool PERM = true, AFTER_DRAIN = false;
    bf16_t* O; const float* bias; int ldc; int pad;
    __device__ __forceinline__ void operator()(const f32x4 (&acc)[2][2][4][2], const Unit& u, int wr, int wc, int fr, int fq) const {
        const int row0 = u.pm * BM + wr * 64 + fr, col0 = u.pn * BM + wc * 32 + 8 * fq;
        f32x4 bv[2][2];
#pragma unroll
        for (int bj = 0; bj < 2; ++bj)
#pragma unroll
            for (int n = 0; n < 2; ++n) bv[bj][n] = bias ? *(const f32x4*)(bias + col0 + bj * HALF + 4 * n) : (f32x4){0.f, 0.f, 0.f, 0.f};
#pragma unroll
        for (int ai = 0; ai < 2; ++ai)
#pragma unroll
            for (int m = 0; m < 4; ++m) { bf16_t* rowp = O + (size_t)(row0 + ai * HALF + m * 16) * ldc + col0;
#pragma unroll
                for (int bj = 0; bj < 2; ++bj) { const f32x4 v0 = acc[ai][bj][m][0] + bv[bj][0], v1 = acc[ai][bj][m][1] + bv[bj][1];
                    u32x4 w; w.x = cvt_pk_bf16(v0[0], v0[1]); w.y = cvt_pk_bf16(v0[2], v0[3]); w.z = cvt_pk_bf16(v1[0], v1[1]); w.w = cvt_pk_bf16(v1[2], v1[3]);
                    *(u32x4*)(rowp + bj * HALF) = w; } }
    }
};
}
template <class F> __global__ void __launch_bounds__(256) k_elem(P p, int a0, int a1, size_t n) { for (size_t i = (size_t)blockIdx.x * 256 + threadIdx.x; i < n; i += (size_t)gridDim.x * 256) F::run(p, a0, a1, i); }
constexpr int WAVE_LDS_FLOATS = 4096;
static_assert(ATT_LDS_FLOATS <= WAVE_LDS_FLOATS, "attention scratch");
template <class F> __global__ void __launch_bounds__(256) k_wave(P p, int a0, int a1) {
    extern __shared__ __attribute__((aligned(16))) float wlds[];
    const int w = threadIdx.x >> 6, gw = blockIdx.x * 4 + w, nw = gridDim.x * 4;
    for (int it = gw; it < F::NITEMS; it += nw) F::run(p, a0, a1, it, wlds + w * WAVE_LDS_FLOATS);
}
__global__ void __launch_bounds__(256) k_wtrans(const float* W, int K, int N, bf16* WT) {
    __shared__ float scrs[4][64 * 33];
    const int w = threadIdx.x >> 6, lane = threadIdx.x & 63, gw = blockIdx.x * 4 + w, nw = gridDim.x * 4; float* scr = scrs[w];
    const int nblk = N / 32, nitems = (K / 64) * nblk;
    for (int item = gw; item < nitems; item += nw) {
        const int kb = item / nblk, nb = item % nblk, k0 = 64 * kb, n0 = 32 * nb;
        for (int i = 0; i < 32; ++i) { const int kk = 2 * i + (lane >> 5); scr[kk * 33 + (lane & 31)] = W[(size_t)(k0 + kk) * N + n0 + (lane & 31)]; }
        asm volatile("s_waitcnt lgkmcnt(0)" ::: "memory"); __builtin_amdgcn_wave_barrier();
        const int c = lane & 7;
        for (int j = 0; j < 4; ++j) { const int n = (lane >> 3) + 8 * j; const float* s = scr + (8 * c) * 33 + n;
            uint4 o; o.x = f2bf(s[0]) | ((unsigned)f2bf(s[33]) << 16); o.y = f2bf(s[2 * 33]) | ((unsigned)f2bf(s[3 * 33]) << 16); o.z = f2bf(s[4 * 33]) | ((unsigned)f2bf(s[5 * 33]) << 16); o.w = f2bf(s[6 * 33]) | ((unsigned)f2bf(s[7 * 33]) << 16);
            *(uint4*)(WT + (size_t)(n0 + n) * K + k0 + 8 * c) = o; }
        asm volatile("s_waitcnt lgkmcnt(0)" ::: "memory"); __builtin_amdgcn_wave_barrier();
    }
}
template <class Epi> __global__ void __launch_bounds__(512, 2) k_gemm(pg8::Gemm g, Epi E) {
    extern __shared__ __attribute__((aligned(16))) unsigned char shm[];
    pg8::StaticOrder S; S.init(g.M, g.N, (int)gridDim.x, (int)blockIdx.x);
    pg8::gemm_phase<Epi, pg8::StaticOrder, true, true>((PG8_LAS unsigned char*)shm, g, S, E);
}
static hipStream_t g_stream;
template <class F> static void run_elem(const P& p, int a0, int a1, size_t n) { size_t nb = (n + 255) / 256; if (nb > 8192) nb = 8192; hipLaunchKernelGGL((k_elem<F>), dim3((unsigned)nb), dim3(256), 0, g_stream, p, a0, a1, n); }
template <class F> static void run_wave(const P& p, int a0, int a1) { int nb = (F::NITEMS + 3) / 4; if (nb > 2048) nb = 2048; hipLaunchKernelGGL((k_wave<F>), dim3(nb), dim3(256), WAVE_LDS_FLOATS * 4 * 4, g_stream, p, a0, a1); }
static void run_wtrans(const float* W, int K, int N, bf16* WT) { hipLaunchKernelGGL(k_wtrans, dim3(2048), dim3(256), 0, g_stream, W, K, N, WT); }
static void run_gemm(const bf16* A, const bf16* Bt, int M_, int N, int K, float* Cf, bf16* Cb, int ldc, const float* bias) {
    static bool attr = false;
    if (!attr) { (void)hipFuncSetAttribute((const void*)k_gemm<pg8::EpiF32>, hipFuncAttributeMaxDynamicSharedMemorySize, pg8::STAGE_BYTES); (void)hipFuncSetAttribute((const void*)k_gemm<pg8::EpiB16>, hipFuncAttributeMaxDynamicSharedMemorySize, pg8::STAGE_BYTES); attr = true; }
    pg8::Gemm g{A, Bt, M_, N, K, 0};
    if (Cf) { pg8::EpiF32 E{Cf, bias, ldc, 0}; hipLaunchKernelGGL((k_gemm<pg8::EpiF32>), dim3(256), dim3(512), pg8::STAGE_BYTES, g_stream, g, E); }
    else { pg8::EpiB16 E{Cb, bias, ldc, 0}; hipLaunchKernelGGL((k_gemm<pg8::EpiB16>), dim3(256), dim3(512), pg8::STAGE_BYTES, g_stream, g, E); }
}
#endif

static void forward(const P& p) {
    run_elem<E_copyx>(p, 0, 0, (size_t)M * D);
    run_elem<E_scond>(p, 0, 0, (size_t)NCND * D);
    run_elem<E_mod>(p, 0, 0, (size_t)DEPTH * NCND * 6 * D);
    for (int l = 0; l < DEPTH; ++l) { run_wtrans(p.w_mlp_in + (size_t)l * D * DFF, D, DFF, p.Wt_mlp_in + (size_t)l * D * DFF); run_wtrans(p.w_mlp_out + (size_t)l * D * DFF, DFF, D, p.Wt_mlp_out + (size_t)l * D * DFF); }
    for (int j = 0; j < NHY; ++j) { run_wtrans(p.hy_w_in + (size_t)j * D * 3 * D, D, 3 * D, p.Wt_hy_in + (size_t)j * D * 3 * D); run_wtrans(p.hy_w_out + (size_t)j * D * D, D, D, p.Wt_hy_out + (size_t)j * D * D); }
    run_wtrans(p.at_w_qkv, D, 3 * D, p.Wt_qkv); run_wtrans(p.at_w_o, D, D, p.Wt_wo); run_wtrans(p.s5_w_glu, D, 2 * D, p.Wt_glu);
    run_elem<E_filt1>(p, 0, 0, (size_t)NHY * LMAX * FW);
    run_elem<E_filt2>(p, 0, 0, (size_t)NHY * LMAX * FW);
    run_elem<E_filt3>(p, 0, 0, (size_t)NHY * LMAX * 2 * D);
    run_elem<E_filtnorm>(p, 0, 0, (size_t)NHY * 2 * D);
    for (int i = 0; i < DEPTH; ++i) {
        const int kind = i % 3, j = i / 3;
        run_wave<W_thin>(p, i > 0 ? (i - 1) * 8 + 1 : -1, i * 8 + 0);
        if (kind == 0) {
            run_gemm(p.H, p.Wt_hy_in + (size_t)j * D * 3 * D, M, 3 * D, D, nullptr, p.Z, 3 * D, p.hy_b_in + (size_t)j * 3 * D);
            run_elem<E_hconv1>(p, j, 0, (size_t)M * D);
            run_elem<E_hconv2>(p, j, 0, (size_t)M * D);
            run_gemm(p.H, p.Wt_hy_out + (size_t)j * D * D, M, D, D, p.O, nullptr, D, p.hy_b_out + (size_t)j * D);
        } else if (kind == 1) {
            run_gemm(p.H, p.Wt_qkv, M, 3 * D, D, nullptr, p.Z, 3 * D, nullptr);
            run_elem<E_newkv>(p, 0, 0, (size_t)MC * D);
            run_elem<E_rope>(p, 0, 0, (size_t)ML * 2 * NH * 2 * 2 * QD);
            run_wave<W_attn>(p, 0, 0);
            run_gemm(p.H, p.Wt_wo, M, D, D, p.O, nullptr, D, nullptr);
        } else {
            run_wave<W_s5>(p, 0, 0);
            run_elem<E_s5comb>(p, 0, 0, (size_t)M * D);
            run_gemm(p.H, p.Wt_glu, M, 2 * D, D, nullptr, p.Z, 2 * D, p.s5_b_glu);
            run_elem<E_glu>(p, 0, 0, (size_t)M * D);
        }
        run_wave<W_thin>(p, i * 8 + 0, i * 8 + 1);
        run_gemm(p.H, p.Wt_mlp_in + (size_t)i * D * DFF, M, DFF, D, nullptr, p.HID, DFF, nullptr);
        run_elem<E_relu2>(p, 0, 0, (size_t)M * DFF);
        run_gemm(p.HID, p.Wt_mlp_out + (size_t)i * D * DFF, M, D, DFF, p.O, nullptr, D, nullptr);
    }
    run_wave<W_thin>(p, (DEPTH - 1) * 8 + 1, -1);
}

struct Bump { unsigned char* base; size_t off; template <class T> T* take(size_t n) { T* r = (T*)(base + off); off += (n * sizeof(T) + 255) & ~(size_t)255; return r; } };
static size_t carve(P& p, unsigned char* ws) {
    Bump b{ws, 0};
    p.Wt_mlp_in = b.take<bf16>((size_t)DEPTH * D * DFF); p.Wt_mlp_out = b.take<bf16>((size_t)DEPTH * D * DFF); p.Wt_hy_in = b.take<bf16>((size_t)NHY * D * 3 * D); p.Wt_hy_out = b.take<bf16>((size_t)NHY * D * D);
    p.Wt_qkv = b.take<bf16>((size_t)D * 3 * D); p.Wt_wo = b.take<bf16>((size_t)D * D); p.Wt_glu = b.take<bf16>((size_t)D * 2 * D);
    p.X = b.take<float>((size_t)M * D); p.MOD = b.take<float>((size_t)DEPTH * NCND * 6 * D); p.SCOND = b.take<float>((size_t)NCND * D); p.O = b.take<float>((size_t)M * D);
    p.HRAW = b.take<float>((size_t)NHY * LMAX * 2 * D); p.H1 = b.take<float>((size_t)NHY * LMAX * FW); p.H2 = b.take<float>((size_t)NHY * LMAX * FW); p.KINV = b.take<float>((size_t)NHY * 2 * D);
    p.H = b.take<bf16>((size_t)M * D); p.Z = b.take<bf16>((size_t)M * 3 * D);
    const size_t hid_off = b.off; p.HID = b.take<bf16>((size_t)M * DFF); const size_t hid_end = b.off;
    Bump o{ws, hid_off}; p.X0C = o.take<float>((size_t)M * D); p.VV = o.take<float>((size_t)M * D); p.YF = p.X0C; p.YB = p.VV;
    return hid_end > o.off ? hid_end : o.off;
}
static void set_inputs(P& p, void* const* in) {
    const float** f = (const float**)&p.x_prompt; for (int i = 0; i < 42; ++i) f[i] = (const float*)in[i];
}

#ifdef HOST_EMU
int main(int argc, char** argv) {
    const size_t G_ = SGS, P_ = SP, H_ = SG;
    const size_t sizes[42] = {(size_t)MC * D, (size_t)ML * D, (size_t)DEC_BATCH * NAT * PAST * NH * 2 * HDIM, (size_t)DEC_BATCH * NAT * PAST * NH * VD, (size_t)DEC_BATCH * NSS * 2 * G_ * P_, (size_t)DEC_BATCH * NSS * 2 * G_ * P_,
        (size_t)DEC_BATCH * D, (size_t)D, (size_t)DEPTH * D * 6 * D, (size_t)DEPTH * 6 * D, (size_t)DEPTH * 4 * D, (size_t)DEPTH * D * DFF, (size_t)DEPTH * DFF * D,
        (size_t)NHY * D * 3 * D, (size_t)NHY * 3 * D, (size_t)NHY * 3 * 3 * D, (size_t)NHY * 3 * D, (size_t)NHY * 32 * FW, (size_t)NHY * FW, (size_t)NHY * FW, (size_t)NHY * FW * FW, (size_t)NHY * FW, (size_t)NHY * FW,
        (size_t)NHY * FW * 2 * D, (size_t)NHY * D, (size_t)NHY * D, (size_t)NHY * D * D, (size_t)NHY * D,
        (size_t)NAT * D * 3 * D, (size_t)NAT * 4 * HDIM, (size_t)NAT * VD, (size_t)NAT * D * D,
        (size_t)NSS * 2 * G_ * P_, (size_t)NSS * 2 * G_ * P_, (size_t)NSS * 2 * G_, (size_t)NSS * 2 * G_ * P_ * H_, (size_t)NSS * 2 * G_ * P_ * H_, (size_t)NSS * 2 * G_ * H_ * P_, (size_t)NSS * 2 * G_ * H_ * P_,
        (size_t)NSS * D, (size_t)NSS * D * 2 * D, (size_t)NSS * 2 * D};
    FILE* f = fopen(argc > 1 ? argv[1] : "in_small.bin", "rb"); if (!f) { printf("no input\n"); return 1; }
    std::vector<std::vector<float>> ins(42); void* inp[42];
    for (int i = 0; i < 42; ++i) { ins[i].resize(sizes[i]); if (fread(ins[i].data(), 4, sizes[i], f) != sizes[i]) { printf("short read %d\n", i); return 1; } inp[i] = ins[i].data(); }
    fclose(f);
    P p; memset(&p, 0, sizeof(p)); set_inputs(p, inp);
    P tmp = p; const size_t need = carve(tmp, nullptr);
    std::vector<unsigned char> ws(need + 256, 0xAA); std::vector<float> out(OUT_END, -7.f);
    carve(p, ws.data()); p.out = out.data();
    forward(p);
    FILE* g = fopen(argc > 2 ? argv[2] : "emu_out.bin", "wb"); fwrite(out.data(), 4, out.size(), g); fclose(g);
    printf("host emulation done: %zu outputs, ws %zu bytes\n", out.size(), need);
    return 0;
}
#else
extern "C" void kernel_launch(void* const* d_in, const int* in_sizes, int n_in, void* d_out, int out_size, void* d_ws, size_t ws_size, hipStream_t stream) {
    P p{}; set_inputs(p, d_in); p.out = (float*)d_out;
    const size_t need = carve(p, (unsigned char*)d_ws);
    if (n_in != 42 || (size_t)out_size != OUT_END || need > ws_size) { fprintf(stderr, "kernel_launch: unexpected sizes: n_in %d out %d ws %zu (need %zu)\n", n_in, out_size, ws_size, need); return; }
    g_stream = stream;
    forward(p);
}
#endif
```

```cpp
#ifdef HOST_EMU
#include <cstdio>
#include <cstdlib>
#include <cstring>
#include <cmath>
#include <vector>
#define HD
#else
#include <hip/hip_runtime.h>
#include <cstdio>
#define HD __host__ __device__ __forceinline__
#endif

typedef unsigned short bf16;

#ifdef SMALL_CFG
constexpr int D = 256, BATCH = 4, SEQ = 256, DEC_BATCH = 2, DEC_SEQ = 512, PAST = 64;
#else
constexpr int D = 2048, BATCH = 32, SEQ = 256, DEC_BATCH = 8, DEC_SEQ = 1024, PAST = 512;
#endif
constexpr int DEPTH = 4, NHY = 2, NAT = 1, NSS = 1, DFF = 4 * D, GRID_W = 64;
constexpr int NH = 8, HDIM = D / NH / 2, VD = 2 * HDIM, QD = HDIM / 4;
constexpr int SG = 16, SGS = D / SG, SP = 64;
constexpr int MC = BATCH * SEQ, ML = DEC_BATCH * DEC_SEQ, M = MC + ML, NCND = 1 + DEC_BATCH;
constexpr int LMAX = DEC_SEQ > SEQ ? DEC_SEQ : SEQ;
constexpr int FW = 64, PEB = 16;
constexpr int TMAX = PAST + DEC_SEQ;
constexpr float NORM_EPS = 1e-6f;
constexpr int ATT_LAYER = 1;

struct P {
    const float *x_prompt, *x_sample, *cache_k, *cache_v, *st_re, *st_im, *c, *c_ctx, *w_mod, *b_mod, *g_norm, *w_mlp_in, *w_mlp_out,
        *hy_w_in, *hy_b_in, *hy_w_short, *hy_b_short, *hy_f_w1, *hy_f_b1, *hy_f_freq1, *hy_f_w2, *hy_f_b2, *hy_f_freq2, *hy_f_w3, *hy_log_alpha, *hy_skip, *hy_w_out, *hy_b_out,
        *at_w_qkv, *at_lam, *at_g_sub, *at_w_o, *s5_lam_re, *s5_lam_im, *s5_log_dt, *s5_b_re, *s5_b_im, *s5_c_re, *s5_c_im, *s5_d, *s5_w_glu, *s5_b_glu;
    float* out;
    float *X, *MOD, *SCOND, *O, *HRAW, *H1, *H2, *KINV, *X0C, *VV, *YF, *YB;
    bf16 *XB, *H, *Z, *HID, *Wt_mlp_in, *Wt_mlp_out, *Wt_hy_in, *Wt_hy_out, *Wt_qkv, *Wt_wo, *Wt_glu;
    bf16 *KT, *TS, *X0Cb, *VT, *YT, *KC, *VTT, *S5BB, *S5CM, *Z0, *ZT;
    float *S5LB, *MV, *PS, *PM, *RS, *RT;
    bf16 *Ob, *ObA;
    unsigned* CTL;
};
constexpr size_t CTL_BYTES = 65536;
constexpr size_t OUT_YC = 0, OUT_YL = (size_t)MC * D, OUT_K = (size_t)M * D, OUT_V = OUT_K + (size_t)MC * D, OUT_SRE = OUT_V + (size_t)MC * D, OUT_SIM = OUT_SRE + (size_t)BATCH * NSS * 2 * SGS * SP,
                 OUT_END = OUT_SIM + (size_t)BATCH * NSS * 2 * SGS * SP;

HD float bf2f(bf16 b) { unsigned u = ((unsigned)b) << 16; float f; __builtin_memcpy(&f, &u, 4); return f; }
HD bf16 f2bf(float f) { unsigned u; __builtin_memcpy(&u, &f, 4); u += 0x7fffu + ((u >> 16) & 1u); return (bf16)(u >> 16); }
#ifdef HOST_EMU
static inline unsigned pk2bf(float lo, float hi) { return (unsigned)f2bf(lo) | ((unsigned)f2bf(hi) << 16); }
#else
__device__ __forceinline__ unsigned pk2bf(float lo, float hi) { unsigned r; asm volatile("v_cvt_pk_bf16_f32 %0, %1, %2" : "=v"(r) : "v"(lo), "v"(hi)); return r; }
#endif
HD float rsq(float x) { return 1.0f / sqrtf(x); }
HD float silu_f(float v) { return v / (1.0f + expf(-v)); }
#ifdef HOST_EMU
static inline float gelu_tanh_f(float x) { const float u = 0.7978845608028654f * (x + 0.044715f * x * x * x); return x / (1.0f + expf(-2.0f * u)); }
#else
__device__ __forceinline__ float gelu_tanh_f(float x) { const float u = 0.7978845608028654f * (x + 0.044715f * x * x * x); return x * __builtin_amdgcn_rcpf(1.0f + __builtin_amdgcn_exp2f(-2.8853900817779268f * u)); }
#endif
HD void row_info(int row, int& seq0, int& t, int& L, int& cls, int& b) {
    if (row < MC) { b = row / SEQ; t = row % SEQ; L = SEQ; cls = 0; } else { const int r = row - MC; b = r / DEC_SEQ; t = r % DEC_SEQ; L = DEC_SEQ; cls = 1; }
    seq0 = row - t;
}

#ifdef HOST_EMU
#define WAVE_FOR for (int lane = 0; lane < 64; ++lane)
#define LI lane
#define NL 64
#define WAVE_SYNC() do { } while (0)
#define WAVE_SYNC_LDS() do { } while (0)
static inline void wsum_h(float* v) { float s = 0.f; for (int l = 0; l < 64; ++l) s += v[l]; for (int l = 0; l < 64; ++l) v[l] = s; }
static inline void wmax_h(float* v) { float s = v[0]; for (int l = 1; l < 64; ++l) s = v[l] > s ? v[l] : s; for (int l = 0; l < 64; ++l) v[l] = s; }
#define wsum(a) wsum_h(a)
#define wmax(a) wmax_h(a)
#else
#define WAVE_FOR for (int lane = (int)(threadIdx.x & 63), _once = 1; _once; _once = 0)
#define LI 0
#define NL 1
#define WAVE_SYNC() do { asm volatile("s_waitcnt vmcnt(0) lgkmcnt(0)" ::: "memory"); __builtin_amdgcn_wave_barrier(); } while (0)
#define WAVE_SYNC_LDS() do { asm volatile("s_waitcnt lgkmcnt(0)" ::: "memory"); __builtin_amdgcn_wave_barrier(); } while (0)
__device__ __forceinline__ float wsum_d(float s) {
#pragma unroll
    for (int o = 1; o < 64; o <<= 1) s += __shfl_xor(s, o);
    return s; }
__device__ __forceinline__ float wmax_d(float s) {
#pragma unroll
    for (int o = 1; o < 64; o <<= 1) { const float t = __shfl_xor(s, o); s = t > s ? t : s; }
    return s; }
#define wsum(a) ((a)[0] = wsum_d((a)[0]))
#define wmax(a) ((a)[0] = wmax_d((a)[0]))
#endif

struct E_copyx { static HD void run(const P& p, int, int, size_t i) { p.X[i] = i < (size_t)MC * D ? p.x_prompt[i] : p.x_sample[i - (size_t)MC * D]; } };
struct E_scond { static HD void run(const P& p, int, int, size_t i) { const int r = (int)(i / D), k = (int)(i % D); const float v = r == 0 ? p.c_ctx[k] : p.c[(size_t)(r - 1) * D + k]; p.SCOND[i] = silu_f(v); } };
struct E_mod { static HD void run(const P& p, int, int, size_t i) {
    const int n = (int)(i % (6 * D)), r = (int)((i / (6 * D)) % NCND), l = (int)(i / ((size_t)6 * D * NCND));
    const float* w = p.w_mod + (size_t)l * D * 6 * D + n; const float* s = p.SCOND + (size_t)r * D;
    float acc = 0.f; for (int k = 0; k < D; ++k) acc += s[k] * w[(size_t)k * 6 * D];
    p.MOD[i] = acc + p.b_mod[(size_t)l * 6 * D + n]; } };
struct E_relu2 { static HD void run(const P& p, int, int, size_t i) { float v = bf2f(p.HID[i]); v = v > 0.f ? v : 0.f; p.HID[i] = f2bf(v * v); } };

struct E_filt1 { static HD void run(const P& p, int, int, size_t i) {
    const int w = (int)(i % FW), t = (int)((i / FW) % LMAX), j = (int)(i / ((size_t)FW * LMAX));
    float acc = p.hy_f_b1[j * FW + w];
    for (int k = 0; k < 2 * PEB; ++k) { const int band = k % PEB; const float per = 2.0f * powf(2048.0f, (float)band / (float)(PEB - 1)); const float ang = (float)t * (6.283185307179586f / per);
        const float pe = k < PEB ? sinf(ang) : cosf(ang); acc += pe * p.hy_f_w1[((size_t)j * 2 * PEB + k) * FW + w]; }
    p.H1[i] = sinf(p.hy_f_freq1[j * FW + w] * acc); } };
struct E_filt2 { static HD void run(const P& p, int, int, size_t i) {
    const int w = (int)(i % FW), t = (int)((i / FW) % LMAX), j = (int)(i / ((size_t)FW * LMAX));
    float acc = p.hy_f_b2[j * FW + w]; const float* h1 = p.H1 + ((size_t)j * LMAX + t) * FW;
    for (int v = 0; v < FW; ++v) acc += h1[v] * p.hy_f_w2[((size_t)j * FW + v) * FW + w];
    p.H2[i] = sinf(p.hy_f_freq2[j * FW + w] * acc); } };
struct E_filt3 { static HD void run(const P& p, int, int, size_t i) {
    const int col = (int)(i % (2 * D)), t = (int)((i / (2 * D)) % LMAX), j = (int)(i / ((size_t)2 * D * LMAX)), d = col % D;
    const float* h2 = p.H2 + ((size_t)j * LMAX + t) * FW; float acc = 0.f;
    for (int w = 0; w < FW; ++w) acc += h2[w] * p.hy_f_w3[((size_t)j * FW + w) * 2 * D + col];
    p.HRAW[i] = acc * expf(-expf(p.hy_log_alpha[j * D + d]) * (float)t); } };
struct E_filtnorm { static HD void run(const P& p, int, int, size_t i) {
    const int d = (int)(i % D), cls = (int)((i / D) % 2), j = (int)(i / (2 * D)), L = cls ? DEC_SEQ : SEQ;
    const float* h = p.HRAW + (size_t)j * LMAX * 2 * D; float s = 0.f;
    for (int t = 0; t < L; ++t) { s += fabsf(h[(size_t)t * 2 * D + d]); if (t >= 1) s += fabsf(h[(size_t)t * 2 * D + D + d]); }
    p.KINV[i] = 1.0f / (s + 1e-6f); } };
struct E_hconv1 { static HD void run(const P& p, int j, int, size_t i) {
    const int row = (int)(i / D), c = (int)(i % D); int seq0, t, L, cls, b; row_info(row, seq0, t, L, cls, b);
    float zc[3];
    for (int blk = 0; blk < 3; ++blk) { const int col = blk * D + c; const float* ws = p.hy_w_short + (size_t)j * 3 * 3 * D;
        const float zp = t > 0 ? bf2f(p.Z[(size_t)(row - 1) * 3 * D + col]) : 0.f, z0 = bf2f(p.Z[(size_t)row * 3 * D + col]), zn = t < L - 1 ? bf2f(p.Z[(size_t)(row + 1) * 3 * D + col]) : 0.f;
        zc[blk] = zp * ws[col] + z0 * ws[3 * D + col] + zn * ws[2 * 3 * D + col] + p.hy_b_short[(size_t)j * 3 * D + col]; }
    p.X0C[i] = zc[0]; p.VV[i] = zc[2] * zc[1]; } };
struct E_hconv2 { static HD void run(const P& p, int j, int, size_t i) {
    const int row = (int)(i / D), c = (int)(i % D); int seq0, t, L, cls, b; row_info(row, seq0, t, L, cls, b);
    const float* h = p.HRAW + (size_t)j * LMAX * 2 * D; float y = 0.f;
    for (int s = 0; s < L; ++s) { const int jj = t - s; const float k = jj >= 0 ? h[(size_t)jj * 2 * D + c] : h[(size_t)(-jj) * 2 * D + D + c]; y += k * p.VV[(size_t)(seq0 + s) * D + c]; }
    y *= p.KINV[((size_t)j * 2 + cls) * D + c]; y += p.VV[i] * p.hy_skip[j * D + c];
    p.H[i] = f2bf(p.X0C[i] * y); } };

struct E_newkv { static HD void run(const P& p, int, int, size_t i) { const int row = (int)(i / D), c = (int)(i % D);
    p.out[OUT_K + i] = bf2f(p.Z[(size_t)row * 3 * D + D + c]); p.out[OUT_V + i] = bf2f(p.Z[(size_t)row * 3 * D + 2 * D + c]); } };
struct E_rope { static HD void run(const P& p, int, int, size_t i) {
    size_t r = i; const int e = (int)(r % (2 * QD)); r /= 2 * QD; const int comp = (int)(r % 2); r /= 2; const int h = (int)(r % NH); r /= NH; const int which = (int)(r % 2); r /= 2; const int lrow = (int)r;
    const int grp = e / QD, ii = e % QD, t = lrow % DEC_SEQ, gr = t / GRID_W, gc = t % GRID_W;
    const float inv = powf(10000.0f, -(float)(2 * ii) / (float)(HDIM / 2)), ang = (float)(grp == 0 ? gr : gc) * inv, cs = cosf(ang), sn = sinf(ang);
    bf16* z = p.Z + (size_t)(MC + lrow) * 3 * D + which * D + h * 2 * HDIM + comp * HDIM + grp * 2 * QD + ii;
    const float a = bf2f(z[0]), bb = bf2f(z[QD]); z[0] = f2bf(a * cs - bb * sn); z[QD] = f2bf(bb * cs + a * sn); } };
struct E_s5comb { static HD void run(const P& p, int, int, size_t i) { const int c = (int)(i % D); const float u = bf2f(p.H[i]); p.H[i] = f2bf(gelu_tanh_f(p.s5_d[c] * u + p.YF[i] + p.YB[i])); } };
struct E_glu { static HD void run(const P& p, int, int, size_t i) { const int row = (int)(i / D), c = (int)(i % D); const float a = bf2f(p.Z[(size_t)row * 2 * D + c]), g = bf2f(p.Z[(size_t)row * 2 * D + D + c]);
    p.O[i] = a / (1.0f + expf(-g)); } };

struct W_thin { static constexpr int NITEMS = M; static HD void run(const P& p, int a0, int a1, int row, float*  ) {
    const int midx = row < MC ? 0 : 1 + (row - MC) / DEC_SEQ; const bool fin = a1 < 0; float* xout = fin ? p.out : p.X;
    float ss[NL];
    if (a0 >= 0) { const int l = a0 >> 3, wh = a0 & 7; const float* g = p.g_norm + ((size_t)l * 4 + (wh ? 3 : 1)) * D; const float* gate = p.MOD + (((size_t)l * NCND + midx) * 6 + (wh ? 5 : 2)) * D;
        WAVE_FOR { float s = 0.f; for (int c = lane; c < D; c += 64) { const float o = p.O[(size_t)row * D + c]; s += o * o; } ss[LI] = s; }
        wsum(ss);
        WAVE_FOR { const float rstd = rsq(ss[LI] / (float)D + NORM_EPS); for (int c = lane; c < D; c += 64) xout[(size_t)row * D + c] = p.X[(size_t)row * D + c] + gate[c] * (p.O[(size_t)row * D + c] * rstd * g[c]); } }
    if (a1 >= 0) { const int l = a1 >> 3, wh = a1 & 7; const float* g = p.g_norm + ((size_t)l * 4 + (wh ? 2 : 0)) * D; const float* sh = p.MOD + (((size_t)l * NCND + midx) * 6 + (wh ? 3 : 0)) * D; const float* sc = sh + D;
        WAVE_FOR { float s = 0.f; for (int c = lane; c < D; c += 64) { const float x = p.X[(size_t)row * D + c]; s += x * x; } ss[LI] = s; }
        wsum(ss);
        WAVE_FOR { const float rstd = rsq(ss[LI] / (float)D + NORM_EPS); for (int c = lane; c < D; c += 64) p.H[(size_t)row * D + c] = f2bf(p.X[(size_t)row * D + c] * rstd * g[c] * (1.0f + sc[c]) + sh[c]); } }
} };

constexpr int ATT_LDS_FLOATS = 2 * TMAX + 2 * HDIM + VD;
struct W_attn { static constexpr int NITEMS = M * NH; static HD void run(const P& p, int, int, int item, float* lds) {
    const int row = item / NH, h = item % NH; int seq0, t, L, cls, b; row_info(row, seq0, t, L, cls, b);
    const int T = cls ? PAST + DEC_SEQ : SEQ; const float scale = 1.0f / sqrtf((float)HDIM);
    const float lam_init = 0.8f - 0.6f * expf(-0.3f * (float)ATT_LAYER);
    float s01 = 0.f, s23 = 0.f; for (int d = 0; d < HDIM; ++d) { s01 += p.at_lam[d] * p.at_lam[HDIM + d]; s23 += p.at_lam[2 * HDIM + d] * p.at_lam[3 * HDIM + d]; }
    const float lam = expf(s01) - expf(s23) + lam_init;
    float* s0 = lds; float* s1 = lds + TMAX; float* q = lds + 2 * TMAX; float* ov = q + 2 * HDIM;
    WAVE_FOR { for (int d = lane; d < 2 * HDIM; d += 64) q[d] = bf2f(p.Z[(size_t)row * 3 * D + h * 2 * HDIM + d]); }
    WAVE_SYNC();
    float m0[NL], m1[NL], l0[NL], l1[NL];
    WAVE_FOR { float mx0 = -3.0e38f, mx1 = -3.0e38f;
        for (int kk = lane; kk < T; kk += 64) { float d0 = 0.f, d1 = 0.f;
            if (cls && kk < PAST) { const float* kp = p.cache_k + (((size_t)b * NAT * PAST + kk) * NH + h) * 2 * HDIM; for (int d = 0; d < HDIM; ++d) { d0 += q[d] * kp[d]; d1 += q[HDIM + d] * kp[HDIM + d]; } }
            else { const bf16* kp = p.Z + (size_t)(seq0 + (cls ? kk - PAST : kk)) * 3 * D + D + h * 2 * HDIM; for (int d = 0; d < HDIM; ++d) { d0 += q[d] * bf2f(kp[d]); d1 += q[HDIM + d] * bf2f(kp[HDIM + d]); } }
            d0 *= scale; d1 *= scale; s0[kk] = d0; s1[kk] = d1; mx0 = d0 > mx0 ? d0 : mx0; mx1 = d1 > mx1 ? d1 : mx1; }
        m0[LI] = mx0; m1[LI] = mx1; }
    wmax(m0); wmax(m1);
    WAVE_FOR { float a0 = 0.f, a1 = 0.f; for (int kk = lane; kk < T; kk += 64) { a0 += expf(s0[kk] - m0[LI]); a1 += expf(s1[kk] - m1[LI]); } l0[LI] = a0; l1[LI] = a1; }
    wsum(l0); wsum(l1);
    WAVE_FOR { for (int kk = lane; kk < T; kk += 64) s0[kk] = expf(s0[kk] - m0[LI]) / l0[LI] - lam * expf(s1[kk] - m1[LI]) / l1[LI]; }
    WAVE_SYNC();
    float sq[NL];
    WAVE_FOR { float ssq = 0.f;
        for (int e = lane; e < VD; e += 64) { float o = 0.f;
            for (int kk = 0; kk < T; ++kk) { float v;
                if (cls && kk < PAST) v = p.cache_v[(((size_t)b * NAT * PAST + kk) * NH + h) * VD + e];
                else v = bf2f(p.Z[(size_t)(seq0 + (cls ? kk - PAST : kk)) * 3 * D + 2 * D + h * VD + e]);
                o += s0[kk] * v; }
            ov[e] = o; ssq += o * o; }
        sq[LI] = ssq; }
    wsum(sq);
    WAVE_FOR { const float rstd = rsq(sq[LI] / (float)VD + NORM_EPS); for (int e = lane; e < VD; e += 64) p.H[(size_t)row * D + h * VD + e] = f2bf(ov[e] * rstd * p.at_g_sub[e] * (1.0f - lam_init)); }
    WAVE_SYNC();
} };

struct W_s5 { static constexpr int NITEMS = (BATCH + DEC_BATCH) * SGS * 2; static HD void run(const P& p, int, int, int item, float*  ) {
    const int dir = item & 1, g = (item >> 1) % SGS, sidx = (item >> 1) / SGS; const bool lat = sidx >= BATCH; const int b = lat ? sidx - BATCH : sidx;
    const int L = lat ? DEC_SEQ : SEQ, seq0 = lat ? MC + b * DEC_SEQ : b * SEQ;
    float lbr[NL], lbi[NL], xr[NL], xi[NL], bbr[NL][SG], bbi[NL][SG], cr[NL][SG], ci[NL][SG], part[SG][NL];
    WAVE_FOR { const int pp = lane; const size_t gp = ((size_t)dir * SGS + g) * SP + pp;
        float lre = p.s5_lam_re[gp]; lre = lre < -1e-4f ? lre : -1e-4f; const float lim = p.s5_lam_im[gp], dt = expf(p.s5_log_dt[dir * SGS + g]);
        const float er = expf(lre * dt), br_ = er * cosf(lim * dt), bi_ = er * sinf(lim * dt); lbr[LI] = br_; lbi[LI] = bi_;
        const float nr = br_ - 1.0f, ni = bi_, den = lre * lre + lim * lim, cfr = (nr * lre + ni * lim) / den, cfi = (ni * lre - nr * lim) / den;
#pragma unroll
        for (int h = 0; h < SG; ++h) { const float b_r = p.s5_b_re[gp * SG + h], b_i = p.s5_b_im[gp * SG + h]; bbr[LI][h] = cfr * b_r - cfi * b_i; bbi[LI][h] = cfr * b_i + cfi * b_r;
            cr[LI][h] = p.s5_c_re[(((size_t)dir * SGS + g) * SG + h) * SP + pp]; ci[LI][h] = p.s5_c_im[(((size_t)dir * SGS + g) * SG + h) * SP + pp]; }
        if (lat) { const size_t si = (((size_t)b * NSS) * 2 + dir) * SGS * SP + (size_t)g * SP + pp; xr[LI] = p.st_re[si]; xi[LI] = p.st_im[si]; } else { xr[LI] = 0.f; xi[LI] = 0.f; } }
    float* Y = dir ? p.YB : p.YF;
    for (int step = 0; step < L; ++step) { const int t = dir ? L - 1 - step : step; const size_t ro = (size_t)(seq0 + t) * D + g * SG;
        WAVE_FOR { float bur = 0.f, bui = 0.f;
#pragma unroll
            for (int h = 0; h < SG; ++h) { const float u = bf2f(p.H[ro + h]); bur += bbr[LI][h] * u; bui += bbi[LI][h] * u; }
            const float nxr = lbr[LI] * xr[LI] - lbi[LI] * xi[LI] + bur, nxi = lbr[LI] * xi[LI] + lbi[LI] * xr[LI] + bui; xr[LI] = nxr; xi[LI] = nxi;
#pragma unroll
            for (int h = 0; h < SG; ++h) part[h][LI] = nxr * cr[LI][h] - nxi * ci[LI][h]; }
#pragma unroll
        for (int h = 0; h < SG; ++h) wsum(part[h]);
        WAVE_FOR {
#pragma unroll
            for (int h = 0; h < SG; ++h) if (lane == h) Y[ro + h] = part[h][LI]; } }
    if (!lat) { WAVE_FOR { const size_t so = (((size_t)b * NSS) * 2 + dir) * SGS * SP + (size_t)g * SP + lane; p.out[OUT_SRE + so] = xr[LI]; p.out[OUT_SIM + so] = xi[LI]; } }
} };


#ifdef HOST_EMU
struct Frag8 { bf16 e[8]; bf16& operator[](int i) { return e[i]; } const bf16& operator[](int i) const { return e[i]; } };
struct Acc16 { float e[16]; float& operator[](int i) { return e[i]; } const float& operator[](int i) const { return e[i]; } };
struct Acc4 { float e[4]; float& operator[](int i) { return e[i]; } const float& operator[](int i) const { return e[i]; } };
static inline Frag8 ld_frag8(const bf16* p) { Frag8 f; memcpy(f.e, p, 16); return f; }
static inline Frag8 zero_frag8() { Frag8 f; memset(f.e, 0, 16); return f; }
static inline void st_frag8(bf16* p, const Frag8& f) { memcpy(p, f.e, 16); }
static inline void st4b(bf16* p, const float* v) { for (int e = 0; e < 4; ++e) p[e] = f2bf(v[e]); }
static inline Frag8 pack8(const float* v) { Frag8 f; for (int e = 0; e < 8; ++e) f.e[e] = f2bf(v[e]); return f; }
static inline void mfma32_h(Acc16* acc, const Frag8* a, const Frag8* b) {
    static float A[32][16], B[16][32];
    for (int l = 0; l < 64; ++l) for (int i = 0; i < 8; ++i) { A[l & 31][8 * (l >> 5) + i] = bf2f(a[l][i]); B[8 * (l >> 5) + i][l & 31] = bf2f(b[l][i]); }
    for (int l = 0; l < 64; ++l) for (int r = 0; r < 16; ++r) { const int row = (r & 3) + 8 * (r >> 2) + 4 * (l >> 5), col = l & 31; float s = acc[l][r]; for (int k = 0; k < 16; ++k) s += A[row][k] * B[k][col]; acc[l][r] = s; }
}
static inline void mfma16_h(Acc4* acc, const Frag8* a, const Frag8* b) {
    static float A[16][32], B[32][16];
    for (int l = 0; l < 64; ++l) for (int i = 0; i < 8; ++i) { A[l & 15][8 * (l >> 4) + i] = bf2f(a[l][i]); B[8 * (l >> 4) + i][l & 15] = bf2f(b[l][i]); }
    for (int l = 0; l < 64; ++l) for (int r = 0; r < 4; ++r) { const int row = 4 * (l >> 4) + r, col = l & 15; float s = acc[l][r]; for (int k = 0; k < 32; ++k) s += A[row][k] * B[k][col]; acc[l][r] = s; }
}
#define MFMA32(acc, a, b) mfma32_h(acc, a, b)
#define MFMA16(acc, a, b) mfma16_h(acc, a, b)
#else
typedef short Frag8 __attribute__((ext_vector_type(8)));
typedef float Acc16 __attribute__((ext_vector_type(16)));
typedef float Acc4 __attribute__((ext_vector_type(4)));
__device__ __forceinline__ Frag8 ld_frag8(const bf16* p) { return *(const Frag8*)p; }
__device__ __forceinline__ Frag8 zero_frag8() { return (Frag8){0, 0, 0, 0, 0, 0, 0, 0}; }
__device__ __forceinline__ void st_frag8(bf16* p, const Frag8& f) { *(Frag8*)p = f; }
__device__ __forceinline__ void st4b(bf16* p, const float* v) { uint2 o; o.x = pk2bf(v[0], v[1]); o.y = pk2bf(v[2], v[3]); *(uint2*)p = o; }
typedef unsigned U32x4v __attribute__((ext_vector_type(4)));
__device__ __forceinline__ Frag8 pack8(const float* v) { U32x4v u; u[0] = pk2bf(v[0], v[1]); u[1] = pk2bf(v[2], v[3]); u[2] = pk2bf(v[4], v[5]); u[3] = pk2bf(v[6], v[7]); return __builtin_bit_cast(Frag8, u); }
#define MFMA32(acc, a, b) ((acc)[0] = __builtin_amdgcn_mfma_f32_32x32x16_bf16((a)[0], (b)[0], (acc)[0], 0, 0, 0))
#define MFMA16(acc, a, b) ((acc)[0] = __builtin_amdgcn_mfma_f32_16x16x32_bf16((a)[0], (b)[0], (acc)[0], 0, 0, 0))
#endif

constexpr size_t KT_C = (size_t)D * 2 * SEQ, KT_L = (size_t)D * 2 * DEC_SEQ, KT_LAYER = KT_C + KT_L;
constexpr size_t TS_C = (size_t)D * 8 * 2 * SEQ, TS_L = (size_t)D * 8 * 2 * DEC_SEQ, TS_ALL = TS_C + TS_L;
HD size_t kt_off(int j, int cls, int c) { return (size_t)j * KT_LAYER + (cls ? KT_C + (size_t)c * 2 * DEC_SEQ : (size_t)c * 2 * SEQ); }
HD size_t ts_off(int cls, int c, int rho) { return cls ? TS_C + ((size_t)c * 8 + rho) * 2 * DEC_SEQ : ((size_t)c * 8 + rho) * 2 * SEQ; }
struct E_filtkt { static HD void run(const P& p, int, int, size_t i) {
    const int d = (int)(i % D), cls = (int)((i / D) % 2), j = (int)(i / (2 * D)), L = cls ? DEC_SEQ : SEQ;
    const float* h = p.HRAW + (size_t)j * LMAX * 2 * D; float s = 0.f;
    for (int t = 0; t < L; ++t) { s += fabsf(h[(size_t)t * 2 * D + d]); if (t >= 1) s += fabsf(h[(size_t)t * 2 * D + D + d]); }
    const float inv = 1.0f / (s + 1e-6f); p.KINV[i] = inv;
    bf16* kt = p.KT + kt_off(j, cls, d); kt[0] = 0;
    for (int t = 0; t < L; ++t) { kt[L + t] = f2bf(h[(size_t)t * 2 * D + d] * inv); if (t >= 1) kt[L - t] = f2bf(h[(size_t)t * 2 * D + D + d] * inv); } } };
struct E_taps { static HD void run(const P& p, int j, int, size_t i) {
    size_t e0 = i * 8; const int cls = e0 >= TS_C ? 1 : 0; if (cls) e0 -= TS_C; const int L = cls ? DEC_SEQ : SEQ;
    const int idx0 = (int)(e0 % (2 * L)), rho = (int)((e0 / (2 * L)) % 8), c = (int)(e0 / ((size_t)2 * L * 8));
    const bf16* kt = p.KT + kt_off(j, cls, c); bf16* ts = p.TS + ts_off(cls, c, rho) + idx0;
    for (int e = 0; e < 8; ++e) { const int jt = rho - (idx0 + e - L); ts[e] = (jt > -L && jt < L) ? kt[jt + L] : (bf16)0; } } };
struct W_hconv1t { static constexpr int NITEMS = (M / 64) * (D / 64); static HD void run(const P& p, int j, int, int item, float* ldsf) {
    bf16* tl = (bf16*)ldsf; const int ct = item % (D / 64), rt = item / (D / 64), row0 = rt * 64, c0 = ct * 64;
    int seq0, t0, L, cls, b; row_info(row0, seq0, t0, L, cls, b);
    WAVE_FOR { const int c = c0 + lane; float w[3][3], bs[3], prev[3], cur[3], nxt[3];
#pragma unroll
        for (int blk = 0; blk < 3; ++blk) { const int col = blk * D + c; const float* ws = p.hy_w_short + (size_t)j * 9 * D; w[blk][0] = ws[col]; w[blk][1] = ws[3 * D + col]; w[blk][2] = ws[6 * D + col]; bs[blk] = p.hy_b_short[(size_t)j * 3 * D + col];
            prev[blk] = t0 > 0 ? bf2f(p.Z[(size_t)(row0 - 1) * 3 * D + col]) : 0.f; cur[blk] = bf2f(p.Z[(size_t)row0 * 3 * D + col]); }
        for (int tt = 0; tt < 64; ++tt) { const int row = row0 + tt; float zc[3];
#pragma unroll
            for (int blk = 0; blk < 3; ++blk) { nxt[blk] = (t0 + tt < L - 1) ? bf2f(p.Z[(size_t)(row + 1) * 3 * D + blk * D + c]) : 0.f;
                zc[blk] = prev[blk] * w[blk][0] + cur[blk] * w[blk][1] + nxt[blk] * w[blk][2] + bs[blk]; prev[blk] = cur[blk]; cur[blk] = nxt[blk]; }
            p.X0Cb[(size_t)row * D + c] = f2bf(zc[0]); tl[lane * 66 + tt] = f2bf(zc[2] * zc[1]); } }
    WAVE_SYNC();
    WAVE_FOR { for (int ch = 0; ch < 64; ++ch) p.VT[(size_t)(c0 + ch) * M + row0 + lane] = tl[ch * 66 + lane]; }
    WAVE_SYNC();
} };
constexpr int CV_SPG_C = BATCH < 32 ? BATCH : 32, CV_TPG_C = 32 / CV_SPG_C, CV_NB_C = SEQ / 32, CV_NG_C = (BATCH / CV_SPG_C) * (CV_NB_C / CV_TPG_C);
constexpr int CV_SPG_L = DEC_BATCH < 32 ? DEC_BATCH : 32, CV_TPG_L = 32 / CV_SPG_L, CV_NB_L = DEC_SEQ / 32, CV_NG_L = (DEC_BATCH / CV_SPG_L) * (CV_NB_L / CV_TPG_L);
static_assert(CV_NG_C <= 8 && CV_NG_L <= 8 && CV_NB_C % CV_TPG_C == 0 && CV_NB_L % CV_TPG_L == 0 && D % 256 == 0, "conv grouping");
struct W_hconv2m { static constexpr int NITEMS = D * 16; static HD void run(const P& p, int j, int, int item, float*) {
    const int w8 = item & 7, rest = item >> 3, cls = (rest >> 8) & 1, c = (rest & 255) | ((rest >> 9) << 8);
    const int NG = cls ? CV_NG_L : CV_NG_C; if (w8 >= NG) return;
    const int SPG = cls ? CV_SPG_L : CV_SPG_C, TPG = cls ? CV_TPG_L : CV_TPG_C, NB = cls ? CV_NB_L : CV_NB_C, L = cls ? DEC_SEQ : SEQ;
    const int ntg = NB / TPG, sg = w8 / ntg, tg = w8 % ntg, dlo = tg * TPG - (NB - 1), dhi = tg * TPG + TPG - 1;
    const bf16* vt = p.VT + (size_t)c * M; const float skip = p.hy_skip[j * D + c];
    Acc16 acc[NL];
    WAVE_FOR { for (int r = 0; r < 16; ++r) acc[LI][r] = 0.f; }
    const int nIt = 2 * (dhi - dlo + 1);
    for (int i0 = 0; i0 < nIt; i0 += 8) {
        Frag8 fa8[8][NL], fb8[8][NL];
#pragma unroll
        for (int u = 0; u < 8; ++u) {
            WAVE_FOR { const int it = i0 + u, itc = it < nIt ? it : nIt - 1, dl = dlo + (itc >> 1), ks = itc & 1, q = 2 * dl - ks; const int r = lane & 31, h = lane >> 5, a = r >> 3, rho = r & 7;
                fa8[u][LI] = ld_frag8(p.TS + ts_off(cls, c, rho) + (8 * (h - a - 2 * q) + L));
                const int seq = sg * SPG + r / TPG, t1 = tg * TPG + r % TPG, s1 = t1 - dl; const int base = (cls ? MC + seq * DEC_SEQ : seq * SEQ);
                fb8[u][LI] = (it < nIt && s1 >= 0 && s1 < NB) ? ld_frag8(vt + base + 32 * s1 + 16 * ks + 8 * h) : zero_frag8(); } }
#pragma unroll
        for (int u = 0; u < 8; ++u) MFMA32(acc, fa8[u], fb8[u]);
    }
    WAVE_FOR { const int r = lane & 31, h = lane >> 5; const int seq = sg * SPG + r / TPG, t1 = tg * TPG + r % TPG; const int base = (cls ? MC + seq * DEC_SEQ : seq * SEQ) + 32 * t1;
        for (int rg = 0; rg < 4; ++rg) { const int tok = base + 8 * rg + 4 * h;
            for (int e = 0; e < 4; ++e) p.YT[(size_t)c * M + tok + e] = f2bf(acc[LI][4 * rg + e] + skip * bf2f(vt[tok + e])); } }
} };
struct W_hconv3t { static constexpr int NITEMS = (M / 64) * (D / 64); static HD void run(const P& p, int, int, int item, float* ldsf) {
    bf16* tl = (bf16*)ldsf; const int ct = item % (D / 64), rt = item / (D / 64), row0 = rt * 64, c0 = ct * 64;
    WAVE_FOR { for (int ch = 0; ch < 64; ++ch) tl[ch * 66 + lane] = p.YT[(size_t)(c0 + ch) * M + row0 + lane]; }
    WAVE_SYNC();
    WAVE_FOR { for (int tt = 0; tt < 64; ++tt) { const size_t o = (size_t)(row0 + tt) * D + c0 + lane; p.H[o] = f2bf(bf2f(p.X0Cb[o]) * bf2f(tl[lane * 66 + tt])); } }
    WAVE_SYNC();
} };

constexpr size_t VTT_C = (size_t)BATCH * NH * VD * SEQ, VTT_L = (size_t)DEC_BATCH * NH * VD * TMAX, VTT_ALL = VTT_C + VTT_L;
HD int kperm32(int k) { return 8 * ((k >> 2) & 3) + 4 * (k >> 4) + (k & 3); }
#ifdef HOST_EMU
static inline void gmax16_h(float* v) { for (int q = 0; q < 16; ++q) { float s = v[q]; for (int g = 1; g < 4; ++g) s = v[q + 16 * g] > s ? v[q + 16 * g] : s; for (int g = 0; g < 4; ++g) v[q + 16 * g] = s; } }
static inline void gsum16_h(float* v) { for (int q = 0; q < 16; ++q) { float s = 0.f; for (int g = 0; g < 4; ++g) s += v[q + 16 * g]; for (int g = 0; g < 4; ++g) v[q + 16 * g] = s; } }
#define gmax16(a) gmax16_h(a)
#define gsum16(a) gsum16_h(a)
#define SCHED_FENCE() do { } while (0)
#else
__device__ __forceinline__ float gmax16_d(float s) { auto a = __builtin_amdgcn_permlane16_swap(__float_as_uint(s), __float_as_uint(s), false, false); const unsigned a0 = a[0], a1 = a[1]; const float m = fmaxf(__uint_as_float(a0), __uint_as_float(a1));
    auto b = __builtin_amdgcn_permlane32_swap(__float_as_uint(m), __float_as_uint(m), false, false); const unsigned b0 = b[0], b1 = b[1]; return fmaxf(__uint_as_float(b0), __uint_as_float(b1)); }
__device__ __forceinline__ float gsum16_d(float s) { auto a = __builtin_amdgcn_permlane16_swap(__float_as_uint(s), __float_as_uint(s), false, false); const unsigned a0 = a[0], a1 = a[1]; const float m = __uint_as_float(a0) + __uint_as_float(a1);
    auto b = __builtin_amdgcn_permlane32_swap(__float_as_uint(m), __float_as_uint(m), false, false); const unsigned b0 = b[0], b1 = b[1]; return __uint_as_float(b0) + __uint_as_float(b1); }
#define SCHED_FENCE() __builtin_amdgcn_sched_barrier(0)
#define gmax16(a) ((a)[0] = gmax16_d((a)[0]))
#define gsum16(a) ((a)[0] = gsum16_d((a)[0]))
#endif
struct E_kcvt { static HD void run(const P& p, int, int, size_t i) { p.KC[i] = f2bf(p.cache_k[i]); } };
constexpr int VT_ITEMS_C = BATCH * NH * (SEQ / 64) * (VD / 64 > 0 ? VD / 64 : 1), VT_ITEMS_L = DEC_BATCH * NH * (TMAX / 64) * (VD / 64 > 0 ? VD / 64 : 1);
constexpr int VT_EW = VD < 64 ? VD : 64;
struct W_vtrans { static constexpr int NITEMS = VT_ITEMS_C + VT_ITEMS_L; static HD void run(const P& p, int, int, int item, float* ldsf) {
    bf16* tl = (bf16*)ldsf; const bool lat = item >= VT_ITEMS_C; int r = lat ? item - VT_ITEMS_C : item; const int T = lat ? TMAX : SEQ, net = VD / VT_EW, nkt = T / 64;
    const int et = r % net; r /= net; const int kt = r % nkt; r /= nkt; const int h = r % NH, b = r / NH, e0 = et * VT_EW, k0 = kt * 64;
    WAVE_FOR { if (lane < VT_EW) for (int kk = 0; kk < 64; ++kk) { const int key = k0 + kk; float v;
            if (lat && key < PAST) v = p.cache_v[(((size_t)b * NAT * PAST + key) * NH + h) * VD + e0 + lane];
            else v = bf2f(p.Z[(size_t)((lat ? MC + b * DEC_SEQ + key - PAST : b * SEQ + key)) * 3 * D + 2 * D + h * VD + e0 + lane]);
            tl[lane * 66 + 32 * (kk >> 5) + kperm32(kk & 31)] = f2bf(v); } }
    WAVE_SYNC();
    bf16* dst = p.VTT + (lat ? VTT_C + ((size_t)(b * NH + h) * VD) * TMAX : ((size_t)(b * NH + h) * VD) * SEQ);
    WAVE_FOR { for (int e = 0; e < VT_EW; ++e) dst[(size_t)(e0 + e) * T + k0 + lane] = tl[e * 66 + lane]; }
    WAVE_SYNC();
} };
constexpr int AT_NQC = SEQ / 16, AT_NQL = DEC_SEQ / 16, AT_ITEMS_C = BATCH * NH * AT_NQC, AT_ITEMS_L = DEC_BATCH * NH * AT_NQL;
constexpr int AT_KS = HDIM / 32 > 0 ? HDIM / 32 : 1, AT_ET = VD / 16;
static_assert(HDIM % 32 == 0 || HDIM == 16, "head dim");
struct W_attn2 { static constexpr int NITEMS = AT_ITEMS_C + AT_ITEMS_L; static HD void run(const P& p, int, int, int item, float*) {
    const bool lat = item >= AT_ITEMS_C; int r = lat ? item - AT_ITEMS_C : item; const int nq = lat ? AT_NQL : AT_NQC; const int qb = r % nq; r /= nq; const int h = r % NH, b = r / NH;
    const int T = lat ? TMAX : SEQ, seq0 = lat ? MC + b * DEC_SEQ : b * SEQ, row0 = seq0 + qb * 16;
    const bf16* vt = p.VTT + (lat ? VTT_C + ((size_t)(b * NH + h) * VD) * TMAX : ((size_t)(b * NH + h) * VD) * SEQ);
    const float scale = 1.0f / sqrtf((float)HDIM), lam_init = 0.8f - 0.6f * expf(-0.3f * (float)ATT_LAYER);
    float s01 = 0.f, s23 = 0.f; for (int d = 0; d < HDIM; ++d) { s01 += p.at_lam[d] * p.at_lam[HDIM + d]; s23 += p.at_lam[2 * HDIM + d] * p.at_lam[3 * HDIM + d]; }
    const float lam = expf(s01) - expf(s23) + lam_init;
    Frag8 fq[NL], fa[NL], pf[2][NL]; Acc4 oacc[2][AT_ET][NL], st[2][2][NL]; float mrow[2][NL], lrow[2][NL], tmx[2][NL];
    WAVE_FOR {
#pragma unroll
        for (int c = 0; c < 2; ++c) {
#pragma unroll
            for (int et = 0; et < AT_ET; ++et) for (int e = 0; e < 4; ++e) oacc[c][et][LI][e] = 0.f;
            mrow[c][LI] = -1.0e30f; lrow[c][LI] = 0.f; } }
    for (int k0 = 0; k0 < T; k0 += 32) {
#pragma unroll
        for (int c = 0; c < 2; ++c)
#pragma unroll
            for (int tau = 0; tau < 2; ++tau) { WAVE_FOR { for (int e = 0; e < 4; ++e) st[c][tau][LI][e] = 0.f; }
#pragma unroll
                for (int ks = 0; ks < AT_KS; ++ks) {
                    WAVE_FOR { const int kg = lane >> 4, key = k0 + 16 * tau + (lane & 15);
                        const bf16* kp = (lat && key < PAST) ? p.KC + (((size_t)b * NAT * PAST + key) * NH + h) * 2 * HDIM : p.Z + (size_t)(seq0 + key - (lat ? PAST : 0)) * 3 * D + D + h * 2 * HDIM;
                        if (HDIM >= 32 || kg < 2) { fa[LI] = ld_frag8(kp + c * HDIM + 32 * ks + 8 * kg); fq[LI] = ld_frag8(p.Z + (size_t)(row0 + (lane & 15)) * 3 * D + h * 2 * HDIM + c * HDIM + 32 * ks + 8 * kg); }
                        else { fa[LI] = zero_frag8(); fq[LI] = zero_frag8(); } }
                    MFMA16(st[c][tau], fa, fq); }
                SCHED_FENCE(); }
        WAVE_FOR {
#pragma unroll
            for (int c = 0; c < 2; ++c) { float mx = -1.0e30f;
#pragma unroll
                for (int tau = 0; tau < 2; ++tau) for (int e = 0; e < 4; ++e) { const float v = st[c][tau][LI][e] * scale; mx = v > mx ? v : mx; }
                tmx[c][LI] = mx; } }
        gmax16(tmx[0]); gmax16(tmx[1]);
        WAVE_FOR {
#pragma unroll
            for (int c = 0; c < 2; ++c) { const float mn = tmx[c][LI] > mrow[c][LI] ? tmx[c][LI] : mrow[c][LI], alpha = expf(mrow[c][LI] - mn); mrow[c][LI] = mn; float ps = 0.f;
#pragma unroll
                for (int tau = 0; tau < 2; ++tau) for (int e = 0; e < 4; ++e) { const float pv = expf(st[c][tau][LI][e] * scale - mn); ps += pv; pf[c][LI][4 * tau + e] = (short)f2bf(pv); }
                lrow[c][LI] = lrow[c][LI] * alpha + ps;
#pragma unroll
                for (int et = 0; et < AT_ET; ++et) for (int e = 0; e < 4; ++e) oacc[c][et][LI][e] *= alpha; } }
#pragma unroll
        for (int et = 0; et < AT_ET; ++et) {
            WAVE_FOR { fa[LI] = ld_frag8(vt + (size_t)(16 * et + (lane & 15)) * T + k0 + 8 * (lane >> 4)); }
            MFMA16(oacc[0][et], fa, pf[0]); MFMA16(oacc[1][et], fa, pf[1]); if ((et & 3) == 3) SCHED_FENCE(); }
    }
    gsum16(lrow[0]); gsum16(lrow[1]);
    float ssq[NL];
    WAVE_FOR { const float i0 = 1.0f / lrow[0][LI], i1 = lam / lrow[1][LI]; float s = 0.f;
#pragma unroll
        for (int et = 0; et < AT_ET; ++et) for (int e = 0; e < 4; ++e) { const float o = oacc[0][et][LI][e] * i0 - oacc[1][et][LI][e] * i1; oacc[0][et][LI][e] = o; s += o * o; }
        ssq[LI] = s; }
    gsum16(ssq);
    WAVE_FOR { const int q = lane & 15, kg = lane >> 4; const float rstd = rsq(ssq[LI] / (float)VD + NORM_EPS) * (1.0f - lam_init);
#pragma unroll
        for (int et = 0; et < AT_ET; ++et) for (int e = 0; e < 4; ++e) { const int ee = 16 * et + 4 * kg + e; p.H[(size_t)(row0 + q) * D + h * VD + ee] = f2bf(oacc[0][et][LI][e] * rstd * p.at_g_sub[ee]); } }
} };

constexpr size_t S5_BBT = (size_t)2 * SGS * 128 * SG, S5_CMT = (size_t)2 * SGS * SG * 128;
struct E_s5tab { static HD void run(const P& p, int, int, size_t i) {
    const int pp = (int)(i % SP); const size_t dg = i / SP;
    float lre = p.s5_lam_re[i]; lre = lre < -1e-4f ? lre : -1e-4f; const float lim = p.s5_lam_im[i], dt = expf(p.s5_log_dt[dg]);
    const float er = expf(lre * dt), br_ = er * cosf(lim * dt), bi_ = er * sinf(lim * dt); p.S5LB[2 * i] = br_; p.S5LB[2 * i + 1] = bi_;
    const float nr = br_ - 1.0f, ni = bi_, den = lre * lre + lim * lim, cfr = (nr * lre + ni * lim) / den, cfi = (ni * lre - nr * lim) / den;
    for (int h = 0; h < SG; ++h) { const float b_r = p.s5_b_re[i * SG + h], b_i = p.s5_b_im[i * SG + h];
        p.S5BB[(dg * 128 + pp) * SG + h] = f2bf(cfr * b_r - cfi * b_i); p.S5BB[(dg * 128 + 64 + pp) * SG + h] = f2bf(cfr * b_i + cfi * b_r);
        p.S5CM[(dg * SG + h) * 128 + 2 * pp] = f2bf(p.s5_c_re[(dg * SG + h) * SP + pp]); p.S5CM[(dg * SG + h) * 128 + 2 * pp + 1] = f2bf(-p.s5_c_im[(dg * SG + h) * SP + pp]); } } };
#ifdef HOST_EMU
static inline void swap32_h(Acc16* a, Acc16* b) { for (int r = 0; r < 16; ++r) for (int n = 0; n < 32; ++n) { const float t = a[32 + n][r]; a[32 + n][r] = b[n][r]; b[n][r] = t; } }
#define SWAP32(a, b) swap32_h(a, b)
#else
__device__ __forceinline__ void swap32_d(Acc16& a, Acc16& b) {
#pragma unroll
    for (int r = 0; r < 16; ++r) { const float x = a[r], y = b[r];
        auto v = __builtin_amdgcn_permlane32_swap(__float_as_uint(x), __float_as_uint(y), false, false); const unsigned v0 = v[0], v1 = v[1]; a[r] = __uint_as_float(v0); b[r] = __uint_as_float(v1); } }
#define SWAP32(a, b) swap32_d((a)[0], (b)[0])
#endif
constexpr int S5_ROWW = 68;
struct W_s5m { static constexpr int NITEMS = (BATCH + DEC_BATCH) * SGS * 2; static HD void run(const P& p, int, int, int item, float* ldsf) {
    const int dir = item & 1, g = (item >> 1) % SGS, sidx = (item >> 1) / SGS; const bool lat = sidx >= BATCH; const int b = lat ? sidx - BATCH : sidx;
    const int L = lat ? DEC_SEQ : SEQ, seq0 = lat ? MC + b * DEC_SEQ : b * SEQ; const size_t dg = (size_t)dir * SGS + g;
    unsigned* tl = (unsigned*)ldsf; float* Y = dir ? p.YB : p.YF;
    Frag8 fb[4][NL], fc[4][NL], fa[NL], fx[NL]; Acc16 bu[4][NL]; Acc4 yv[2][NL]; float lbr[NL], lbi[NL], xr[NL], xi[NL];
    WAVE_FOR { const int n = lane & 31, hh = lane >> 5, pp = n + 32 * hh;
#pragma unroll
        for (int q = 0; q < 4; ++q) { fb[q][LI] = ld_frag8(p.S5BB + (dg * 128 + 32 * q + n) * SG + 8 * hh); fc[q][LI] = ld_frag8(p.S5CM + (dg * SG + (lane & 15)) * 128 + 32 * q + 8 * (lane >> 4)); }
        lbr[LI] = p.S5LB[2 * (dg * SP + pp)]; lbi[LI] = p.S5LB[2 * (dg * SP + pp) + 1];
        if (lat) { const size_t si = (((size_t)b * NSS) * 2 + dir) * SGS * SP + (size_t)g * SP + pp; xr[LI] = p.st_re[si]; xi[LI] = p.st_im[si]; } else { xr[LI] = 0.f; xi[LI] = 0.f; } }
    WAVE_FOR { const int m = lane & 31, hh = lane >> 5, pos = 16 * ((m >> 2) & 1) + 4 * (m >> 3) + (m & 3), t = dir ? L - 1 - pos : pos; fa[LI] = ld_frag8(p.H + (size_t)(seq0 + t) * D + g * SG + 8 * hh); }
    for (int ch = 0; ch < L / 32; ++ch) {
        WAVE_FOR {
#pragma unroll
            for (int q = 0; q < 4; ++q) for (int r = 0; r < 16; ++r) bu[q][LI][r] = 0.f; }
#pragma unroll
        for (int q = 0; q < 4; ++q) MFMA32(bu[q], fa, fb[q]);
        if (ch + 1 < L / 32) { WAVE_FOR { const int m = lane & 31, hh = lane >> 5, pos = (ch + 1) * 32 + 16 * ((m >> 2) & 1) + 4 * (m >> 3) + (m & 3), t = dir ? L - 1 - pos : pos;
            fa[LI] = ld_frag8(p.H + (size_t)(seq0 + t) * D + g * SG + 8 * hh); } }
        SWAP32(bu[0], bu[1]); SWAP32(bu[2], bu[3]);
        WAVE_FOR { const int pp = (lane & 31) + 32 * (lane >> 5); float ar = xr[LI], ai = xi[LI]; const float cr_ = lbr[LI], ci_ = lbi[LI];
#pragma unroll
            for (int s = 0; s < 32; ++s) { const float ur = bu[s >> 4][LI][s & 15], ui = bu[2 + (s >> 4)][LI][s & 15];
                const float nr = cr_ * ar - ci_ * ai + ur, ni = cr_ * ai + ci_ * ar + ui; ar = nr; ai = ni;
                tl[s * S5_ROWW + pp] = pk2bf(nr, ni); }
            xr[LI] = ar; xi[LI] = ai; }
        WAVE_SYNC_LDS();
#pragma unroll
        for (int pt = 0; pt < 2; ++pt) { WAVE_FOR { for (int e = 0; e < 4; ++e) yv[pt][LI][e] = 0.f; }
#pragma unroll
            for (int ks = 0; ks < 4; ++ks) { WAVE_FOR { fx[LI] = ld_frag8((const bf16*)(tl + (16 * pt + (lane & 15)) * S5_ROWW) + 32 * ks + 8 * (lane >> 4)); }
                MFMA16(yv[pt], fc[ks], fx); } }
        WAVE_FOR { const int kg = lane >> 4;
#pragma unroll
            for (int pt = 0; pt < 2; ++pt) { const int pos = ch * 32 + 16 * pt + (lane & 15), t = dir ? L - 1 - pos : pos; float* yo = Y + (size_t)(seq0 + t) * D + g * SG + 4 * kg;
                for (int e = 0; e < 4; ++e) yo[e] = yv[pt][LI][e]; } }
        WAVE_SYNC_LDS();
    }
    if (!lat) { WAVE_FOR { const size_t so = (((size_t)b * NSS) * 2 + dir) * SGS * SP + (size_t)g * SP + (lane & 31) + 32 * (lane >> 5); p.out[OUT_SRE + so] = xr[LI]; p.out[OUT_SIM + so] = xi[LI]; } }
} };


#ifdef HOST_EMU
static inline void ld8f(const float* p, float* v) { for (int e = 0; e < 8; ++e) v[e] = p[e]; }
static inline void st8f(float* p, const float* v) { for (int e = 0; e < 8; ++e) p[e] = v[e]; }
static inline void ld8b(const bf16* p, float* v) { for (int e = 0; e < 8; ++e) v[e] = bf2f(p[e]); }
static inline void st8b(bf16* p, const float* v) { for (int e = 0; e < 8; ++e) p[e] = f2bf(v[e]); }
#else
__device__ __forceinline__ void ld8f(const float* p, float* v) { const float4 a = ((const float4*)p)[0], b = ((const float4*)p)[1]; v[0] = a.x; v[1] = a.y; v[2] = a.z; v[3] = a.w; v[4] = b.x; v[5] = b.y; v[6] = b.z; v[7] = b.w; }
__device__ __forceinline__ void st8f(float* p, const float* v) { ((float4*)p)[0] = make_float4(v[0], v[1], v[2], v[3]); ((float4*)p)[1] = make_float4(v[4], v[5], v[6], v[7]); }
__device__ __forceinline__ void ld8b(const bf16* p, float* v) { const uint4 a = *(const uint4*)p; v[0] = __uint_as_float(a.x << 16); v[1] = __uint_as_float(a.x & 0xffff0000u); v[2] = __uint_as_float(a.y << 16); v[3] = __uint_as_float(a.y & 0xffff0000u);
    v[4] = __uint_as_float(a.z << 16); v[5] = __uint_as_float(a.z & 0xffff0000u); v[6] = __uint_as_float(a.w << 16); v[7] = __uint_as_float(a.w & 0xffff0000u); }
__device__ __forceinline__ void st8b(bf16* p, const float* v) { uint4 o; o.x = pk2bf(v[0], v[1]); o.y = pk2bf(v[2], v[3]); o.z = pk2bf(v[4], v[5]); o.w = pk2bf(v[6], v[7]); *(uint4*)p = o; }
#endif
HD size_t mv_off(int l, int wh, int midx, int k) { return ((((size_t)l * 2 + wh) * NCND + midx) * 3 + k) * D; }
struct E_modvec { static HD void run(const P& p, int, int, size_t i) {
    const int c = (int)(i % D); size_t r = i / D; const int k = (int)(r % 3); r /= 3; const int midx = (int)(r % NCND); r /= NCND; const int wh = (int)(r % 2), l = (int)(r / 2);
    const float* mod = p.MOD + ((size_t)l * NCND + midx) * 6 * D; const float* g = p.g_norm + (size_t)l * 4 * D; float v;
    if (k == 0) v = mod[(wh ? 5 : 2) * D + c] * g[(wh ? 3 : 1) * D + c]; else if (k == 1) v = g[(wh ? 2 : 0) * D + c] * (1.0f + mod[(wh ? 4 : 1) * D + c]); else v = mod[(wh ? 3 : 0) * D + c];
    p.MV[i] = v; } };
constexpr int TH_K = (D + 511) / 512;
#define TH_ON(k) (512 * (k) + 8 * lane < D)
constexpr int TH_MODE_A = 0x100, TH_MODE_B = 0x200, TH_SRC_IN = 0x400;
struct W_thin2 { static constexpr int NITEMS = M; static HD void run(const P& p, int a0, int a1, int row, float*) {
    const int midx = row < MC ? 0 : 1 + (row - MC) / DEC_SEQ; const bool fin = a1 < 0, first = a0 < 0; const bool modeA = !first && (a0 & TH_MODE_A), modeB = !first && (a0 & TH_MODE_B); const int ps = first ? 0 : (a0 & 0xff);
    const bool srcin = first || (a0 & TH_SRC_IN);
    const float* xin = row < MC ? p.x_prompt + (size_t)row * D : p.x_sample + (size_t)(row - MC) * D; const bf16* xbin = p.XB + (size_t)row * D; float* xout = p.out + (size_t)row * D; bf16* xbout = p.XB + (size_t)row * D;
    float x[NL][TH_K * 8], ss[NL];
    WAVE_FOR {
#pragma unroll
        for (int k = 0; k < TH_K; ++k) { if (TH_ON(k)) { if (srcin) ld8f(xin + 512 * k + 8 * lane, &x[LI][8 * k]); else ld8b(xbin + 512 * k + 8 * lane, &x[LI][8 * k]); } else for (int e = 0; e < 8; ++e) x[LI][8 * k + e] = 0.f; } }
    if (modeB) { const float* gpa = p.MV + mv_off(ps >> 3, 0, midx, 0); const float rsa = p.RS[2 * (size_t)row];
        WAVE_FOR {
#pragma unroll
            for (int k = 0; k < TH_K; ++k) if (TH_ON(k)) { float g8[8], o8[8]; ld8f(gpa + 512 * k + 8 * lane, g8); ld8b(p.ObA + (size_t)row * D + 512 * k + 8 * lane, o8); for (int e = 0; e < 8; ++e) x[LI][8 * k + e] += g8[e] * (o8[e] * rsa); } } }
    if (!first) { const float* gp = p.MV + mv_off(ps >> 3, ps & 7, midx, 0); const bf16* ob = (modeA ? p.ObA : p.Ob) + (size_t)row * D; float o[NL][TH_K * 8];
        WAVE_FOR { float s = 0.f;
#pragma unroll
            for (int k = 0; k < TH_K; ++k) { if (TH_ON(k)) ld8b(ob + 512 * k + 8 * lane, &o[LI][8 * k]); else for (int e = 0; e < 8; ++e) o[LI][8 * k + e] = 0.f; for (int e = 0; e < 8; ++e) s += o[LI][8 * k + e] * o[LI][8 * k + e]; }
            ss[LI] = s; }
        wsum(ss);
        WAVE_FOR { const float rstd = rsq(ss[LI] / (float)D + NORM_EPS); if (modeA && lane == 0) p.RS[2 * (size_t)row] = rstd;
#pragma unroll
            for (int k = 0; k < TH_K; ++k) if (TH_ON(k)) { float g8[8]; ld8f(gp + 512 * k + 8 * lane, g8); for (int e = 0; e < 8; ++e) x[LI][8 * k + e] += g8[e] * (o[LI][8 * k + e] * rstd); } } }
    if (!first && !modeA) { WAVE_FOR {
#pragma unroll
        for (int k = 0; k < TH_K; ++k) if (TH_ON(k)) { if (fin) st8f(xout + 512 * k + 8 * lane, &x[LI][8 * k]); else st8b(xbout + 512 * k + 8 * lane, &x[LI][8 * k]); } } }
    if (!fin) { const float* av = p.MV + mv_off(a1 >> 3, a1 & 7, midx, 1); const float* bv = av + D;
        WAVE_FOR { float s = 0.f;
#pragma unroll
            for (int k = 0; k < TH_K * 8; ++k) s += x[LI][k] * x[LI][k];
            ss[LI] = s; }
        wsum(ss);
        WAVE_FOR { const float rstd = rsq(ss[LI] / (float)D + NORM_EPS);
#pragma unroll
            for (int k = 0; k < TH_K; ++k) if (TH_ON(k)) { float a8[8], b8[8], h8[8]; ld8f(av + 512 * k + 8 * lane, a8); ld8f(bv + 512 * k + 8 * lane, b8); for (int e = 0; e < 8; ++e) h8[e] = x[LI][8 * k + e] * rstd * a8[e] + b8[e];
                st8b(p.H + (size_t)row * D + 512 * k + 8 * lane, h8); } } }
} };
constexpr int F3_NCH = LMAX / 32;
struct E_filt3c { static HD void run(const P& p, int, int, size_t i) {
    const int col = (int)(i % (2 * D)), ch = (int)((i / (2 * D)) % F3_NCH), j = (int)(i / ((size_t)2 * D * F3_NCH)), d = col % D, dir = col / D;
    float w[FW];
#pragma unroll
    for (int k = 0; k < FW; ++k) w[k] = p.hy_f_w3[((size_t)j * FW + k) * 2 * D + col];
    const float dcy = expf(p.hy_log_alpha[j * D + d]); float ps = 0.f;
    for (int tt = 0; tt < 32; ++tt) { const int t = ch * 32 + tt; const float* h2 = p.H2 + ((size_t)j * LMAX + t) * FW; float acc = 0.f;
#pragma unroll
        for (int k = 0; k < FW; ++k) acc += h2[k] * w[k];
        const float v = acc * expf(-dcy * (float)t); p.HRAW[((size_t)j * LMAX + t) * 2 * D + col] = v; if (!(dir == 1 && t == 0)) ps += fabsf(v); }
    p.PS[i] = ps; } };
constexpr int FK_NC0 = SEQ / 32, FK_NC1 = DEC_SEQ / 32;
struct E_fk2 { static HD void run(const P& p, int, int, size_t i) {
    const int d = (int)(i % D); int r = (int)((i / D) % (FK_NC0 + FK_NC1)); const int j = (int)(i / ((size_t)D * (FK_NC0 + FK_NC1))); const int cls = r >= FK_NC0 ? 1 : 0; const int ch = cls ? r - FK_NC0 : r, L = cls ? DEC_SEQ : SEQ;
    float s = 0.f; for (int c2 = 0; c2 < L / 32; ++c2) s += p.PS[((size_t)j * F3_NCH + c2) * 2 * D + d] + p.PS[((size_t)j * F3_NCH + c2) * 2 * D + D + d];
    const float inv = 1.0f / (s + 1e-6f); const float* h = p.HRAW + (size_t)j * LMAX * 2 * D; bf16* kt = p.KT + kt_off(j, cls, d);
    if (ch == 0) p.KINV[((size_t)j * 2 + cls) * D + d] = inv;
    for (int tt = 0; tt < 32; ++tt) { const int t = ch * 32 + tt, tb = t + 1; kt[L + t] = f2bf(h[(size_t)t * 2 * D + d] * inv); kt[L - tb] = tb < L ? f2bf(h[(size_t)tb * 2 * D + D + d] * inv) : (bf16)0; } } };
struct E_kcvt8 { static HD void run(const P& p, int, int, size_t i) { float v[8]; ld8f(p.cache_k + 8 * i, v); st8b(p.KC + 8 * i, v); } };
struct E_s5comb8 { static HD void run(const P& p, int, int, size_t i) { const int c = (int)((8 * i) % D); float u[8], yf[8], yb[8], dd[8]; ld8b(p.H + 8 * i, u); ld8f(p.YF + 8 * i, yf); ld8f(p.YB + 8 * i, yb); ld8f(p.s5_d + c, dd);
    for (int e = 0; e < 8; ++e) u[e] = gelu_tanh_f(dd[e] * u[e] + yf[e] + yb[e]); st8b(p.H + 8 * i, u); } };

#ifdef HOST_EMU
static inline void ld4b(const bf16* p, float* v) { for (int e = 0; e < 4; ++e) v[e] = bf2f(p[e]); }
static inline void ld4f(const float* p, float* v) { for (int e = 0; e < 4; ++e) v[e] = p[e]; }
static inline void st4f(float* p, const float* v) { for (int e = 0; e < 4; ++e) p[e] = v[e]; }
#else
__device__ __forceinline__ void ld4b(const bf16* p, float* v) { const uint2 a = *(const uint2*)p; v[0] = __uint_as_float(a.x << 16); v[1] = __uint_as_float(a.x & 0xffff0000u); v[2] = __uint_as_float(a.y << 16); v[3] = __uint_as_float(a.y & 0xffff0000u); }
__device__ __forceinline__ void ld4f(const float* p, float* v) { const float4 a = *(const float4*)p; v[0] = a.x; v[1] = a.y; v[2] = a.z; v[3] = a.w; }
__device__ __forceinline__ void st4f(float* p, const float* v) { *(float4*)p = make_float4(v[0], v[1], v[2], v[3]); }
#endif
#ifdef HOST_EMU
static inline void ld2b(const bf16* p, float* v) { v[0] = bf2f(p[0]); v[1] = bf2f(p[1]); }
static inline void ld2f(const float* p, float* v) { v[0] = p[0]; v[1] = p[1]; }
static inline void st2b(bf16* p, const float* v) { p[0] = f2bf(v[0]); p[1] = f2bf(v[1]); }
#else
__device__ __forceinline__ void ld2b(const bf16* p, float* v) { const unsigned a = *(const unsigned*)p; v[0] = __uint_as_float(a << 16); v[1] = __uint_as_float(a & 0xffff0000u); }
__device__ __forceinline__ void ld2f(const float* p, float* v) { const float2 a = *(const float2*)p; v[0] = a.x; v[1] = a.y; }
__device__ __forceinline__ void st2b(bf16* p, const float* v) { *(unsigned*)p = pk2bf(v[0], v[1]); }
#endif
struct W_hconv1v { static constexpr int NITEMS = (M / 64) * (D / 128); static HD void run(const P& p, int j, int, int item, float*) {
    const int cb = item % (D / 128), rt = item / (D / 128), row0 = rt * 64; int seq0, t0, L, cls, b; row_info(row0, seq0, t0, L, cls, b);
    WAVE_FOR { const int c = cb * 128 + 2 * lane; float w[3][3][2], bs[3][2], prev[3][2], cur[3][2];
#pragma unroll
        for (int blk = 0; blk < 3; ++blk) { const float* ws = p.hy_w_short + (size_t)j * 9 * D + blk * D + c; ld2f(ws, w[blk][0]); ld2f(ws + 3 * D, w[blk][1]); ld2f(ws + 6 * D, w[blk][2]); ld2f(p.hy_b_short + (size_t)j * 3 * D + blk * D + c, bs[blk]);
            if (t0 > 0) ld2b(p.Z + (size_t)(row0 - 1) * 3 * D + blk * D + c, prev[blk]); else { prev[blk][0] = 0.f; prev[blk][1] = 0.f; }
            ld2b(p.Z + (size_t)row0 * 3 * D + blk * D + c, cur[blk]); }
        for (int tb = 0; tb < 8; ++tb) { float zn[8][3][2], vv[2][8];
#pragma unroll
            for (int u = 0; u < 8; ++u) { const int tt = 8 * tb + u;
#pragma unroll
                for (int blk = 0; blk < 3; ++blk) { if (t0 + tt < L - 1) ld2b(p.Z + (size_t)(row0 + tt + 1) * 3 * D + blk * D + c, zn[u][blk]); else { zn[u][blk][0] = 0.f; zn[u][blk][1] = 0.f; } } }
#pragma unroll
            for (int u = 0; u < 8; ++u) { float zc[3][2];
#pragma unroll
                for (int blk = 0; blk < 3; ++blk) for (int e = 0; e < 2; ++e) { zc[blk][e] = prev[blk][e] * w[blk][0][e] + cur[blk][e] * w[blk][1][e] + zn[u][blk][e] * w[blk][2][e] + bs[blk][e]; prev[blk][e] = cur[blk][e]; cur[blk][e] = zn[u][blk][e]; }
                st2b(p.X0Cb + (size_t)(row0 + 8 * tb + u) * D + c, zc[0]);
                for (int e = 0; e < 2; ++e) vv[e][u] = zc[2][e] * zc[1][e]; }
#pragma unroll
            for (int e = 0; e < 2; ++e) st8b(p.VT + (size_t)(c + e) * M + row0 + 8 * tb, vv[e]); } }
} };
struct W_hconv3v { static constexpr int NITEMS = (M / 64) * (D / 256); static HD void run(const P& p, int, int, int item, float*) {
    const int cb = item % (D / 256), rt = item / (D / 256), row0 = rt * 64;
    WAVE_FOR { const int c = cb * 256 + 4 * lane;
        for (int tb = 0; tb < 8; ++tb) { float y[4][8], x0[8][4];
#pragma unroll
            for (int e = 0; e < 4; ++e) ld8b(p.YT + (size_t)(c + e) * M + row0 + 8 * tb, y[e]);
#pragma unroll
            for (int u = 0; u < 8; ++u) ld4b(p.X0Cb + (size_t)(row0 + 8 * tb + u) * D + c, x0[u]);
#pragma unroll
            for (int u = 0; u < 8; ++u) { float o4[4]; for (int e = 0; e < 4; ++e) o4[e] = x0[u][e] * y[e][u]; st4b(p.H + (size_t)(row0 + 8 * tb + u) * D + c, o4); } } }
} };
struct W_hconv3x { static constexpr int NITEMS = (M / 64) * (D / 256); static HD void run(const P& p, int j, int, int item, float*) {
    const int cb = item % (D / 256), rt = item / (D / 256), row0 = rt * 64; int seq0, t0, L, cls, b; row_info(row0, seq0, t0, L, cls, b);
    WAVE_FOR { const int c = cb * 256 + 4 * lane; float w[3][4], bs[4], prev[4], cur[4]; const float* ws = p.hy_w_short + (size_t)j * 9 * D + c;
        ld4f(ws, w[0]); ld4f(ws + 3 * D, w[1]); ld4f(ws + 6 * D, w[2]); ld4f(p.hy_b_short + (size_t)j * 3 * D + c, bs);
        if (t0 > 0) ld4b(p.Z0 + (size_t)(row0 - 1) * D + c, prev); else for (int e = 0; e < 4; ++e) prev[e] = 0.f;
        ld4b(p.Z0 + (size_t)row0 * D + c, cur);
        for (int tb = 0; tb < 8; ++tb) { float y[4][8], zn[8][4];
#pragma unroll
            for (int e = 0; e < 4; ++e) ld8b(p.YT + (size_t)(c + e) * M + row0 + 8 * tb, y[e]);
#pragma unroll
            for (int u = 0; u < 8; ++u) { if (t0 + 8 * tb + u < L - 1) ld4b(p.Z0 + (size_t)(row0 + 8 * tb + u + 1) * D + c, zn[u]); else for (int e = 0; e < 4; ++e) zn[u][e] = 0.f; }
#pragma unroll
            for (int u = 0; u < 8; ++u) { float o4[4]; for (int e = 0; e < 4; ++e) { const float x0 = prev[e] * w[0][e] + cur[e] * w[1][e] + zn[u][e] * w[2][e] + bs[e]; prev[e] = cur[e]; cur[e] = zn[u][e]; o4[e] = x0 * y[e][u]; }
                st4b(p.H + (size_t)(row0 + 8 * tb + u) * D + c, o4); } } }
} };
constexpr int V3_ITEMS_C = BATCH * NH * (SEQ / 32), V3_ITEMS_L = DEC_BATCH * NH * (TMAX / 32);
struct W_vtrans3 { static constexpr int NITEMS = V3_ITEMS_C + V3_ITEMS_L; static HD void run(const P& p, int, int, int item, float*) {
    const bool lat = item >= V3_ITEMS_C; int r = lat ? item - V3_ITEMS_C : item; const int T = lat ? TMAX : SEQ, nkb = T / 32; const int kb = r % nkb; r /= nkb; const int h = r % NH, b = r / NH, k0 = kb * 32;
    bf16* dst = p.VTT + (lat ? VTT_C + ((size_t)(b * NH + h) * VD) * TMAX : ((size_t)(b * NH + h) * VD) * SEQ);
    WAVE_FOR { if (4 * lane < VD) { const int e0 = 4 * lane; float v[32][4];
#pragma unroll
            for (int kk = 0; kk < 32; ++kk) { const int key = k0 + kk;
                if (lat && key < PAST) ld4f(p.cache_v + (((size_t)b * NAT * PAST + key) * NH + h) * VD + e0, v[kk]);
                else ld4b(p.Z + (size_t)((lat ? MC + b * DEC_SEQ + key - PAST : b * SEQ + key)) * 3 * D + 2 * D + h * VD + e0, v[kk]); }
#pragma unroll
            for (int e = 0; e < 4; ++e)
#pragma unroll
                for (int kg = 0; kg < 4; ++kg) { float o8[8]; for (int jx = 0; jx < 8; ++jx) o8[jx] = v[16 * (jx >> 2) + 4 * kg + (jx & 3)][e]; st8b(dst + (size_t)(e0 + e) * T + k0 + 8 * kg, o8); } } }
} };

struct W_vtransc { static constexpr int NITEMS = DEC_BATCH * NH * (PAST / 32); static HD void run(const P& p, int, int, int item, float*) {
    int r = item; const int kb = r % (PAST / 32); r /= (PAST / 32); const int h = r % NH, b = r / NH, k0 = kb * 32;
    bf16* dst = p.VTT + VTT_C + ((size_t)(b * NH + h) * VD) * TMAX;
    WAVE_FOR { if (4 * lane < VD) { const int e0 = 4 * lane; float v[32][4];
#pragma unroll
            for (int kk = 0; kk < 32; ++kk) ld4f(p.cache_v + (((size_t)b * NAT * PAST + k0 + kk) * NH + h) * VD + e0, v[kk]);
#pragma unroll
            for (int e = 0; e < 4; ++e)
#pragma unroll
                for (int kg = 0; kg < 4; ++kg) { float o8[8]; for (int jx = 0; jx < 8; ++jx) o8[jx] = v[16 * (jx >> 2) + 4 * kg + (jx & 3)][e]; st8b(dst + (size_t)(e0 + e) * TMAX + k0 + 8 * kg, o8); } } }
} };
struct W_hconv3y { static constexpr int NITEMS = (M / 64) * (D / 64); static HD void run(const P& p, int j, int, int item, float*) {
    const int cb = item % (D / 64), rt = item / (D / 64), row0 = rt * 64; int seq0, t0, L, cls, b; row_info(row0, seq0, t0, L, cls, b);
    WAVE_FOR { const int g = lane >> 3, tg = lane & 7, c = cb * 64 + 8 * g, tk0 = 8 * tg; float w[3][8], bs[8], y[8][8], z[10][8]; const float* ws = p.hy_w_short + (size_t)j * 9 * D + c;
        ld8f(ws, w[0]); ld8f(ws + 3 * D, w[1]); ld8f(ws + 6 * D, w[2]); ld8f(p.hy_b_short + (size_t)j * 3 * D + c, bs);
#pragma unroll
        for (int i = 0; i < 8; ++i) ld8b(p.YT + (size_t)(c + i) * M + row0 + tk0, y[i]);
#pragma unroll
        for (int u = 0; u < 10; ++u) { const int tl = t0 + tk0 + u - 1;
            if (tl >= 0 && tl < L) ld8b(p.Z0 + (size_t)(row0 + tk0 + u - 1) * D + c, z[u]); else for (int e = 0; e < 8; ++e) z[u][e] = 0.f; }
#pragma unroll
        for (int u = 0; u < 8; ++u) { float o8[8]; for (int e = 0; e < 8; ++e) o8[e] = (z[u][e] * w[0][e] + z[u + 1][e] * w[1][e] + z[u + 2][e] * w[2][e] + bs[e]) * y[e][u];
            st8b(p.H + (size_t)(row0 + tk0 + u) * D + c, o8); } }
} };

struct E_taps8 { static HD void run(const P& p, int j, int, size_t i) {
    size_t e0 = i * 8; const int cls = e0 >= TS_C ? 1 : 0; if (cls) e0 -= TS_C; const int L = cls ? DEC_SEQ : SEQ;
    const int idx0 = (int)(e0 % (2 * L)), rho = (int)((e0 / (2 * L)) % 8), c = (int)(e0 / ((size_t)2 * L * 8));
    const bf16* kt = p.KT + kt_off(j, cls, c); Frag8 f;
#pragma unroll
    for (int e = 0; e < 8; ++e) { const int jt = rho - (idx0 + e - L); f[e] = (jt > -L && jt < L) ? kt[jt + L] : (bf16)0; }
    st_frag8(p.TS + ts_off(cls, c, rho) + idx0, f); } };
constexpr size_t RT_LAM = (size_t)DEC_SEQ * 2 * QD * 2;
struct E_ropetab { static HD void run(const P& p, int, int, size_t i) { const int k = (int)(i % (2 * QD)), t = (int)(i / (2 * QD)), ii = k % QD; const float pos = (float)(k < QD ? t / GRID_W : t % GRID_W);
    if (i == 0) { float s01 = 0.f, s23 = 0.f; for (int d = 0; d < HDIM; ++d) { s01 += p.at_lam[d] * p.at_lam[HDIM + d]; s23 += p.at_lam[2 * HDIM + d] * p.at_lam[3 * HDIM + d]; }
        p.RT[RT_LAM] = expf(s01) - expf(s23) + (0.8f - 0.6f * expf(-0.3f * (float)ATT_LAYER)); }
    const float inv = powf(10000.0f, -(float)(2 * ii) / (float)(HDIM / 2)), ang = pos * inv; p.RT[2 * i] = cosf(ang); p.RT[2 * i + 1] = sinf(ang); } };
constexpr int RV = QD % 8 == 0 ? 8 : 4;
static_assert(QD % RV == 0, "rope vector width");
struct E_ropev { static HD void run(const P& p, int, int, size_t i) {
    size_t r = i; const int e = (int)(r % (2 * QD / RV)) * RV; r /= 2 * QD / RV; const int comp = (int)(r % 2); r /= 2; const int h = (int)(r % NH); r /= NH; const int which = (int)(r % 2); r /= 2; const int lrow = (int)r;
    const int grp = e / QD, ii0 = e % QD, t = lrow % DEC_SEQ, gr = t / GRID_W, gc = t % GRID_W; const float pos = (float)(grp == 0 ? gr : gc);
    bf16* z = p.Z + (size_t)(MC + lrow) * 3 * D + which * D + h * 2 * HDIM + comp * HDIM + grp * 2 * QD + ii0;
    float a[8], bb[8], oa[8], ob[8];
    if (RV == 8) { ld8b(z, a); ld8b(z + QD, bb); } else { ld4b(z, a); ld4b(z + QD, bb); }
#pragma unroll
    for (int k = 0; k < RV; ++k) { const float inv = powf(10000.0f, -(float)(2 * (ii0 + k)) / (float)(HDIM / 2)), ang = pos * inv, cs = cosf(ang), sn = sinf(ang); oa[k] = a[k] * cs - bb[k] * sn; ob[k] = bb[k] * cs + a[k] * sn; }
    if (RV == 8) { st8b(z, oa); st8b(z + QD, ob); } else { st4b(z, oa); st4b(z + QD, ob); } } };
constexpr int MOD_KS = 8;
struct E_modp { static HD void run(const P& p, int, int, size_t i) { body(p, p.SCOND, i); }
  static HD void body(const P& p, const float* sc, size_t i) {
    const int n4 = (int)(i % (6 * D / 4)); size_t r0 = i / (6 * D / 4); const int ks = (int)(r0 % MOD_KS), l = (int)(r0 / MOD_KS), kb = ks * (D / MOD_KS);
    float acc[NCND][4];
#pragma unroll
    for (int r = 0; r < NCND; ++r) for (int e = 0; e < 4; ++e) acc[r][e] = 0.f;
    const float* w = p.w_mod + ((size_t)l * D + kb) * 6 * D + 4 * n4;
    for (int k = 0; k < D / MOD_KS; ++k) { float w4[4]; ld4f(w + (size_t)k * 6 * D, w4);
#pragma unroll
        for (int r = 0; r < NCND; ++r) { const float s = sc[(size_t)r * D + kb + k]; for (int e = 0; e < 4; ++e) acc[r][e] += s * w4[e]; } }
#pragma unroll
    for (int r = 0; r < NCND; ++r) { float* o = p.PM + (((size_t)ks * DEPTH + l) * NCND + r) * 6 * D + 4 * n4; for (int e = 0; e < 4; ++e) o[e] = acc[r][e]; } } };
HD float mod_at(const P& p, int l, int midx, int k, int c) { const size_t o = ((size_t)l * NCND + midx) * 6 * D + (size_t)k * D + c; float s = p.b_mod[(size_t)l * 6 * D + (size_t)k * D + c];
    for (int ks = 0; ks < MOD_KS; ++ks) s += p.PM[(size_t)ks * DEPTH * NCND * 6 * D + o]; return s; }
struct E_modvec2 { static HD void run(const P& p, int, int, size_t i) {
    const int c = (int)(i % D); size_t r = i / D; const int k = (int)(r % 3); r /= 3; const int midx = (int)(r % NCND); r /= NCND; const int wh = (int)(r % 2), l = (int)(r / 2);
    const float* g = p.g_norm + (size_t)l * 4 * D; float v;
    if (k == 0) v = mod_at(p, l, midx, wh ? 5 : 2, c) * g[(wh ? 3 : 1) * D + c]; else if (k == 1) v = g[(wh ? 2 : 0) * D + c] * (1.0f + mod_at(p, l, midx, wh ? 4 : 1, c)); else v = mod_at(p, l, midx, wh ? 3 : 0, c);
    p.MV[i] = v; } };

#ifdef HOST_EMU
#define BLOCK_WAVES for (int wv = 0; wv < 8; ++wv)
#define WI wv
#define NW 8
#define BLOCK_SYNC() do { } while (0)
#define BTID (wv * 64 + lane)
static inline bool wany_h(const int* f) { for (int l = 0; l < 64; ++l) if (f[l]) return true; return false; }
#define WANY(f) wany_h(f)
#define EXP2F(x) exp2f(x)
#else
#define BLOCK_WAVES for (int wv = (int)__builtin_amdgcn_readfirstlane(threadIdx.x >> 6), _ow = 1; _ow; _ow = 0)
#define WI 0
#define NW 1
#define BLOCK_SYNC() do { asm volatile("s_waitcnt lgkmcnt(0)" ::: "memory"); __builtin_amdgcn_s_barrier(); asm volatile("" ::: "memory"); } while (0)
#define BTID ((int)threadIdx.x)
#define WANY(f) (__any((f)[0]) != 0)
#define EXP2F(x) __builtin_amdgcn_exp2f(x)
#endif
constexpr int BA_QB = 128, BA_NQC = SEQ / BA_QB, BA_NQL = DEC_SEQ / BA_QB, BA_ITEMS_C = BATCH * NH * BA_NQC, BA_ITEMS_L = DEC_BATCH * NH * BA_NQL;
constexpr int BA_KROW = 2 * HDIM, BA_VROW = 32;
constexpr int BA_KSW = (2 * HDIM / 8 >= 16) ? 15 : (2 * HDIM / 8 - 1);
#define BA_VSW(row) (((row) & 8) ? 3 : 0)
constexpr int BA_KT = 32 * BA_KROW, BA_VT = VD * BA_VROW, BA_STAGE = BA_KT + BA_VT;
constexpr int BA_KCH = 32 * (2 * HDIM / 8), BA_VCH = VD * 4;
constexpr int BA_KPT = (BA_KCH + 511) / 512, BA_VPT = (BA_VCH + 511) / 512;
constexpr int BA_QOFF = 2 * BA_STAGE, BA_QW = 16 * BA_KROW;
static_assert((BA_QOFF + 8 * BA_QW) * 2 <= 146944, "attention LDS");
struct B_attn { static constexpr int NITEMS = BA_ITEMS_C + BA_ITEMS_L; static HD void run(const P& p, int, int, int item, float* ldsf) {
    bf16* lds = (bf16*)ldsf;
    const bool lat = item >= BA_ITEMS_C; int r = lat ? item - BA_ITEMS_C : item; const int nq = lat ? BA_NQL : BA_NQC; int qb = r % nq, gi = r / nq;
    if ((lat ? BA_ITEMS_L : BA_ITEMS_C) % 256 == 0 && 32 % nq == 0) { const int wg = r % 256, rnd = r / 256, x = wg % 8, slot = wg / 8, li = rnd * 32 + slot; gi = x + 8 * (li / nq); qb = li % nq; }
    const int h = gi % NH, b = gi / NH;
    const int T = lat ? TMAX : SEQ, seq0 = lat ? MC + b * DEC_SEQ : b * SEQ, nst = T / 32;
    const bf16* vt = p.VTT + (lat ? VTT_C + ((size_t)(b * NH + h) * VD) * TMAX : ((size_t)(b * NH + h) * VD) * SEQ);
    const float scale = 1.4426950408889634f / sqrtf((float)HDIM), lam_init = 0.8f - 0.6f * expf(-0.3f * (float)ATT_LAYER);
    const float lam = p.RT[RT_LAM];
    Frag8 fq[2][NW][NL], fr[4][NW][NL], pf[2][NW][NL], pk[BA_KPT][NW][NL], pv[BA_VPT][NW][NL]; Acc4 oacc[2][AT_ET][NW][NL], st[2][2][NW][NL]; float mrow[2][NW][NL], lrow[2][NW][NL], tmx[2][NW][NL], alp[2][NW][NL]; int rfl[NW][NL];
    constexpr int CPR = 2 * HDIM / 8, KRJ = 512 / CPR;
    static_assert(512 % CPR == 0 && KRJ % (BA_KSW + 1) == 0 && (BA_KSW & (BA_KSW + 1)) == 0, "key-row chunks");
    int okc[NW][NL], okz[NW][NL], olk[NW][NL], ogv[NW][NL], olv[NW][NL];
    BLOCK_WAVES { WAVE_FOR { const int kr = BTID / CPR, part = BTID % CPR; okc[WI][LI] = kr * (NH * 2 * HDIM) + 8 * part; okz[WI][LI] = kr * (3 * D) + 8 * part; olk[WI][LI] = kr * BA_KROW + 8 * (part ^ (kr & BA_KSW));
        ogv[WI][LI] = (BTID / 4) * T + 8 * (BTID % 4); olv[WI][LI] = (BTID / 4) * BA_VROW + 8 * ((BTID % 4) ^ BA_VSW(BTID / 4)); } }
    int ak[AT_KS][NW][NL], aq[AT_KS][NW][NL], av[NW][NL];
    BLOCK_WAVES { WAVE_FOR { const int rr = lane & 15, kg = lane >> 4;
#pragma unroll
        for (int ks = 0; ks < AT_KS; ++ks) { ak[ks][WI][LI] = rr * BA_KROW + 8 * ((4 * ks + kg) ^ (rr & BA_KSW)); aq[ks][WI][LI] = BA_QOFF + wv * BA_QW + ak[ks][WI][LI]; }
        av[WI][LI] = rr * BA_VROW + 8 * (kg ^ BA_VSW(lane)); } }
#define BA_FETCH(s) do { const int k0 = (s) * 32; const bool cached = lat && k0 < PAST;            \
        const bf16* kb = cached ? p.KC + (((size_t)b * NAT * PAST + k0) * NH + h) * 2 * HDIM : p.Z + (size_t)(seq0 + k0 - (lat ? PAST : 0)) * 3 * D + D + h * 2 * HDIM; const bf16* vb = vt + k0; \
        BLOCK_WAVES { WAVE_FOR { \
        _Pragma("unroll") for (int j = 0; j < BA_KPT; ++j) { if (BTID + 512 * j < BA_KCH) pk[j][WI][LI] = ld_frag8(kb + (cached ? okc[WI][LI] + j * KRJ * (NH * 2 * HDIM) : okz[WI][LI] + j * KRJ * (3 * D))); } \
        _Pragma("unroll") for (int j = 0; j < BA_VPT; ++j) { if (BTID + 512 * j < BA_VCH) pv[j][WI][LI] = ld_frag8(vb + ogv[WI][LI] + j * 128 * T); } } } } while (0);
#define BA_COMMIT(buf) BLOCK_WAVES { WAVE_FOR { bf16* kl = lds + (buf) * BA_STAGE; bf16* vl = kl + BA_KT; \
        _Pragma("unroll") for (int j = 0; j < BA_KPT; ++j) { if (BTID + 512 * j < BA_KCH) st_frag8(kl + olk[WI][LI] + j * KRJ * BA_KROW, pk[j][WI][LI]); } \
        _Pragma("unroll") for (int j = 0; j < BA_VPT; ++j) { if (BTID + 512 * j < BA_VCH) st_frag8(vl + olv[WI][LI] + j * 128 * BA_VROW, pv[j][WI][LI]); } } }
    constexpr float BA_LAZY = 8.0f;
    BA_FETCH(0)
    BLOCK_WAVES { WAVE_FOR {
#pragma unroll
        for (int c = 0; c < 2; ++c) {
#pragma unroll
            for (int et = 0; et < AT_ET; ++et) for (int e = 0; e < 4; ++e) oacc[c][et][WI][LI][e] = 0.f;
            mrow[c][WI][LI] = -1.0e30f; lrow[c][WI][LI] = 0.f; } } }
    BLOCK_SYNC();
    BLOCK_WAVES { WAVE_FOR { const int row0 = seq0 + qb * BA_QB + 16 * wv; bf16* ql = lds + BA_QOFF + wv * BA_QW;
        for (int ci = lane; ci < 16 * (2 * HDIM / 8); ci += 64) { const int rr = ci / (2 * HDIM / 8), part = ci % (2 * HDIM / 8); float q8[8]; ld8b(p.Z + (size_t)(row0 + rr) * 3 * D + h * 2 * HDIM + 8 * part, q8); for (int e = 0; e < 8; ++e) q8[e] *= scale; st_frag8(ql + rr * BA_KROW + 8 * (part ^ (rr & BA_KSW)), pack8(q8)); } } }
    BA_COMMIT(0)
    BLOCK_SYNC();
    for (int s = 0; s < nst; ++s) {
        if (s + 1 < nst) { BA_FETCH(s + 1) }
        BLOCK_WAVES {
            const bf16* kl = lds + (s & 1) * BA_STAGE; const bf16* vl = kl + BA_KT;
#define BA_KADDR(i) ((HDIM / 8 > BA_KSW) ? kl + (16 * ((i) & 1)) * BA_KROW + ((i) / (2 * AT_KS)) * HDIM + ak[((i) >> 1) % AT_KS][WI][LI] \
        : kl + (16 * ((i) & 1) + (lane & 15)) * BA_KROW + 8 * (((((i) / (2 * AT_KS)) * (HDIM / 8)) + 4 * (((i) >> 1) % AT_KS) + (lane >> 4)) ^ (lane & BA_KSW)))
#define BA_QADDR(j) ((HDIM / 8 > BA_KSW) ? lds + ((j) / AT_KS) * HDIM + aq[(j) % AT_KS][WI][LI] \
        : lds + BA_QOFF + wv * BA_QW + (lane & 15) * BA_KROW + 8 * (((((j) / AT_KS) * (HDIM / 8)) + 4 * ((j) % AT_KS) + (lane >> 4)) ^ (lane & BA_KSW)))
#define BA_VADDR(et) (vl + 16 * (et) * BA_VROW + av[WI][LI])
            WAVE_FOR { const bool on = HDIM >= 32 || (lane >> 4) < 2;
#pragma unroll
                for (int c = 0; c < 2; ++c) for (int e = 0; e < 4; ++e) { st[c][0][WI][LI][e] = 0.f; st[c][1][WI][LI][e] = 0.f; }
#pragma unroll
                for (int j = 0; j < 2 && j < 2 * AT_KS; ++j) fq[j][WI][LI] = on ? ld_frag8(BA_QADDR(j)) : zero_frag8();
#pragma unroll
                for (int i = 0; i < 4 && i < 4 * AT_KS; ++i) fr[i][WI][LI] = on ? ld_frag8(BA_KADDR(i)) : zero_frag8(); }
            SCHED_FENCE();
#pragma unroll
            for (int i = 0; i < 4 * AT_KS; ++i) {
                MFMA16(st[i / (2 * AT_KS)][i & 1][WI], fr[i % 4][WI], fq[(i >> 1) & 1][WI]);
                SCHED_FENCE();
                WAVE_FOR { const bool on = HDIM >= 32 || (lane >> 4) < 2;
                    if (i + 4 < 4 * AT_KS) fr[i % 4][WI][LI] = on ? ld_frag8(BA_KADDR(i + 4)) : zero_frag8();
                    if ((i & 1) && (i >> 1) + 2 < 2 * AT_KS) fq[(i >> 1) & 1][WI][LI] = on ? ld_frag8(BA_QADDR((i >> 1) + 2)) : zero_frag8(); }
                SCHED_FENCE(); }
            WAVE_FOR {
#pragma unroll
                for (int i = 0; i < 4 && i < AT_ET; ++i) fr[i][WI][LI] = ld_frag8(BA_VADDR(i)); }
            SCHED_FENCE();
            WAVE_FOR {
#pragma unroll
                for (int c = 0; c < 2; ++c) { float mx = -1.0e30f;
#pragma unroll
                    for (int tau = 0; tau < 2; ++tau) for (int e = 0; e < 4; ++e) { mx = fmaxf(mx, st[c][tau][WI][LI][e]); }
                    tmx[c][WI][LI] = mx; } }
            gmax16(tmx[0][WI]); gmax16(tmx[1][WI]);
            WAVE_FOR { rfl[WI][LI] = 0;
#pragma unroll
                for (int c = 0; c < 2; ++c) { const float mn = tmx[c][WI][LI] > mrow[c][WI][LI] + BA_LAZY ? tmx[c][WI][LI] : mrow[c][WI][LI], alpha = EXP2F(mrow[c][WI][LI] - mn); rfl[WI][LI] |= (mn != mrow[c][WI][LI]) ? 1 : 0; mrow[c][WI][LI] = mn; alp[c][WI][LI] = alpha; float ps = 0.f, p8[8];
#pragma unroll
                    for (int tau = 0; tau < 2; ++tau) for (int e = 0; e < 4; ++e) { const float pvv = EXP2F(st[c][tau][WI][LI][e] - mn); ps += pvv; p8[4 * tau + e] = pvv; }
                    pf[c][WI][LI] = pack8(p8); lrow[c][WI][LI] = lrow[c][WI][LI] * alpha + ps; } }
            if (WANY(rfl[WI])) {
                WAVE_FOR {
#pragma unroll
                    for (int c = 0; c < 2; ++c) { const float alpha = alp[c][WI][LI];
#pragma unroll
                        for (int et = 0; et < AT_ET; ++et) for (int e = 0; e < 4; ++e) oacc[c][et][WI][LI][e] *= alpha; } } }
            SCHED_FENCE();
#pragma unroll
            for (int et = 0; et < AT_ET; ++et) {
                MFMA16(oacc[0][et][WI], fr[et % 4][WI], pf[0][WI]); MFMA16(oacc[1][et][WI], fr[et % 4][WI], pf[1][WI]);
                SCHED_FENCE();
                if (et + 4 < AT_ET) { WAVE_FOR { fr[et % 4][WI][LI] = ld_frag8(BA_VADDR(et + 4)); } }
                SCHED_FENCE(); }
#undef BA_KADDR
#undef BA_QADDR
#undef BA_VADDR
        }
        if (s + 1 < nst) { BA_COMMIT((s + 1) & 1) }
        BLOCK_SYNC();
    }
    BLOCK_WAVES {
        gsum16(lrow[0][WI]); gsum16(lrow[1][WI]);
        float ssq[NL];
        WAVE_FOR { const float i0 = 1.0f / lrow[0][WI][LI], i1 = lam / lrow[1][WI][LI]; float sq = 0.f;
#pragma unroll
            for (int et = 0; et < AT_ET; ++et) for (int e = 0; e < 4; ++e) { const float o = oacc[0][et][WI][LI][e] * i0 - oacc[1][et][WI][LI][e] * i1; oacc[0][et][WI][LI][e] = o; sq += o * o; }
            ssq[LI] = sq; }
        gsum16(ssq);
        WAVE_FOR { const int q = lane & 15, kg = lane >> 4, row0 = seq0 + qb * BA_QB + 16 * wv; const float rstd = rsq(ssq[LI] / (float)VD + NORM_EPS) * (1.0f - lam_init);
#pragma unroll
            for (int et = 0; et < AT_ET; ++et) { float o4[4]; for (int e = 0; e < 4; ++e) o4[e] = oacc[0][et][WI][LI][e] * rstd * p.at_g_sub[16 * et + 4 * kg + e]; st4b(p.H + (size_t)(row0 + q) * D + h * VD + 16 * et + 4 * kg, o4); } }
    }
#undef BA_FETCH
#undef BA_COMMIT
#undef BA_VSW
} };

constexpr int BC_VROW_L = DEC_SEQ + 8, BC_TROW_L = 2 * DEC_SEQ + 16, BC_VROW_C = SEQ + 8, BC_TROW_C = 2 * SEQ + 16;
constexpr int BC_RA = DEC_BATCH * BC_VROW_L + 8 * BC_TROW_L + 2 * DEC_SEQ, BC_RB = BATCH * BC_VROW_C + 8 * BC_TROW_C + 2 * SEQ;
constexpr int BC_VCH_L = DEC_BATCH * DEC_SEQ / 8, BC_TCH_L = 2 * DEC_SEQ / 8, BC_VCH_C = BATCH * SEQ / 8, BC_TCH_C = 2 * SEQ / 8;
constexpr int BC_CPT_L = (BC_VCH_L + BC_TCH_L + 511) / 512, BC_CPT_C = (BC_VCH_C + BC_TCH_C + 511) / 512, BC_CPT = BC_CPT_L > BC_CPT_C ? BC_CPT_L : BC_CPT_C;
static_assert((BC_RA + BC_RB) * 2 <= 146944, "conv LDS");
#ifdef HOST_EMU
static inline void unpack8(const Frag8& f, float* v) { for (int e = 0; e < 8; ++e) v[e] = bf2f(f.e[e]); }
#else
__device__ __forceinline__ void unpack8(const Frag8& f, float* v) { const U32x4v u = __builtin_bit_cast(U32x4v, f);
    _Pragma("unroll") for (int i = 0; i < 4; ++i) { const unsigned w = u[i]; v[2 * i] = __uint_as_float(w << 16); v[2 * i + 1] = __uint_as_float(w & 0xffff0000u); } }
#endif
struct B_conv { static constexpr int NITEMS = 1; static HD void run(const P& p, int j, int stride_, int first, float* ldsf) {
    bf16* lds = (bf16*)ldsf; const int stride = stride_ > 0 ? stride_ : 1; int c = first; if (c >= D) return;
    float wsx[4], wsv[4], nsx[4], nsv[4]; const float* ws = p.hy_w_short + (size_t)j * 9 * D; const float* bsb = p.hy_b_short + (size_t)j * 3 * D;
#define BC_LOADW(cc, WX, WV) do { for (int tp = 0; tp < 3; ++tp) { WX[tp] = ws[(size_t)tp * 3 * D + D + (cc)]; WV[tp] = ws[(size_t)tp * 3 * D + 2 * D + (cc)]; } WX[3] = bsb[D + (cc)]; WV[3] = bsb[2 * D + (cc)]; } while (0)
    BC_LOADW(c, wsx, wsv);
    Frag8 rx[2][BC_CPT][NW][NL], rv[2][BC_CPT][NW][NL]; unsigned hxa[2][BC_CPT][NW][NL], hxb[2][BC_CPT][NW][NL], hva[2][BC_CPT][NW][NL], hvb[2][BC_CPT][NW][NL];
#define BC_FETCH(cls, cc) BLOCK_WAVES { WAVE_FOR { const int vch = (cls) ? BC_VCH_L : BC_VCH_C, tch = (cls) ? BC_TCH_L : BC_TCH_C, Lc = (cls) ? DEC_SEQ : SEQ; \
        _Pragma("unroll") for (int k = 0; k < BC_CPT; ++k) { const int ci = BTID + 512 * k; \
            if (ci < vch) { const int gt = ((cls) ? MC : 0) + 8 * ci, tl = (8 * ci) % Lc; const bf16* xr = p.ZT + (size_t)(cc) * M + gt; const bf16* vr = p.ZT + (size_t)(D + (cc)) * M + gt; \
                rx[cls][k][WI][LI] = ld_frag8(xr); rv[cls][k][WI][LI] = ld_frag8(vr); \
                const int oa = tl > 0 ? -1 : 0, ob = tl + 8 < Lc ? 4 : 3;     \
                hxa[cls][k][WI][LI] = ((const unsigned*)xr)[oa]; hxb[cls][k][WI][LI] = ((const unsigned*)xr)[ob]; hva[cls][k][WI][LI] = ((const unsigned*)vr)[oa]; hvb[cls][k][WI][LI] = ((const unsigned*)vr)[ob]; } \
            else if (ci < vch + tch) { const int t = ci - vch; rx[cls][k][WI][LI] = ld_frag8(p.KT + kt_off(j, (cls), (cc)) + 8 * (size_t)t); } } (void)Lc; } }
#define BC_COMMIT(cls, WX, WV) BLOCK_WAVES { WAVE_FOR { const int vch = (cls) ? BC_VCH_L : BC_VCH_C, tch = (cls) ? BC_TCH_L : BC_TCH_C, Lc = (cls) ? DEC_SEQ : SEQ, vrow = (cls) ? BC_VROW_L : BC_VROW_C, trow = (cls) ? BC_TROW_L : BC_TROW_C; \
        bf16* reg = lds + ((cls) ? 0 : BC_RA); bf16* tsl = reg + ((cls) ? DEC_BATCH : BATCH) * vrow; \
        _Pragma("unroll") for (int k = 0; k < BC_CPT; ++k) { const int ci = BTID + 512 * k; \
            if (ci < vch) { const int e0 = 8 * ci; float xx[10], vv[10], g8[8]; unpack8(rx[cls][k][WI][LI], xx + 1); unpack8(rv[cls][k][WI][LI], vv + 1); const int tl = e0 % Lc; const bool ea = tl > 0, eb = tl + 8 < Lc; \
                xx[0] = ea ? bf2f((bf16)(hxa[cls][k][WI][LI] >> 16)) : 0.f; xx[9] = eb ? bf2f((bf16)(hxb[cls][k][WI][LI] & 0xffffu)) : 0.f; vv[0] = ea ? bf2f((bf16)(hva[cls][k][WI][LI] >> 16)) : 0.f; vv[9] = eb ? bf2f((bf16)(hvb[cls][k][WI][LI] & 0xffffu)) : 0.f; \
                for (int e = 0; e < 8; ++e) { const float x1 = xx[e] * WX[0] + xx[e + 1] * WX[1] + xx[e + 2] * WX[2] + WX[3], v1 = vv[e] * WV[0] + vv[e + 1] * WV[1] + vv[e + 2] * WV[2] + WV[3]; g8[e] = x1 * v1; } \
                st_frag8(reg + (e0 / Lc) * vrow + (e0 % Lc), pack8(g8)); } \
            else if (ci < vch + tch) { st_frag8(tsl + 8 * trow + 8 * (ci - vch), rx[cls][k][WI][LI]); } } } }
#define BC_BUILD(cls) BLOCK_WAVES { WAVE_FOR { const int Lc = (cls) ? DEC_SEQ : SEQ, vrow = (cls) ? BC_VROW_L : BC_VROW_C, trow = (cls) ? BC_TROW_L : BC_TROW_C; \
        bf16* tsl = lds + ((cls) ? 0 : BC_RA) + ((cls) ? DEC_BATCH : BATCH) * vrow; const bf16* ktl = tsl + 8 * trow; \
        for (int ci = BTID; ci < 2 * Lc; ci += 512) { const int rho = ci / (2 * Lc / 8), idx0 = 8 * (ci % (2 * Lc / 8)); Frag8 f; \
            _Pragma("unroll") for (int e = 0; e < 8; ++e) { const int jt = rho - (idx0 + e - Lc); f[e] = (jt > -Lc && jt < Lc) ? (short)ktl[jt + Lc] : (short)0; } \
            st_frag8(tsl + rho * trow + idx0, f); } } }
#define BC_LOADG(SET, grp) WAVE_FOR { const int r = lane & 31, h = lane >> 5, a = r >> 3, rho = r & 7, sl = sg * SPG + r / TPG, t1 = tg * TPG + r % TPG; \
        _Pragma("unroll") for (int u = 0; u < 4; ++u) { const int dl = dlo + 2 * (grp) + (u >> 1), ks = u & 1, q = 2 * dl - ks, s1 = t1 - dl; const bool dv = dl <= dhi; \
            ga[SET][u][LI] = ld_frag8(tsl + rho * trow + (dv ? 8 * (h - a - 2 * q) + L : 0)); \
            gb[SET][u][LI] = ld_frag8((dv && s1 >= 0 && s1 < NB) ? reg + sl * vrow + 32 * s1 + 16 * ks + 8 * h : reg + L); } }
#define BC_MFMAG(SET) _Pragma("unroll") for (int u = 0; u < 4; ++u) MFMA32(acc, ga[SET][u], gb[SET][u]);
#define BC_COMPUTE(cls) BLOCK_WAVES { const int NG = (cls) ? CV_NG_L : CV_NG_C; if (wv < NG) { \
        const int SPG = (cls) ? CV_SPG_L : CV_SPG_C, TPG = (cls) ? CV_TPG_L : CV_TPG_C, NB = (cls) ? CV_NB_L : CV_NB_C, L = (cls) ? DEC_SEQ : SEQ, vrow = (cls) ? BC_VROW_L : BC_VROW_C, trow = (cls) ? BC_TROW_L : BC_TROW_C; \
        const bf16* reg = lds + ((cls) ? 0 : BC_RA); const bf16* tsl = reg + ((cls) ? DEC_BATCH : BATCH) * vrow; \
        const int ntg = NB / TPG, sg = wv / ntg, tg = wv % ntg, dlo = tg * TPG - (NB - 1), dhi = tg * TPG + TPG - 1, ngrp = (((TPG + NB - 1) + 1) / 2 + 1) & ~1; \
        Acc16 acc[NL]; Frag8 ga[2][4][NL], gb[2][4][NL]; \
        WAVE_FOR { for (int r = 0; r < 16; ++r) acc[LI][r] = 0.f; } \
        BC_LOADG(0, 0) \
        SCHED_FENCE(); \
        _Pragma("unroll 1") for (int g = 0; g < ngrp; g += 2) { BC_LOADG(1, g + 1) SCHED_FENCE(); BC_MFMAG(0) SCHED_FENCE(); BC_LOADG(0, g + 2) SCHED_FENCE(); BC_MFMAG(1) SCHED_FENCE(); } \
        WAVE_FOR { const int r = lane & 31, h = lane >> 5; const int sl = sg * SPG + r / TPG, t1 = tg * TPG + r % TPG; const int gbase = ((cls) ? MC + sl * DEC_SEQ : sl * SEQ) + 32 * t1; \
            _Pragma("unroll") for (int rg = 0; rg < 4; ++rg) { const int to = 8 * rg + 4 * h; float o4[4]; \
                for (int e = 0; e < 4; ++e) o4[e] = acc[LI][4 * rg + e] + skip * bf2f(reg[sl * vrow + 32 * t1 + to + e]); \
                st4b(p.YT + (size_t)c * M + gbase + to, o4); } } } }
    BLOCK_WAVES { WAVE_FOR { if (BTID < 8) { lds[DEC_SEQ + BTID] = 0; lds[BC_RA + SEQ + BTID] = 0; } } }
    float skip = p.hy_skip[j * D + c], nskip = 0.f;
    BC_FETCH(1, c) BC_FETCH(0, c)
    for (;;) { const int cn = c + stride; const bool more = cn < D;
        BC_COMMIT(1, wsx, wsv)
        if (more) { BC_LOADW(cn, nsx, nsv); nskip = p.hy_skip[j * D + cn]; BC_FETCH(1, cn) }
        BLOCK_SYNC();
        BC_BUILD(1)
        BLOCK_SYNC();
        BC_COMPUTE(1)
        BC_COMMIT(0, wsx, wsv)
        if (more) { BC_FETCH(0, cn) }
        BLOCK_SYNC();
        BC_BUILD(0)
        BLOCK_SYNC();
        BC_COMPUTE(0)
        if (!more) break;
        c = cn; skip = nskip; for (int tp = 0; tp < 4; ++tp) { wsx[tp] = nsx[tp]; wsv[tp] = nsv[tp]; }
    }
#undef BC_LOADW
#undef BC_FETCH
#undef BC_COMMIT
#undef BC_COMPUTE
#undef BC_LOADG
#undef BC_MFMAG
#undef BC_BUILD
} };

constexpr int S5_NLONG = DEC_BATCH * SGS, S5_NSHORT = BATCH * SGS, S5_R = S5_NSHORT / S5_NLONG;
static_assert(S5_NSHORT % S5_NLONG == 0, "S5 item balance");
#ifdef HOST_EMU
static inline void ld4f_nc(const float* p, float* v) { for (int e = 0; e < 4; ++e) v[e] = p[e]; }
#else
__device__ __forceinline__ void ld4f_nc(const float* p, float* v) { const unsigned long long a = __hip_atomic_load((const unsigned long long*)p, __ATOMIC_RELAXED, __HIP_MEMORY_SCOPE_AGENT), b = __hip_atomic_load((const unsigned long long*)p + 1, __ATOMIC_RELAXED, __HIP_MEMORY_SCOPE_AGENT);
    v[0] = __uint_as_float((unsigned)a); v[1] = __uint_as_float((unsigned)(a >> 32)); v[2] = __uint_as_float((unsigned)b); v[3] = __uint_as_float((unsigned)(b >> 32)); }
#endif
struct W_s5f { static constexpr int NITEMS = 2 * S5_NLONG * S5_R; static HD void run(const P& p, int, int, int item, float* ldsf) {
    const int vs = item / (2 * S5_NLONG), vw = item % (2 * S5_NLONG); int sg;
    if (vw < S5_NLONG) { if (vs != 0) return; sg = BATCH * SGS + vw; } else sg = vs * S5_NLONG + (vw - S5_NLONG);
    const int g = sg % SGS, sidx = sg / SGS; const bool lat = sidx >= BATCH; const int b = lat ? sidx - BATCH : sidx;
  for (int dir = 0; dir < 2; ++dir) {
    const int L = lat ? DEC_SEQ : SEQ, seq0 = lat ? MC + b * DEC_SEQ : b * SEQ; const size_t dg = (size_t)dir * SGS + g;
    unsigned* tl = (unsigned*)ldsf; float* Y = p.YF;
    Frag8 fb[4][NL], fc[4][NL], fa[NL], fx[NL]; Acc16 bu[4][NL]; Acc4 yv[2][NL]; float lbr[NL], lbi[NL], xr[NL], xi[NL];
    WAVE_FOR { const int n = lane & 31, hh = lane >> 5, pp = n + 32 * hh;
#pragma unroll
        for (int q = 0; q < 4; ++q) { fb[q][LI] = ld_frag8(p.S5BB + (dg * 128 + 32 * q + n) * SG + 8 * hh); fc[q][LI] = ld_frag8(p.S5CM + (dg * SG + (lane & 15)) * 128 + 32 * q + 8 * (lane >> 4)); }
        lbr[LI] = p.S5LB[2 * (dg * SP + pp)]; lbi[LI] = p.S5LB[2 * (dg * SP + pp) + 1];
        if (lat) { const size_t si = (((size_t)b * NSS) * 2 + dir) * SGS * SP + (size_t)g * SP + pp; xr[LI] = p.st_re[si]; xi[LI] = p.st_im[si]; } else { xr[LI] = 0.f; xi[LI] = 0.f; } }
    WAVE_FOR { const int m = lane & 31, hh = lane >> 5, pos = 16 * ((m >> 2) & 1) + 4 * (m >> 3) + (m & 3), t = dir ? L - 1 - pos : pos; fa[LI] = ld_frag8(p.H + (size_t)(seq0 + t) * D + g * SG + 8 * hh); }
    for (int ch = 0; ch < L / 32; ++ch) {
        WAVE_FOR {
#pragma unroll
            for (int q = 0; q < 4; ++q) for (int r = 0; r < 16; ++r) bu[q][LI][r] = 0.f; }
#pragma unroll
        for (int q = 0; q < 4; ++q) MFMA32(bu[q], fa, fb[q]);
        if (ch + 1 < L / 32) { WAVE_FOR { const int m = lane & 31, hh = lane >> 5, pos = (ch + 1) * 32 + 16 * ((m >> 2) & 1) + 4 * (m >> 3) + (m & 3), t = dir ? L - 1 - pos : pos;
            fa[LI] = ld_frag8(p.H + (size_t)(seq0 + t) * D + g * SG + 8 * hh); } }
        SWAP32(bu[0], bu[1]); SWAP32(bu[2], bu[3]);
        WAVE_FOR { const int pp = (lane & 31) + 32 * (lane >> 5); float ar = xr[LI], ai = xi[LI]; const float cr_ = lbr[LI], ci_ = lbi[LI];
#pragma unroll
            for (int s = 0; s < 32; ++s) { const float ur = bu[s >> 4][LI][s & 15], ui = bu[2 + (s >> 4)][LI][s & 15];
                const float nr = fmaf(cr_, ar, fmaf(-ci_, ai, ur)), ni = fmaf(cr_, ai, fmaf(ci_, ar, ui)); ar = nr; ai = ni;
                tl[s * S5_ROWW + pp] = pk2bf(nr, ni); }
            xr[LI] = ar; xi[LI] = ai; }
        WAVE_SYNC_LDS();
#pragma unroll
        for (int pt = 0; pt < 2; ++pt) { WAVE_FOR { for (int e = 0; e < 4; ++e) yv[pt][LI][e] = 0.f; }
#pragma unroll
            for (int ks = 0; ks < 4; ++ks) { WAVE_FOR { fx[LI] = ld_frag8((const bf16*)(tl + (16 * pt + (lane & 15)) * S5_ROWW) + 32 * ks + 8 * (lane >> 4)); }
                MFMA16(yv[pt], fc[ks], fx); } }
        WAVE_FOR { const int kg = lane >> 4;
#pragma unroll
            for (int pt = 0; pt < 2; ++pt) { const int pos = ch * 32 + 16 * pt + (lane & 15), t = dir ? L - 1 - pos : pos; const size_t o = (size_t)(seq0 + t) * D + g * SG + 4 * kg; float* yo = Y + o;
                if (dir == 0) { for (int e = 0; e < 4; ++e) yo[e] = yv[pt][LI][e]; }
                else { float yf[4], u4[4], d4[4], o4[4]; ld4f_nc(yo, yf); ld4b(p.H + o, u4); ld4f(p.s5_d + g * SG + 4 * kg, d4);
                    for (int e = 0; e < 4; ++e) o4[e] = gelu_tanh_f(d4[e] * u4[e] + yf[e] + yv[pt][LI][e]); st4b(p.H + o, o4); } } }
        WAVE_SYNC_LDS();
    }
    if (!lat) { WAVE_FOR { const size_t so = (((size_t)b * NSS) * 2 + dir) * SGS * SP + (size_t)g * SP + (lane & 31) + 32 * (lane >> 5); p.out[OUT_SRE + so] = xr[LI]; p.out[OUT_SIM + so] = xi[LI]; } }
    WAVE_SYNC();
  }
} };


#ifdef HOST_EMU
template <class F> static void run_elem(const P& p, int a0, int a1, size_t n) { for (size_t i = 0; i < n; ++i) F::run(p, a0, a1, i); }
template <class F> static void run_block(const P& p, int a0, int a1) { std::vector<float> lds(65536); for (int it = 0; it < F::NITEMS; ++it) F::run(p, a0, a1, it, lds.data()); }
template <class F> static void run_wave(const P& p, int a0, int a1) { std::vector<float> lds(65536); for (int it = 0; it < F::NITEMS; ++it) F::run(p, a0, a1, it, lds.data()); }
static int wt_dst_row(int n, int N, int mode) { if (mode == 0) return n; const int Dm = N / 2, half = n / Dm, j = n % Dm; return 256 * (j / 128) + 128 * half + (j % 128); }
static void run_wtrans(const float* W, int K, int N, bf16* WT, int mode = 0) { for (int n = 0; n < N; ++n) for (int k = 0; k < K; ++k) WT[(size_t)wt_dst_row(n, N, mode) * K + k] = f2bf(W[(size_t)k * N + n]); }
enum { EP_B16 = 1, EP_RELU2 = 2, EP_QKV = 3, EP_GLU = 4, EP_B16R = 5 };
static void run_gemm(const P& p, const bf16* A, const bf16* Bt, int M_, int N, int K, int mode, bf16* Cb, int ldc, const float* bias) {
    std::vector<float> a((size_t)M_ * K), bt((size_t)N * K), accr(N); for (size_t i = 0; i < a.size(); ++i) a[i] = bf2f(A[i]); for (size_t i = 0; i < bt.size(); ++i) bt[i] = bf2f(Bt[i]);
    for (int m = 0; m < M_; ++m) { for (int n = 0; n < N; ++n) { float acc = 0.f; const float* ar = &a[(size_t)m * K]; const float* br = &bt[(size_t)n * K]; for (int k = 0; k < K; ++k) acc += ar[k] * br[k]; accr[n] = acc; }
        if (mode == EP_B16) for (int n = 0; n < N; ++n) Cb[(size_t)m * ldc + n] = f2bf(accr[n] + (bias ? bias[n] : 0.f));
        else if (mode == EP_B16R) for (int n = 0; n < N; ++n) Cb[(size_t)m * ldc + n] = f2bf(accr[n] + bias[m]);
        else if (mode == EP_RELU2) for (int n = 0; n < N; ++n) { const float v = accr[n] > 0.f ? accr[n] : 0.f; Cb[(size_t)m * ldc + n] = f2bf(v * v); }
        else if (mode == EP_QKV) { if (m >= MC) { const int t = (m - MC) % DEC_SEQ; for (int n = 0; n < 2 * D; ++n) { const int w = n % HDIM, grp = w / (2 * QD), ii = w % QD; if ((w / QD) % 2 == 0) { const float cs = p.RT[((size_t)t * 2 * QD + grp * QD + ii) * 2], sn = p.RT[((size_t)t * 2 * QD + grp * QD + ii) * 2 + 1], a = accr[n], bq = accr[n + QD]; accr[n] = a * cs - bq * sn; accr[n + QD] = bq * cs + a * sn; } } }
          for (int n = 0; n < N; ++n) { if (n < 2 * D) { Cb[(size_t)m * ldc + n] = f2bf(accr[n]); if (m < MC && n >= D) p.out[OUT_K + (size_t)m * D + (n % D)] = accr[n]; }
            else { const bool ctx = m < MC; const int vc = n - 2 * D, b = ctx ? m / SEQ : (m - MC) / DEC_SEQ, key = ctx ? m % SEQ : PAST + (m - MC) % DEC_SEQ, T = ctx ? SEQ : TMAX, pos = 32 * (key >> 5) + kperm32(key & 31);
                if (ctx) p.out[OUT_V + (size_t)m * D + vc] = accr[n]; p.VTT[(ctx ? (size_t)0 : VTT_C) + (size_t)b * NH * VD * T + (size_t)vc * T + pos] = f2bf(accr[n]); } } }
        else if (mode == EP_GLU) for (int pn = 0; pn < N / 256; ++pn) for (int jj = 0; jj < 128; ++jj) { const int j = 128 * pn + jj; const float av = accr[256 * pn + jj] + bias[j], gv = accr[256 * pn + 128 + jj] + bias[N / 2 + j]; Cb[(size_t)m * ldc + j] = f2bf(av / (1.0f + expf(-gv))); } }
}

static void forward(const P& p) {
    run_elem<E_ropetab>(p, 0, 0, (size_t)DEC_SEQ * 2 * QD); run_elem<E_kcvt8>(p, 0, 0, (size_t)DEC_BATCH * NAT * PAST * NH * 2 * HDIM / 8); run_wave<W_vtransc>(p, 0, 0);
    run_elem<E_scond>(p, 0, 0, (size_t)NCND * D); run_elem<E_s5tab>(p, 0, 0, (size_t)2 * SGS * SP); run_elem<E_filt1>(p, 0, 0, (size_t)NHY * LMAX * FW);
    for (int l = 0; l < DEPTH; ++l) { run_wtrans(p.w_mlp_in + (size_t)l * D * DFF, D, DFF, p.Wt_mlp_in + (size_t)l * D * DFF); run_wtrans(p.w_mlp_out + (size_t)l * D * DFF, DFF, D, p.Wt_mlp_out + (size_t)l * D * DFF); }
    for (int j = 0; j < NHY; ++j) { run_wtrans(p.hy_w_in + (size_t)j * D * 3 * D, D, 3 * D, p.Wt_hy_in + (size_t)j * D * 3 * D); run_wtrans(p.hy_w_out + (size_t)j * D * D, D, D, p.Wt_hy_out + (size_t)j * D * D); }
    run_wtrans(p.at_w_qkv, D, 3 * D, p.Wt_qkv); run_wtrans(p.at_w_o, D, D, p.Wt_wo); run_wtrans(p.s5_w_glu, D, 2 * D, p.Wt_glu, 1);
    run_elem<E_modp>(p, 0, 0, (size_t)DEPTH * MOD_KS * 6 * D / 4); run_elem<E_filt2>(p, 0, 0, (size_t)NHY * LMAX * FW);
    run_elem<E_modvec2>(p, 0, 0, (size_t)DEPTH * 2 * NCND * 3 * D); run_elem<E_filt3c>(p, 0, 0, (size_t)NHY * F3_NCH * 2 * D);
    run_elem<E_fk2>(p, 0, 0, (size_t)NHY * (FK_NC0 + FK_NC1) * D);
    for (int i = 0; i < DEPTH; ++i) {
        const int kind = i % 3, j = i / 3;
        run_wave<W_thin2>(p, i > 0 ? (((i - 1) * 8 + 1) | TH_MODE_B | (i == 1 ? TH_SRC_IN : 0)) : -1, i * 8 + 0);
        if (kind == 0) {
            run_gemm(p, p.H, p.Wt_hy_in + (size_t)j * D * 3 * D, M, D, D, EP_B16, p.Z0, D, p.hy_b_in + (size_t)j * 3 * D);
            run_gemm(p, p.Wt_hy_in + (size_t)j * D * 3 * D + (size_t)D * D, p.H, 2 * D, M, D, EP_B16R, p.ZT, M, p.hy_b_in + (size_t)j * 3 * D + D);
            run_block<B_conv>(p, j, 0);
            run_wave<W_hconv3y>(p, j, 0);
            run_gemm(p, p.H, p.Wt_hy_out + (size_t)j * D * D, M, D, D, EP_B16, p.ObA, D, p.hy_b_out + (size_t)j * D);
        } else if (kind == 1) {
            run_gemm(p, p.H, p.Wt_qkv, M, 3 * D, D, EP_QKV, p.Z, 3 * D, nullptr);
            run_block<B_attn>(p, 0, 0);
            run_gemm(p, p.H, p.Wt_wo, M, D, D, EP_B16, p.ObA, D, nullptr);
        } else {
            run_wave<W_s5f>(p, 0, 0);
            run_gemm(p, p.H, p.Wt_glu, M, 2 * D, D, EP_GLU, p.ObA, D, p.s5_b_glu);
        }
        run_wave<W_thin2>(p, (i * 8 + 0) | TH_MODE_A | (i == 0 ? TH_SRC_IN : 0), i * 8 + 1);
        run_gemm(p, p.H, p.Wt_mlp_in + (size_t)i * D * DFF, M, DFF, D, EP_RELU2, p.HID, DFF, nullptr);
        run_gemm(p, p.HID, p.Wt_mlp_out + (size_t)i * D * DFF, M, D, DFF, EP_B16, p.Ob, D, nullptr);
    }
    run_wave<W_thin2>(p, ((DEPTH - 1) * 8 + 1) | TH_MODE_B, -1);
}

struct Bump { unsigned char* base; size_t off; template <class T> T* take(size_t n) { T* r = (T*)(base + off); off += (n * sizeof(T) + 255) & ~(size_t)255; return r; } };
static size_t carve(P& p, unsigned char* ws) {
    Bump b{ws, 0};
    p.CTL = b.take<unsigned>(CTL_BYTES / 4);
    p.Wt_mlp_in = b.take<bf16>((size_t)DEPTH * D * DFF); p.Wt_mlp_out = b.take<bf16>((size_t)DEPTH * D * DFF); p.Wt_hy_in = b.take<bf16>((size_t)NHY * D * 3 * D); p.Wt_hy_out = b.take<bf16>((size_t)NHY * D * D);
    p.Wt_qkv = b.take<bf16>((size_t)D * 3 * D); p.Wt_wo = b.take<bf16>((size_t)D * D); p.Wt_glu = b.take<bf16>((size_t)D * 2 * D);
    p.X = b.take<float>((size_t)M * D); p.MOD = b.take<float>((size_t)DEPTH * NCND * 6 * D); p.SCOND = b.take<float>((size_t)NCND * D); p.O = b.take<float>((size_t)M * D);
    p.HRAW = b.take<float>((size_t)NHY * LMAX * 2 * D); p.H1 = b.take<float>((size_t)NHY * LMAX * FW); p.H2 = b.take<float>((size_t)NHY * LMAX * FW); p.KINV = b.take<float>((size_t)NHY * 2 * D);
    p.KT = b.take<bf16>((size_t)NHY * KT_LAYER); p.S5BB = b.take<bf16>(S5_BBT); p.S5CM = b.take<bf16>(S5_CMT); p.S5LB = b.take<float>((size_t)2 * SGS * SP * 2); p.MV = b.take<float>((size_t)DEPTH * 2 * NCND * 3 * D); p.PS = b.take<float>((size_t)NHY * F3_NCH * 2 * D); p.PM = b.take<float>((size_t)MOD_KS * DEPTH * NCND * 6 * D); p.Ob = (bf16*)p.O; p.ObA = p.Ob + (size_t)M * D; p.RS = b.take<float>((size_t)2 * M); p.RT = b.take<float>((size_t)DEC_SEQ * 2 * QD * 2 + 16);
    p.KC = b.take<bf16>((size_t)DEC_BATCH * NAT * PAST * NH * 2 * HDIM); p.VTT = b.take<bf16>(VTT_ALL);
    p.XB = b.take<bf16>((size_t)M * D);
    p.H = b.take<bf16>((size_t)M * D); p.Z = b.take<bf16>((size_t)M * 3 * D); p.Z0 = p.Z; p.ZT = p.Z + (size_t)M * D;
    const size_t hid_off = b.off; p.HID = b.take<bf16>((size_t)M * DFF); const size_t hid_end = b.off;
    Bump o{ws, hid_off}; p.YF = o.take<float>((size_t)M * D); p.YB = o.take<float>((size_t)M * D); p.X0C = p.YF; p.VV = p.YB;
    Bump o2{ws, hid_off}; p.YT = o2.take<bf16>((size_t)D * M); p.TS = o2.take<bf16>(TS_ALL); p.X0Cb = p.YT; p.VT = p.YT;
    size_t end = hid_end; if (o.off > end) end = o.off; if (o2.off > end) end = o2.off; return end;
}
static void set_inputs(P& p, void* const* in) {
    const float** f = (const float**)&p.x_prompt; for (int i = 0; i < 42; ++i) f[i] = (const float*)in[i];
}


int main(int argc, char** argv) {
    const size_t G_ = SGS, P_ = SP, H_ = SG;
    const size_t sizes[42] = {(size_t)MC * D, (size_t)ML * D, (size_t)DEC_BATCH * NAT * PAST * NH * 2 * HDIM, (size_t)DEC_BATCH * NAT * PAST * NH * VD, (size_t)DEC_BATCH * NSS * 2 * G_ * P_, (size_t)DEC_BATCH * NSS * 2 * G_ * P_,
        (size_t)DEC_BATCH * D, (size_t)D, (size_t)DEPTH * D * 6 * D, (size_t)DEPTH * 6 * D, (size_t)DEPTH * 4 * D, (size_t)DEPTH * D * DFF, (size_t)DEPTH * DFF * D,
        (size_t)NHY * D * 3 * D, (size_t)NHY * 3 * D, (size_t)NHY * 3 * 3 * D, (size_t)NHY * 3 * D, (size_t)NHY * 32 * FW, (size_t)NHY * FW, (size_t)NHY * FW, (size_t)NHY * FW * FW, (size_t)NHY * FW, (size_t)NHY * FW,
        (size_t)NHY * FW * 2 * D, (size_t)NHY * D, (size_t)NHY * D, (size_t)NHY * D * D, (size_t)NHY * D,
        (size_t)NAT * D * 3 * D, (size_t)NAT * 4 * HDIM, (size_t)NAT * VD, (size_t)NAT * D * D,
        (size_t)NSS * 2 * G_ * P_, (size_t)NSS * 2 * G_ * P_, (size_t)NSS * 2 * G_, (size_t)NSS * 2 * G_ * P_ * H_, (size_t)NSS * 2 * G_ * P_ * H_, (size_t)NSS * 2 * G_ * H_ * P_, (size_t)NSS * 2 * G_ * H_ * P_,
        (size_t)NSS * D, (size_t)NSS * D * 2 * D, (size_t)NSS * 2 * D};
    FILE* f = fopen(argc > 1 ? argv[1] : "in_small.bin", "rb"); if (!f) { printf("no input\n"); return 1; }
    std::vector<std::vector<float>> ins(42); void* inp[42];
    for (int i = 0; i < 42; ++i) { ins[i].resize(sizes[i]); if (fread(ins[i].data(), 4, sizes[i], f) != sizes[i]) { printf("short read %d\n", i); return 1; } inp[i] = ins[i].data(); }
    fclose(f);
    P p; memset(&p, 0, sizeof(p)); set_inputs(p, inp);
    P tmp = p; const size_t need = carve(tmp, nullptr);
    std::vector<unsigned char> ws(need + 256, 0xAA); std::vector<float> out(OUT_END, -7.f);
    carve(p, ws.data()); p.out = out.data();
    forward(p);
    FILE* g = fopen(argc > 2 ? argv[2] : "emu_out.bin", "wb"); fwrite(out.data(), 4, out.size(), g); fclose(g);
    printf("host emulation done: %zu outputs, ws %zu bytes\n", out.size(), need);
    return 0;
}

#else
namespace pg8 {
#define PG8_LAS __attribute__((address_space(3)))
typedef unsigned short bf16_t;
typedef short bf16x8 __attribute__((ext_vector_type(8)));
typedef float f32x4 __attribute__((ext_vector_type(4)));
typedef unsigned u32x4 __attribute__((ext_vector_type(4)));
constexpr int BM = 256, BK = 64, HALF = 128, HTB = HALF * BK * 2  , STAGE_BYTES = 8 * HTB, NXCD = 8, WGM = 8;

__host__ __device__ __forceinline__ int lds_byte(int r, int c) { const int st = (r >> 4) * 2 + (c >> 5), rr = r & 15, cc = c & 31, ob = rr * 64 + cc * 2; return st * 1024 + (ob ^ (((ob >> 9) & 1) << 5)); }
__host__ __device__ __forceinline__ void stage_rc(int b, int& R, int& C) { const int st = b / 1024, sb = b % 1024, swz = sb ^ (((sb >> 9) & 1) << 5); R = (st >> 1) * 16 + swz / 64; C = (st & 1) * 32 + (swz % 64) / 2; }
__host__ __device__ __forceinline__ int perm32(int rho) { const int n = rho >> 4, i = rho & 15; return 8 * (i >> 2) + 4 * n + (i & 3); }

struct Unit { int pm, pn; };
struct Gemm { const bf16_t* A; const bf16_t* Bt; int M, N, K, pad; };

struct StaticOrder {
    int nM, nN, nwg, G, c;
    __host__ __device__ void init(int M, int N, int G_, int c_) { nM = M / BM; nN = N / BM; nwg = nM * nN; G = G_; c = c_; }
    __host__ __device__ bool next(int i, Unit& u) const {
        const long L = (long)i * G + c; if (L >= nwg) return false;
        int wgid = (int)L; { const int q = nwg / NXCD, r = nwg % NXCD, xcd = wgid % NXCD, off = wgid / NXCD; wgid = (xcd < r ? xcd * (q + 1) : r * (q + 1) + (xcd - r) * q) + off; }
        const int nig = WGM * nN, gid = wgid / nig, fm = gid * WGM, gsz = (nM - fm) < WGM ? (nM - fm) : WGM;
        u.pm = fm + ((wgid % nig) % gsz); u.pn = (wgid % nig) / gsz; return true;
    }
    __device__ __forceinline__ void a_ready(const Unit&) const {}
    __device__ __forceinline__ void done(const Unit&) const {}
};

__device__ __forceinline__ unsigned cvt_pk_bf16(float lo, float hi) { unsigned r; asm volatile("v_cvt_pk_bf16_f32 %0, %1, %2" : "=v"(r) : "v"(lo), "v"(hi)); return r; }
typedef float f32x2 __attribute__((ext_vector_type(2)));
template <class Epi, class Sched, bool ALIGN_EPI = false, bool SP2 = false>
__device__ __forceinline__ void gemm_phase(PG8_LAS unsigned char* lds, const Gemm g, const Sched& S, const Epi& E) {
    const int tid = threadIdx.x, wid = __builtin_amdgcn_readfirstlane(tid >> 6), lane = tid & 63, wr = wid >> 2, wc = wid & 3, fr = lane & 15, fq = lane >> 4;
    const int K = g.K, nt = K / BK;
    unsigned voffA[2], voffB[2];
#pragma unroll
    for (int i = 0; i < 2; ++i) { int R, C; stage_rc(tid * 16 + i * 8192, R, C); const int Rb = Epi::PERM ? ((R & ~31) + perm32(R & 31)) : R;
        voffA[i] = (unsigned)(R * K + C) * 2u; voffB[i] = (unsigned)(Rb * K + C) * 2u; }
    const size_t kstep = (size_t)(BK * 2);
    const size_t hstep = (size_t)HALF * K * 2;
    const size_t tstep = 2 * hstep;
    const unsigned ldsw = (unsigned)wid * 1024u;
    const int aoff = lds_byte(wr * 64 + fr, fq * 8), boff = lds_byte(wc * 32 + fr, fq * 8);
#define PG8_SA(b, h) (((b) * 2 + (h)) * HTB)
#define PG8_SB(b, h) ((4 + (b) * 2 + (h)) * HTB)
#define PG8_STAGE(bufoff, gbase, voff) do { _Pragma("unroll") for (int _i = 0; _i < 2; ++_i) \
        __builtin_amdgcn_global_load_lds((const unsigned*)((const char*)(gbase) + (voff)[_i]), (PG8_LAS unsigned*)(lds + (bufoff) + ldsw + _i * 8192), 16, 0, 0); } while (0)
#define PG8_LDA(dst, b, h) do { _Pragma("unroll") for (int m = 0; m < 4; ++m) _Pragma("unroll") for (int k = 0; k < 2; ++k) dst[m][k] = *(const PG8_LAS bf16x8*)(lds + PG8_SA(b, h) + aoff + m * 2048 + k * 1024); } while (0)
#define PG8_LDB(dst, b, h) do { _Pragma("unroll") for (int n = 0; n < 2; ++n) _Pragma("unroll") for (int k = 0; k < 2; ++k) dst[n][k] = *(const PG8_LAS bf16x8*)(lds + PG8_SB(b, h) + boff + n * 2048 + k * 1024); } while (0)
#define PG8_MMA(ai, bj, At, Bt) do { __builtin_amdgcn_s_setprio(1); _Pragma("unroll") for (int m = 0; m < 4; ++m) _Pragma("unroll") for (int n = 0; n < 2; ++n) _Pragma("unroll") for (int k = 0; k < 2; ++k) \
        acc[ai][bj][m][n] = __builtin_amdgcn_mfma_f32_16x16x32_bf16(Bt[n][k], At[m][k], acc[ai][bj][m][n], 0, 0, 0); __builtin_amdgcn_s_setprio(0); } while (0)
#define PG8_WAIT_V(n) asm volatile("s_waitcnt vmcnt(" #n ")" ::: "memory")
#define PG8_WAIT_L(n) asm volatile("s_waitcnt lgkmcnt(" #n ")" ::: "memory")
#define PG8_BAR __builtin_amdgcn_s_barrier()
#define PG8_SCHED __builtin_amdgcn_sched_barrier(0)
    Unit cur, nxt; int ui = 0;
    if (!S.next(0, cur)) return;
    f32x4 acc[2][2][4][2];
#pragma unroll
    for (int a = 0; a < 2; ++a)
#pragma unroll
        for (int b = 0; b < 2; ++b)
#pragma unroll
            for (int m = 0; m < 4; ++m)
#pragma unroll
                for (int n = 0; n < 2; ++n) acc[a][b][m][n] = (f32x4){0.f, 0.f, 0.f, 0.f};
    bf16x8 At[4][2], B0[2][2], B1[2][2];
    const char* cA = (const char*)g.A + (size_t)cur.pm * tstep; const char* cB = (const char*)g.Bt + (size_t)cur.pn * tstep;
    S.a_ready(cur);
    if constexpr (SP2) {
        PG8_STAGE(PG8_SB(0, 0), cB, voffB); PG8_STAGE(PG8_SB(0, 1), cB + hstep, voffB); PG8_STAGE(PG8_SA(0, 0), cA, voffA); PG8_STAGE(PG8_SA(0, 1), cA + hstep, voffA);
        if (wr == 1) PG8_BAR;
        PG8_WAIT_V(2); PG8_BAR;
        PG8_STAGE(PG8_SB(1, 0), cB + kstep, voffB); PG8_STAGE(PG8_SA(1, 0), cA + kstep, voffA); PG8_STAGE(PG8_SB(1, 1), cB + hstep + kstep, voffB);
        PG8_WAIT_V(6); PG8_BAR;
    } else {
        PG8_STAGE(PG8_SB(0, 0), cB, voffB); PG8_STAGE(PG8_SA(0, 0), cA, voffA); PG8_STAGE(PG8_SB(0, 1), cB + hstep, voffB); PG8_STAGE(PG8_SA(0, 1), cA + hstep, voffA);
        if (wr == 1) PG8_BAR;
        PG8_WAIT_V(4); PG8_BAR;
        PG8_STAGE(PG8_SB(1, 0), cB + kstep, voffB); PG8_STAGE(PG8_SA(1, 0), cA + kstep, voffA); PG8_STAGE(PG8_SB(1, 1), cB + hstep + kstep, voffB);
        PG8_WAIT_V(6); PG8_BAR;
    }
    for (;;) {
        const bool has_next = S.next(ui + 1, nxt);
        const char* nA = has_next ? (const char*)g.A + (size_t)nxt.pm * tstep : cA; const char* nB = has_next ? (const char*)g.Bt + (size_t)nxt.pn * tstep : cB;
        for (int t = 0; t < nt; t += 2) {
            const bool last = (t == nt - 2);
            const char* a1 = cA + (size_t)(t + 1) * kstep;
            const char* a2 = last ? nA : cA + (size_t)(t + 2) * kstep; const char* b2 = last ? nB : cB + (size_t)(t + 2) * kstep;
            const char* a3 = a2 + kstep; const char* b3 = b2 + kstep;
            if (last && has_next) S.a_ready(nxt);
            if constexpr (SP2) {
            PG8_LDB(B0, 0, 0); PG8_LDB(B1, 0, 1); PG8_SCHED; PG8_LDA(At, 0, 0); PG8_STAGE(PG8_SA(1, 1), a1 + hstep, voffA);
            PG8_WAIT_V(8); PG8_WAIT_L(0); PG8_BAR; PG8_MMA(0, 0, At, B0); PG8_MMA(0, 1, At, B1); PG8_BAR; PG8_SCHED;
            PG8_LDA(At, 0, 1); PG8_STAGE(PG8_SB(0, 0), b2, voffB); PG8_STAGE(PG8_SB(0, 1), b2 + hstep, voffB); PG8_STAGE(PG8_SA(0, 0), a2, voffA);
            PG8_WAIT_V(8); PG8_WAIT_L(0); PG8_BAR; PG8_MMA(1, 0, At, B0); PG8_MMA(1, 1, At, B1); PG8_BAR; PG8_SCHED;
            PG8_LDB(B0, 1, 0); PG8_LDB(B1, 1, 1); PG8_SCHED; PG8_LDA(At, 1, 0); PG8_STAGE(PG8_SA(0, 1), a2 + hstep, voffA);
            PG8_WAIT_V(8); PG8_WAIT_L(0); PG8_BAR; PG8_MMA(0, 0, At, B0); PG8_MMA(0, 1, At, B1); PG8_BAR; PG8_SCHED;
            PG8_LDA(At, 1, 1); PG8_STAGE(PG8_SB(1, 0), b3, voffB); PG8_STAGE(PG8_SB(1, 1), b3 + hstep, voffB); PG8_STAGE(PG8_SA(1, 0), a3, voffA);
            PG8_WAIT_V(8); PG8_WAIT_L(0); PG8_BAR; PG8_MMA(1, 0, At, B0); PG8_MMA(1, 1, At, B1); PG8_BAR; PG8_SCHED;
            } else {
            PG8_LDB(B0, 0, 0); PG8_SCHED; PG8_LDA(At, 0, 0); PG8_STAGE(PG8_SA(1, 1), a1 + hstep, voffA);
            PG8_WAIT_L(8); PG8_BAR; PG8_WAIT_L(0); PG8_MMA(0, 0, At, B0); PG8_BAR; PG8_SCHED;
            PG8_LDB(B1, 0, 1); PG8_STAGE(PG8_SB(0, 0), b2, voffB);
            PG8_BAR; PG8_WAIT_L(0); PG8_MMA(0, 1, At, B1); PG8_BAR;
            PG8_LDA(At, 0, 1); PG8_STAGE(PG8_SA(0, 0), a2, voffA);
            PG8_BAR; PG8_WAIT_L(0); PG8_MMA(1, 0, At, B0); PG8_BAR; PG8_SCHED;
            PG8_STAGE(PG8_SB(0, 1), b2 + hstep, voffB);
            PG8_WAIT_V(6); PG8_BAR; PG8_MMA(1, 1, At, B1); PG8_BAR;
            PG8_LDB(B0, 1, 0); PG8_SCHED; PG8_LDA(At, 1, 0); PG8_STAGE(PG8_SA(0, 1), a2 + hstep, voffA);
            PG8_WAIT_L(8); PG8_BAR; PG8_WAIT_L(0); PG8_MMA(0, 0, At, B0); PG8_BAR; PG8_SCHED;
            PG8_LDB(B1, 1, 1); PG8_STAGE(PG8_SB(1, 0), b3, voffB);
            PG8_BAR; PG8_WAIT_L(0); PG8_MMA(0, 1, At, B1); PG8_BAR;
            PG8_LDA(At, 1, 1); PG8_STAGE(PG8_SA(1, 0), a3, voffA);
            PG8_BAR; PG8_WAIT_L(0); PG8_MMA(1, 0, At, B0); PG8_BAR; PG8_SCHED;
            PG8_STAGE(PG8_SB(1, 1), b3 + hstep, voffB);
            PG8_WAIT_V(6); PG8_BAR; PG8_MMA(1, 1, At, B1); PG8_BAR;
            }
        }
        if constexpr (ALIGN_EPI) { if (wr == 0) PG8_BAR; }
        if constexpr (!Epi::AFTER_DRAIN) { E(acc, cur, wr, wc, fr, fq); S.done(cur); }
        if (!has_next) break;
#pragma unroll
        for (int a = 0; a < 2; ++a)
#pragma unroll
            for (int b = 0; b < 2; ++b)
#pragma unroll
                for (int m = 0; m < 4; ++m)
#pragma unroll
                    for (int n = 0; n < 2; ++n) acc[a][b][m][n] = (f32x4){0.f, 0.f, 0.f, 0.f};
        cur = nxt; cA = nA; cB = nB; ++ui;
        if constexpr (ALIGN_EPI) { if (wr == 1) PG8_BAR; }
    }
    PG8_WAIT_V(0);
    if constexpr (!ALIGN_EPI) { if (wr == 0) PG8_BAR; }
    PG8_BAR;
    if constexpr (Epi::AFTER_DRAIN) { E.fused(acc, cur, wr, wc, fr, fq, lds, wid, lane); S.done(cur); }
#undef PG8_SA
#undef PG8_SB
#undef PG8_STAGE
#undef PG8_LDA
#undef PG8_LDB
#undef PG8_MMA
#undef PG8_WAIT_V
#undef PG8_WAIT_L
#undef PG8_BAR
#undef PG8_SCHED
}
}

namespace pg8 {
struct EpiF32 {
    static constexpr bool PERM = false, AFTER_DRAIN = false;
    float* C; const float* bias; int ldc; int pad;
    __device__ __forceinline__ void operator()(const f32x4 (&acc)[2][2][4][2], const Unit& u, int wr, int wc, int fr, int fq) const {
        const int row0 = u.pm * BM + wr * 64 + fr, col0 = u.pn * BM + wc * 32 + 4 * fq;
        f32x4 bv[2][2];
#pragma unroll
        for (int bj = 0; bj < 2; ++bj)
#pragma unroll
            for (int n = 0; n < 2; ++n) bv[bj][n] = bias ? *(const f32x4*)(bias + col0 + bj * HALF + n * 16) : (f32x4){0.f, 0.f, 0.f, 0.f};
#pragma unroll
        for (int ai = 0; ai < 2; ++ai)
#pragma unroll
            for (int m = 0; m < 4; ++m) { float* rowp = C + (size_t)(row0 + ai * HALF + m * 16) * ldc + col0;
#pragma unroll
                for (int bj = 0; bj < 2; ++bj)
#pragma unroll
                    for (int n = 0; n < 2; ++n) *(f32x4*)(rowp + bj * HALF + n * 16) = acc[ai][bj][m][n] + bv[bj][n]; }
    }
};
struct EpiB16 {
    static constexpr bool PERM = true, AFTER_DRAIN = false;
    bf16_t* O; const float* bias; int ldc; int pad;
    __device__ __forceinline__ void operator()(const f32x4 (&acc)[2][2][4][2], const Unit& u, int wr, int wc, int fr, int fq) const {
        const int row0 = u.pm * BM + wr * 64 + fr, col0 = u.pn * BM + wc * 32 + 8 * fq;
        f32x4 bv[2][2];
#pragma unroll
        for (int bj = 0; bj < 2; ++bj)
#pragma unroll
            for (int n = 0; n < 2; ++n) bv[bj][n] = bias ? *(const f32x4*)(bias + col0 + bj * HALF + 4 * n) : (f32x4){0.f, 0.f, 0.f, 0.f};
#pragma unroll
        for (int ai = 0; ai < 2; ++ai)
#pragma unroll
            for (int m = 0; m < 4; ++m) { bf16_t* rowp = O + (size_t)(row0 + ai * HALF + m * 16) * ldc + col0;
#pragma unroll
                for (int bj = 0; bj < 2; ++bj) { const f32x4 v0 = acc[ai][bj][m][0] + bv[bj][0], v1 = acc[ai][bj][m][1] + bv[bj][1];
                    u32x4 w; w.x = cvt_pk_bf16(v0[0], v0[1]); w.y = cvt_pk_bf16(v0[2], v0[3]); w.z = cvt_pk_bf16(v1[0], v1[1]); w.w = cvt_pk_bf16(v1[2], v1[3]);
                    *(u32x4*)(rowp + bj * HALF) = w; } }
    }
};
struct EpiB16R {
    static constexpr bool PERM = true, AFTER_DRAIN = false;
    bf16_t* O; const float* bias; int ldc; int pad;
    __device__ __forceinline__ void operator()(const f32x4 (&acc)[2][2][4][2], const Unit& u, int wr, int wc, int fr, int fq) const {
        const int row0 = u.pm * BM + wr * 64 + fr, col0 = u.pn * BM + wc * 32 + 8 * fq;
        float bvr[2][4];
#pragma unroll
        for (int ai = 0; ai < 2; ++ai)
#pragma unroll
            for (int m = 0; m < 4; ++m) bvr[ai][m] = bias[row0 + ai * HALF + m * 16];
#pragma unroll
        for (int ai = 0; ai < 2; ++ai)
#pragma unroll
            for (int m = 0; m < 4; ++m) { const int row = row0 + ai * HALF + m * 16; bf16_t* rowp = O + (size_t)row * ldc + col0;
#pragma unroll
                for (int bj = 0; bj < 2; ++bj) { const f32x4 v0 = acc[ai][bj][m][0] + bvr[ai][m], v1 = acc[ai][bj][m][1] + bvr[ai][m];
                    u32x4 w; w.x = cvt_pk_bf16(v0[0], v0[1]); w.y = cvt_pk_bf16(v0[2], v0[3]); w.z = cvt_pk_bf16(v1[0], v1[1]); w.w = cvt_pk_bf16(v1[2], v1[3]);
                    *(u32x4*)(rowp + bj * HALF) = w; } }
    }
};
struct EpiRelu2 {
    static constexpr bool PERM = true, AFTER_DRAIN = false;
    bf16_t* O; int ldc; int pad;
    __device__ __forceinline__ void operator()(const f32x4 (&acc)[2][2][4][2], const Unit& u, int wr, int wc, int fr, int fq) const {
        const int row0 = u.pm * BM + wr * 64 + fr, col0 = u.pn * BM + wc * 32 + 8 * fq;
#pragma unroll
        for (int ai = 0; ai < 2; ++ai)
#pragma unroll
            for (int m = 0; m < 4; ++m) { bf16_t* rowp = O + (size_t)(row0 + ai * HALF + m * 16) * ldc + col0;
#pragma unroll
                for (int bj = 0; bj < 2; ++bj) { f32x4 v0 = acc[ai][bj][m][0], v1 = acc[ai][bj][m][1];
#pragma unroll
                    for (int e = 0; e < 4; ++e) { const float a = v0[e] > 0.f ? v0[e] : 0.f, b = v1[e] > 0.f ? v1[e] : 0.f; v0[e] = a * a; v1[e] = b * b; }
                    u32x4 w; w.x = cvt_pk_bf16(v0[0], v0[1]); w.y = cvt_pk_bf16(v0[2], v0[3]); w.z = cvt_pk_bf16(v1[0], v1[1]); w.w = cvt_pk_bf16(v1[2], v1[3]);
                    *(u32x4*)(rowp + bj * HALF) = w; } }
    }
};
struct EpiQKV {
    static constexpr bool PERM = true, AFTER_DRAIN = false;
    bf16_t* O; float* outk; float* outv; bf16_t* vtt; const float* rope; int ldc, dmodel, mc, pad;
    __device__ __forceinline__ void operator()(const f32x4 (&acc)[2][2][4][2], const Unit& u, int wr, int wc, int fr, int fq) const {
        const int row0 = u.pm * BM + wr * 64 + fr, col0 = u.pn * BM + wc * 32 + 8 * fq; const int sect = (u.pn * BM) / dmodel;
        const bool ctx = u.pm * BM < mc; const int fcol0 = col0 - sect * dmodel;
        if (sect < 2) {
            const int gi = wc >> 1, blk0 = 2 * (wc & 1), off = 8 * fq;
            const int ocol = u.pn * BM + gi * HALF + blk0 * 32 + off, ofc = ocol - sect * dmodel;
#pragma unroll
            for (int ai = 0; ai < 2; ++ai)
#pragma unroll
                for (int m = 0; m < 4; ++m) { const int row = row0 + ai * HALF + m * 16; bf16_t* rowp = O + (size_t)row * ldc + ocol;
                    f32x4 x0 = acc[ai][0][m][0], x1 = acc[ai][0][m][1], y0 = acc[ai][1][m][0], y1 = acc[ai][1][m][1];
                    if (!ctx) { const float* rt = rope + ((size_t)((row - mc) % DEC_SEQ) * 64 + (blk0 ? 32 : 0) + off) * 2;
                        const f32x4 t0 = *(const f32x4*)rt, t1 = *(const f32x4*)(rt + 4), t2 = *(const f32x4*)(rt + 8), t3 = *(const f32x4*)(rt + 12);
                        const float cs[8] = {t0[0], t0[2], t1[0], t1[2], t2[0], t2[2], t3[0], t3[2]}, sn[8] = {t0[1], t0[3], t1[1], t1[3], t2[1], t2[3], t3[1], t3[3]};
#pragma unroll
                        for (int e = 0; e < 4; ++e) { const float a0 = x0[e], b0 = y0[e], a1 = x1[e], b1 = y1[e];
                            x0[e] = a0 * cs[e] - b0 * sn[e]; y0[e] = b0 * cs[e] + a0 * sn[e]; x1[e] = a1 * cs[4 + e] - b1 * sn[4 + e]; y1[e] = b1 * cs[4 + e] + a1 * sn[4 + e]; } }
                    u32x4 w; w.x = cvt_pk_bf16(x0[0], x0[1]); w.y = cvt_pk_bf16(x0[2], x0[3]); w.z = cvt_pk_bf16(x1[0], x1[1]); w.w = cvt_pk_bf16(x1[2], x1[3]); *(u32x4*)rowp = w;
                    w.x = cvt_pk_bf16(y0[0], y0[1]); w.y = cvt_pk_bf16(y0[2], y0[3]); w.z = cvt_pk_bf16(y1[0], y1[1]); w.w = cvt_pk_bf16(y1[2], y1[3]); *(u32x4*)(rowp + 32) = w;
                    if (sect == 1 && ctx) { float* fp = outk + (size_t)row * dmodel + ofc; *(f32x4*)fp = x0; *(f32x4*)(fp + 4) = x1; *(f32x4*)(fp + 32) = y0; *(f32x4*)(fp + 36) = y1; } }
        } else {
#pragma unroll
            for (int ai = 0; ai < 2; ++ai)
#pragma unroll
                for (int m = 0; m < 4; ++m) { const int row = row0 + ai * HALF + m * 16;
                    const int b = ctx ? row / SEQ : (row - mc) / DEC_SEQ, key = ctx ? row % SEQ : PAST + (row - mc) % DEC_SEQ, T = ctx ? SEQ : TMAX, pos = 32 * (key >> 5) + kperm32(key & 31);
                    bf16_t* vb = vtt + (ctx ? (size_t)0 : VTT_C) + (size_t)b * NH * VD * T + pos;
#pragma unroll
                    for (int bj = 0; bj < 2; ++bj) { const f32x4 v0 = acc[ai][bj][m][0], v1 = acc[ai][bj][m][1]; const int vc = fcol0 + bj * HALF;
                        if (ctx) { float* fp = outv + (size_t)row * dmodel + vc; *(f32x4*)fp = v0; *(f32x4*)(fp + 4) = v1; }
                        const unsigned w0 = cvt_pk_bf16(v0[0], v0[1]), w1 = cvt_pk_bf16(v0[2], v0[3]), w2 = cvt_pk_bf16(v1[0], v1[1]), w3 = cvt_pk_bf16(v1[2], v1[3]);
                        bf16_t* vp = vb + (size_t)vc * T;
                        vp[0] = (bf16_t)w0; vp[(size_t)T] = (bf16_t)(w0 >> 16); vp[(size_t)2 * T] = (bf16_t)w1; vp[(size_t)3 * T] = (bf16_t)(w1 >> 16);
                        vp[(size_t)4 * T] = (bf16_t)w2; vp[(size_t)5 * T] = (bf16_t)(w2 >> 16); vp[(size_t)6 * T] = (bf16_t)w3; vp[(size_t)7 * T] = (bf16_t)(w3 >> 16); } }
        }
    }
};
struct EpiGLU {
    static constexpr bool PERM = true, AFTER_DRAIN = false;
    bf16_t* O; const float* bias; int ldc, dmodel;
    __device__ __forceinline__ void operator()(const f32x4 (&acc)[2][2][4][2], const Unit& u, int wr, int wc, int fr, int fq) const {
        const int row0 = u.pm * BM + wr * 64 + fr, j0 = u.pn * HALF + wc * 32 + 8 * fq;
        f32x4 ba[2], bg[2];
#pragma unroll
        for (int n = 0; n < 2; ++n) { ba[n] = *(const f32x4*)(bias + j0 + 4 * n); bg[n] = *(const f32x4*)(bias + dmodel + j0 + 4 * n); }
#pragma unroll
        for (int ai = 0; ai < 2; ++ai)
#pragma unroll
            for (int m = 0; m < 4; ++m) { bf16_t* rowp = O + (size_t)(row0 + ai * HALF + m * 16) * ldc + j0; f32x4 r[2];
#pragma unroll
                for (int n = 0; n < 2; ++n) { const f32x4 a = acc[ai][0][m][n] + ba[n], g = acc[ai][1][m][n] + bg[n];
#pragma unroll
                    for (int e = 0; e < 4; ++e) r[n][e] = a[e] / (1.0f + __expf(-g[e])); }
                u32x4 w; w.x = cvt_pk_bf16(r[0][0], r[0][1]); w.y = cvt_pk_bf16(r[0][2], r[0][3]); w.z = cvt_pk_bf16(r[1][0], r[1][1]); w.w = cvt_pk_bf16(r[1][2], r[1][3]);
                *(u32x4*)rowp = w; }
    }
};
}

#define LAS __attribute__((address_space(3)))
#define XB_TMO      128
#define XB_XCNT(j)  (256  + 64 * (j))
#define XB_XSUB(j)  (1280 + 64 * (j))
#define XB_XGEN(j)  (2304 + 64 * (j))
#define XB_TOP      3328
#define XB_TOPGEN   3392
#define XCD_BAR_WORDS 3456
#define XB_SPIN_CAP (1u << 18)

__device__ __forceinline__ unsigned xb_ld(unsigned* p)              { return __hip_atomic_load(p, __ATOMIC_RELAXED, __HIP_MEMORY_SCOPE_AGENT); }
__device__ __forceinline__ unsigned xb_add(unsigned* p, unsigned v) { return __hip_atomic_fetch_add(p, v, __ATOMIC_RELAXED, __HIP_MEMORY_SCOPE_AGENT); }
__device__ __forceinline__ unsigned xb_xcc_id() { return (unsigned)__builtin_amdgcn_s_getreg((3 << 11) | 20) & 0xFu; }
#define XB_SPIN(cond, bar) do { unsigned _sp = 0; while (cond) { __builtin_amdgcn_s_sleep(1); \
    if ((++_sp & 255u) == 0u) { if (xb_ld(&(bar)[XB_TMO])) break; if (_sp > XB_SPIN_CAP) { atomicAdd(&(bar)[XB_TMO], 1u); break; } } } } while (0)

struct XcdBarrier {
    unsigned* bar; unsigned x;
    volatile LAS unsigned* st;
};

__device__ __forceinline__ XcdBarrier xcd_barrier_post(unsigned* bar, volatile LAS unsigned* st) {
    XcdBarrier b; b.bar = bar; b.x = xb_xcc_id(); b.st = st;
    if (threadIdx.x == 0) (void)xb_add(&bar[XB_XCNT(b.x)], 1u);
    return b;
}
__device__ __forceinline__ void xcd_barrier_complete(unsigned* bar, unsigned x, unsigned& nloc, unsigned& nx) {
    const unsigned G = gridDim.x * gridDim.y * gridDim.z;
    unsigned sum, cnt, mine, sp = 0u;
    for (;;) {
        sum = 0u; cnt = 0u; mine = 0u;
#pragma unroll
        for (unsigned j = 0; j < 16; ++j) { const unsigned c = xb_ld(&bar[XB_XCNT(j)]); sum += c; cnt += (c > 0u) ? 1u : 0u; mine = (j == x) ? c : mine; }
        if (sum == G) break;
        __builtin_amdgcn_s_sleep(1);
        if ((++sp & 255u) == 0u) { if (xb_ld(&bar[XB_TMO])) break; if (sp > XB_SPIN_CAP) { atomicAdd(&bar[XB_TMO], 1u); break; } }
    }
    nloc = mine > 0u ? mine : 1u; nx = cnt > 0u ? cnt : 1u;
}

__device__ __forceinline__ void xcd_barrier(const XcdBarrier& b) {
    asm volatile("s_waitcnt vmcnt(0)" ::: "memory");
    __syncthreads();
    if (threadIdx.x == 0) {
        unsigned* bar = b.bar;
        __builtin_amdgcn_s_waitcnt(0);
        unsigned nloc = b.st[0], nx = b.st[1];
        if (nloc == 0u) { xcd_barrier_complete(bar, b.x, nloc, nx); b.st[0] = nloc; b.st[1] = nx; }
        const unsigned old = xb_add(&bar[XB_XSUB(b.x)], 1u);
        const unsigned gen = old / nloc;
        if (old + 1u == (gen + 1u) * nloc) {
            __builtin_amdgcn_fence(__ATOMIC_RELEASE, "agent");
            asm volatile("s_waitcnt vmcnt(0)" ::: "memory");
            const unsigned og = xb_add(&bar[XB_TOP], 1u);
            const unsigned tg = og / nx;
            if (og + 1u == (tg + 1u) * nx) xb_add(&bar[XB_TOPGEN], 1u);
            else XB_SPIN(xb_ld(&bar[XB_TOPGEN]) == tg, bar);
            __builtin_amdgcn_fence(__ATOMIC_ACQUIRE, "agent");
            xb_add(&bar[XB_XGEN(b.x)], 1u);
            asm volatile("s_waitcnt vmcnt(0)" ::: "memory");
        } else {
            XB_SPIN(xb_ld(&bar[XB_XGEN(b.x)]) == gen, bar);
            __builtin_amdgcn_fence(__ATOMIC_ACQUIRE, "agent");
            asm volatile("s_waitcnt vmcnt(0)" ::: "memory");
        }
    }
    __syncthreads();
}

struct Bump { unsigned char* base; size_t off; template <class T> T* take(size_t n) { T* r = (T*)(base + off); off += (n * sizeof(T) + 255) & ~(size_t)255; return r; } };
static size_t carve(P& p, unsigned char* ws) {
    Bump b{ws, 0};
    p.CTL = b.take<unsigned>(CTL_BYTES / 4);
    p.Wt_mlp_in = b.take<bf16>((size_t)DEPTH * D * DFF); p.Wt_mlp_out = b.take<bf16>((size_t)DEPTH * D * DFF); p.Wt_hy_in = b.take<bf16>((size_t)NHY * D * 3 * D); p.Wt_hy_out = b.take<bf16>((size_t)NHY * D * D);
    p.Wt_qkv = b.take<bf16>((size_t)D * 3 * D); p.Wt_wo = b.take<bf16>((size_t)D * D); p.Wt_glu = b.take<bf16>((size_t)D * 2 * D);
    p.X = b.take<float>((size_t)M * D); p.MOD = b.take<float>((size_t)DEPTH * NCND * 6 * D); p.SCOND = b.take<float>((size_t)NCND * D); p.O = b.take<float>((size_t)M * D);
    p.HRAW = b.take<float>((size_t)NHY * LMAX * 2 * D); p.H1 = b.take<float>((size_t)NHY * LMAX * FW); p.H2 = b.take<float>((size_t)NHY * LMAX * FW); p.KINV = b.take<float>((size_t)NHY * 2 * D);
    p.KT = b.take<bf16>((size_t)NHY * KT_LAYER); p.S5BB = b.take<bf16>(S5_BBT); p.S5CM = b.take<bf16>(S5_CMT); p.S5LB = b.take<float>((size_t)2 * SGS * SP * 2); p.MV = b.take<float>((size_t)DEPTH * 2 * NCND * 3 * D); p.PS = b.take<float>((size_t)NHY * F3_NCH * 2 * D); p.PM = b.take<float>((size_t)MOD_KS * DEPTH * NCND * 6 * D); p.Ob = (bf16*)p.O; p.ObA = p.Ob + (size_t)M * D; p.RS = b.take<float>((size_t)2 * M); p.RT = b.take<float>((size_t)DEC_SEQ * 2 * QD * 2 + 16);
    p.KC = b.take<bf16>((size_t)DEC_BATCH * NAT * PAST * NH * 2 * HDIM); p.VTT = b.take<bf16>(VTT_ALL);
    p.XB = b.take<bf16>((size_t)M * D);
    p.H = b.take<bf16>((size_t)M * D); p.Z = b.take<bf16>((size_t)M * 3 * D); p.Z0 = p.Z; p.ZT = p.Z + (size_t)M * D;
    const size_t hid_off = b.off; p.HID = b.take<bf16>((size_t)M * DFF); const size_t hid_end = b.off;
    Bump o{ws, hid_off}; p.YF = o.take<float>((size_t)M * D); p.YB = o.take<float>((size_t)M * D); p.X0C = p.YF; p.VV = p.YB;
    Bump o2{ws, hid_off}; p.YT = o2.take<bf16>((size_t)D * M); p.TS = o2.take<bf16>(TS_ALL); p.X0Cb = p.YT; p.VT = p.YT;
    size_t end = hid_end; if (o.off > end) end = o.off; if (o2.off > end) end = o2.off; return end;
}
static void set_inputs(P& p, void* const* in) {
    const float** f = (const float**)&p.x_prompt; for (int i = 0; i < 42; ++i) f[i] = (const float*)in[i];
}


constexpr int LDS_BYTES = 147456;
constexpr int LDS_CTL_OFF = 146944;
constexpr int WAVE_LDS_BYTES = 16384;
static_assert(ATT_LDS_FLOATS * 4 <= WAVE_LDS_BYTES && 64 * 33 * 4 <= WAVE_LDS_BYTES, "per-wave scratch");

__device__ __forceinline__ void wtrans_items(const float* W, int K, int N, bf16* WT, float*, int gw, int nw, int lane, int mode = 0) {
    const int nblk = N / 64, nitems = (K / 64) * nblk, nq = lane & 15, kb = lane >> 4;
    for (int item = gw; item < nitems; item += nw) {
        const int kt = item / nblk, nb = item % nblk, k0 = 64 * kt + 16 * kb, n0 = 64 * nb; int r0 = n0; if (mode == 1) { const int Dm = N / 2, half = n0 / Dm, j = n0 % Dm; r0 = 256 * (j / 128) + 128 * half + (j % 128); }
        float4 v[16]; const float* src = W + (size_t)k0 * N + n0 + 4 * nq;
#pragma unroll
        for (int i = 0; i < 16; ++i) v[i] = *(const float4*)(src + (size_t)i * N);
        int rl = r0 + 4 * nq;
        if (mode == 2) { const int n = n0 + 4 * nq;
            if (n < 2 * (N / 3)) { const int r = n % 256, gi = r / 128, blk = (r % 128) / 32, off = r % 32; rl = (n - r) + (blk & 1) * 128 + gi * 64 + (blk >> 1) * 32 + off; } }
        bf16* dst = WT + (size_t)rl * K + k0;
#pragma unroll
        for (int e = 0; e < 4; ++e) {
#pragma unroll
            for (int hf = 0; hf < 2; ++hf) { uint4 o; const int b8 = 8 * hf;
#define WT_EL(i) (e == 0 ? v[i].x : e == 1 ? v[i].y : e == 2 ? v[i].z : v[i].w)
                o.x = f2bf(WT_EL(b8 + 0)) | ((unsigned)f2bf(WT_EL(b8 + 1)) << 16); o.y = f2bf(WT_EL(b8 + 2)) | ((unsigned)f2bf(WT_EL(b8 + 3)) << 16);
                o.z = f2bf(WT_EL(b8 + 4)) | ((unsigned)f2bf(WT_EL(b8 + 5)) << 16); o.w = f2bf(WT_EL(b8 + 6)) | ((unsigned)f2bf(WT_EL(b8 + 7)) << 16);
#undef WT_EL
                *(uint4*)(dst + (size_t)e * K + b8) = o; } }
    }
}

struct Args { P p; int ph_lo, ph_hi, li, pad; };

__global__ void __launch_bounds__(512, 2) fwd(Args args) {
    extern __shared__ __attribute__((aligned(16))) unsigned char lds[];
    const P& p = args.p;
    const int tid = threadIdx.x, lane = tid & 63, wave = __builtin_amdgcn_readfirstlane(tid >> 6), G = gridDim.x;
    volatile LAS unsigned* lctl = (volatile LAS unsigned*)((LAS unsigned char*)lds + LDS_CTL_OFF);
    if (tid < 64) lctl[tid] = 0u;
    __syncthreads();
    XcdBarrier bar = xcd_barrier_post(p.CTL + args.li * 4096, lctl + 8);
    float* wscr = (float*)(lds + wave * WAVE_LDS_BYTES);
    const int gw = blockIdx.x * 8 + wave, nw = G * 8;
    const int lo = args.ph_lo, hi = args.ph_hi;
    int ph = 0;
#define PH_BEGIN if (lo <= ph && ph < hi) {
#define PH_END   if (ph + 1 < hi) xcd_barrier(bar); } ++ph;
#define ELEM(F, a0, a1, n) do { for (size_t i = (size_t)blockIdx.x * 512 + tid; i < (size_t)(n); i += (size_t)G * 512) F::run(p, a0, a1, i); } while (0)
#define WAVE(F, a0, a1) do { for (int it = gw; it < F::NITEMS; it += nw) F::run(p, a0, a1, it, wscr); } while (0)
#define BLOCK(F, a0, a1) do { for (int it = blockIdx.x; it < F::NITEMS; it += G) F::run(p, a0, a1, it, (float*)lds); } while (0)
#define BLOCK1(F, a0) F::run(p, a0, G, (int)blockIdx.x, (float*)lds)
#define WTR(W, K, N, WT) wtrans_items(W, K, N, WT, wscr, gw, nw, lane)
#define WTRM(W, K, N, WT, mode) wtrans_items(W, K, N, WT, wscr, gw, nw, lane, mode)
#define GEMM_RUNM(EPI, A, Bt, MM, N, K, ...) do { pg8::Gemm g{A, Bt, MM, N, K, 0}; pg8::StaticOrder S; S.init(MM, N, G, (int)blockIdx.x); pg8::EPI E{__VA_ARGS__}; \
        pg8::gemm_phase<pg8::EPI, pg8::StaticOrder, true, true>((PG8_LAS unsigned char*)lds, g, S, E); } while (0)
#define GEMM_RUN(EPI, A, Bt, N, K, ...) do { pg8::Gemm g{A, Bt, M, N, K, 0}; pg8::StaticOrder S; S.init(M, N, G, (int)blockIdx.x); pg8::EPI E{__VA_ARGS__}; \
        pg8::gemm_phase<pg8::EPI, pg8::StaticOrder, true, true>((PG8_LAS unsigned char*)lds, g, S, E); } while (0)
#define GEMM_B16(A, Bt, N, K, C, ldc, bias) GEMM_RUN(EpiB16, A, Bt, N, K, C, bias, ldc, 0)
#define GEMM_RELU2(A, Bt, N, K, C, ldc) GEMM_RUN(EpiRelu2, A, Bt, N, K, C, ldc, 0)
#define GEMM_QKV(A, Bt, C) GEMM_RUN(EpiQKV, A, Bt, 3 * D, D, C, p.out + OUT_K, p.out + OUT_V, p.VTT, p.RT, 3 * D, D, MC, 0)
#define GEMM_GLU(A, Bt, C, bias) GEMM_RUN(EpiGLU, A, Bt, 2 * D, D, C, bias, D, D)

    PH_BEGIN
        { float* sc = (float*)lds;
          for (int i = tid; i < NCND * D; i += 512) { const int r = i / D, k = i % D; sc[i] = silu_f(r == 0 ? p.c_ctx[k] : p.c[(size_t)(r - 1) * D + k]); }
          __syncthreads();
          for (size_t i = (size_t)blockIdx.x * 512 + tid; i < (size_t)DEPTH * MOD_KS * 6 * D / 4; i += (size_t)G * 512) E_modp::body(p, sc, i);
          __syncthreads(); }
        ELEM(E_ropetab, 0, 0, (size_t)DEC_SEQ * 2 * QD); ELEM(E_kcvt8, 0, 0, (size_t)DEC_BATCH * NAT * PAST * NH * 2 * HDIM / 8); WAVE(W_vtransc, 0, 0); ELEM(E_s5tab, 0, 0, (size_t)2 * SGS * SP); ELEM(E_filt1, 0, 0, (size_t)NHY * LMAX * FW);
#pragma unroll 1
        for (int l = 0; l < DEPTH; ++l) { WTR(p.w_mlp_in + (size_t)l * D * DFF, D, DFF, p.Wt_mlp_in + (size_t)l * D * DFF); WTR(p.w_mlp_out + (size_t)l * D * DFF, DFF, D, p.Wt_mlp_out + (size_t)l * D * DFF); }
#pragma unroll 1
        for (int j = 0; j < NHY; ++j) { WTR(p.hy_w_in + (size_t)j * D * 3 * D, D, 3 * D, p.Wt_hy_in + (size_t)j * D * 3 * D); WTR(p.hy_w_out + (size_t)j * D * D, D, D, p.Wt_hy_out + (size_t)j * D * D); }
        WTRM(p.at_w_qkv, D, 3 * D, p.Wt_qkv, 2); WTR(p.at_w_o, D, D, p.Wt_wo); WTRM(p.s5_w_glu, D, 2 * D, p.Wt_glu, 1);
    PH_END
    PH_BEGIN ELEM(E_modvec2, 0, 0, (size_t)DEPTH * 2 * NCND * 3 * D); ELEM(E_filt2, 0, 0, (size_t)NHY * LMAX * FW); PH_END
    PH_BEGIN ELEM(E_filt3c, 0, 0, (size_t)NHY * F3_NCH * 2 * D); WAVE(W_thin2, -1, 0 * 8 + 0); PH_END
    PH_BEGIN ELEM(E_fk2, 0, 0, (size_t)NHY * (FK_NC0 + FK_NC1) * D); GEMM_B16(p.H, p.Wt_hy_in + (size_t)0 * D * 3 * D, D, D, p.Z0, D, p.hy_b_in + (size_t)0 * 3 * D); __syncthreads();
        GEMM_RUNM(EpiB16R, p.Wt_hy_in + (size_t)0 * D * 3 * D + (size_t)D * D, p.H, 2 * D, M, D, p.ZT, p.hy_b_in + (size_t)0 * 3 * D + D, M, 0); PH_END
    PH_BEGIN BLOCK1(B_conv, 0); PH_END
    PH_BEGIN WAVE(W_hconv3y, 0, 0); PH_END
    PH_BEGIN GEMM_B16(p.H, p.Wt_hy_out + (size_t)0 * D * D, D, D, p.ObA, D, p.hy_b_out + (size_t)0 * D); PH_END
    PH_BEGIN WAVE(W_thin2, (0 * 8 + 0) | TH_MODE_A | TH_SRC_IN, 0 * 8 + 1); PH_END
    PH_BEGIN GEMM_RUNM(EpiRelu2, p.H + (size_t)0 * (M / 2) * D, p.Wt_mlp_in + (size_t)0 * D * DFF, M / 2, DFF, D, p.HID + (size_t)0 * (M / 2) * DFF, DFF, 0); PH_END
    PH_BEGIN GEMM_RUNM(EpiB16, p.HID + (size_t)0 * (M / 2) * DFF, p.Wt_mlp_out + (size_t)0 * D * DFF, M / 2, D, DFF, p.Ob + (size_t)0 * (M / 2) * D, nullptr, D, 0); __syncthreads();
        GEMM_RUNM(EpiRelu2, p.H + (size_t)1 * (M / 2) * D, p.Wt_mlp_in + (size_t)0 * D * DFF, M / 2, DFF, D, p.HID + (size_t)1 * (M / 2) * DFF, DFF, 0); PH_END
    PH_BEGIN GEMM_RUNM(EpiB16, p.HID + (size_t)1 * (M / 2) * DFF, p.Wt_mlp_out + (size_t)0 * D * DFF, M / 2, D, DFF, p.Ob + (size_t)1 * (M / 2) * D, nullptr, D, 0); PH_END
    PH_BEGIN WAVE(W_thin2, (0 * 8 + 1) | TH_MODE_B | TH_SRC_IN, 1 * 8 + 0); PH_END
    PH_BEGIN GEMM_QKV(p.H, p.Wt_qkv, p.Z); PH_END
    PH_BEGIN BLOCK(B_attn, 0, 0); PH_END
    PH_BEGIN GEMM_B16(p.H, p.Wt_wo, D, D, p.ObA, D, nullptr); PH_END
    PH_BEGIN WAVE(W_thin2, (1 * 8 + 0) | TH_MODE_A, 1 * 8 + 1); PH_END
    PH_BEGIN GEMM_RUNM(EpiRelu2, p.H + (size_t)0 * (M / 2) * D, p.Wt_mlp_in + (size_t)1 * D * DFF, M / 2, DFF, D, p.HID + (size_t)0 * (M / 2) * DFF, DFF, 0); PH_END
    PH_BEGIN GEMM_RUNM(EpiB16, p.HID + (size_t)0 * (M / 2) * DFF, p.Wt_mlp_out + (size_t)1 * D * DFF, M / 2, D, DFF, p.Ob + (size_t)0 * (M / 2) * D, nullptr, D, 0); __syncthreads();
        GEMM_RUNM(EpiRelu2, p.H + (size_t)1 * (M / 2) * D, p.Wt_mlp_in + (size_t)1 * D * DFF, M / 2, DFF, D, p.HID + (size_t)1 * (M / 2) * DFF, DFF, 0); PH_END
    PH_BEGIN GEMM_RUNM(EpiB16, p.HID + (size_t)1 * (M / 2) * DFF, p.Wt_mlp_out + (size_t)1 * D * DFF, M / 2, D, DFF, p.Ob + (size_t)1 * (M / 2) * D, nullptr, D, 0); PH_END
    PH_BEGIN WAVE(W_thin2, (1 * 8 + 1) | TH_MODE_B, 2 * 8 + 0); PH_END
    PH_BEGIN WAVE(W_s5f, 0, 0); PH_END
    PH_BEGIN GEMM_GLU(p.H, p.Wt_glu, p.ObA, p.s5_b_glu); PH_END
    PH_BEGIN WAVE(W_thin2, (2 * 8 + 0) | TH_MODE_A, 2 * 8 + 1); PH_END
    PH_BEGIN GEMM_RUNM(EpiRelu2, p.H + (size_t)0 * (M / 2) * D, p.Wt_mlp_in + (size_t)2 * D * DFF, M / 2, DFF, D, p.HID + (size_t)0 * (M / 2) * DFF, DFF, 0); PH_END
    PH_BEGIN GEMM_RUNM(EpiB16, p.HID + (size_t)0 * (M / 2) * DFF, p.Wt_mlp_out + (size_t)2 * D * DFF, M / 2, D, DFF, p.Ob + (size_t)0 * (M / 2) * D, nullptr, D, 0); __syncthreads();
        GEMM_RUNM(EpiRelu2, p.H + (size_t)1 * (M / 2) * D, p.Wt_mlp_in + (size_t)2 * D * DFF, M / 2, DFF, D, p.HID + (size_t)1 * (M / 2) * DFF, DFF, 0); PH_END
    PH_BEGIN GEMM_RUNM(EpiB16, p.HID + (size_t)1 * (M / 2) * DFF, p.Wt_mlp_out + (size_t)2 * D * DFF, M / 2, D, DFF, p.Ob + (size_t)1 * (M / 2) * D, nullptr, D, 0); PH_END
    PH_BEGIN WAVE(W_thin2, (2 * 8 + 1) | TH_MODE_B, 3 * 8 + 0); PH_END
    PH_BEGIN GEMM_B16(p.H, p.Wt_hy_in + (size_t)1 * D * 3 * D, D, D, p.Z0, D, p.hy_b_in + (size_t)1 * 3 * D); __syncthreads();
        GEMM_RUNM(EpiB16R, p.Wt_hy_in + (size_t)1 * D * 3 * D + (size_t)D * D, p.H, 2 * D, M, D, p.ZT, p.hy_b_in + (size_t)1 * 3 * D + D, M, 0); PH_END
    PH_BEGIN BLOCK1(B_conv, 1); PH_END
    PH_BEGIN WAVE(W_hconv3y, 1, 0); PH_END
    PH_BEGIN GEMM_B16(p.H, p.Wt_hy_out + (size_t)1 * D * D, D, D, p.ObA, D, p.hy_b_out + (size_t)1 * D); PH_END
    PH_BEGIN WAVE(W_thin2, (3 * 8 + 0) | TH_MODE_A, 3 * 8 + 1); PH_END
    PH_BEGIN GEMM_RUNM(EpiRelu2, p.H + (size_t)0 * (M / 2) * D, p.Wt_mlp_in + (size_t)3 * D * DFF, M / 2, DFF, D, p.HID + (size_t)0 * (M / 2) * DFF, DFF, 0); PH_END
    PH_BEGIN GEMM_RUNM(EpiB16, p.HID + (size_t)0 * (M / 2) * DFF, p.Wt_mlp_out + (size_t)3 * D * DFF, M / 2, D, DFF, p.Ob + (size_t)0 * (M / 2) * D, nullptr, D, 0); __syncthreads();
        GEMM_RUNM(EpiRelu2, p.H + (size_t)1 * (M / 2) * D, p.Wt_mlp_in + (size_t)3 * D * DFF, M / 2, DFF, D, p.HID + (size_t)1 * (M / 2) * DFF, DFF, 0); PH_END
    PH_BEGIN GEMM_RUNM(EpiB16, p.HID + (size_t)1 * (M / 2) * DFF, p.Wt_mlp_out + (size_t)3 * D * DFF, M / 2, D, DFF, p.Ob + (size_t)1 * (M / 2) * D, nullptr, D, 0); PH_END
    PH_BEGIN WAVE(W_thin2, (3 * 8 + 1) | TH_MODE_B, -1); PH_END
}

extern "C" void kernel_launch(void* const* d_in, const int* in_sizes, int n_in, void* d_out, int out_size, void* d_ws, size_t ws_size, hipStream_t stream) {
    static int grid = 0;
    Args a{}; set_inputs(a.p, d_in); a.p.out = (float*)d_out;
    const size_t need = carve(a.p, (unsigned char*)d_ws);
    if (grid == 0) {
        if (n_in != 42 || (size_t)out_size != OUT_END || need > ws_size) { fprintf(stderr, "kernel_launch: unexpected sizes: n_in %d out %d ws %zu (need %zu)\n", n_in, out_size, ws_size, need); grid = -1; return; }
        int dev = 0, cus = 0, per_cu = 0;
        if (hipGetDevice(&dev) != hipSuccess || hipDeviceGetAttribute(&cus, hipDeviceAttributeMultiprocessorCount, dev) != hipSuccess) { grid = -1; return; }
        if (hipFuncSetAttribute((const void*)fwd, hipFuncAttributeMaxDynamicSharedMemorySize, LDS_BYTES) != hipSuccess) { fprintf(stderr, "kernel_launch: hipFuncSetAttribute failed\n"); grid = -1; return; }
        if (hipOccupancyMaxActiveBlocksPerMultiprocessor(&per_cu, (const void*)fwd, 512, LDS_BYTES) != hipSuccess || per_cu < 1) fprintf(stderr, "kernel_launch: occupancy query reports %d workgroups per CU\n", per_cu);
        (void)hipGetLastError();
        grid = cus;
    }
    if (grid < 0) return;
    if (hipMemsetAsync(a.p.CTL, 0, CTL_BYTES, stream) != hipSuccess) return;
    a.ph_lo = 0; a.ph_hi = 36; a.li = 0; a.pad = 0;
    hipLaunchKernelGGL(fwd, dim3(grid), dim3(512), LDS_BYTES, stream, a);
}
#endif
```

```cpp
#ifdef HOST_EMU
#include <cstdio>
#include <cstdlib>
#include <cstring>
#include <cmath>
#include <vector>
#define HD
#else
#include <hip/hip_runtime.h>
#include <cstdio>
#define HD __host__ __device__ __forceinline__
#endif

typedef unsigned short bf16;

#ifdef SMALL_CFG
constexpr int D = 256, BATCH = 4, SEQ = 256, DEC_BATCH = 2, DEC_SEQ = 512, PAST = 64;
#else
constexpr int D = 2048, BATCH = 32, SEQ = 256, DEC_BATCH = 8, DEC_SEQ = 1024, PAST = 512;
#endif
constexpr int DEPTH = 4, NHY = 2, NAT = 1, NSS = 1, DFF = 4 * D, GRID_W = 64;
constexpr int NH = 8, HDIM = D / NH / 2, VD = 2 * HDIM, QD = HDIM / 4;
constexpr int SG = 16, SGS = D / SG, SP = 64;
constexpr int MC = BATCH * SEQ, ML = DEC_BATCH * DEC_SEQ, M = MC + ML, NCND = 1 + DEC_BATCH;
constexpr int LMAX = DEC_SEQ > SEQ ? DEC_SEQ : SEQ;
constexpr int FW = 64, PEB = 16;
constexpr int TMAX = PAST + DEC_SEQ;
constexpr float NORM_EPS = 1e-6f;
constexpr int ATT_LAYER = 1;

struct P {
    const float *x_prompt, *x_sample, *cache_k, *cache_v, *st_re, *st_im, *c, *c_ctx, *w_mod, *b_mod, *g_norm, *w_mlp_in, *w_mlp_out,
        *hy_w_in, *hy_b_in, *hy_w_short, *hy_b_short, *hy_f_w1, *hy_f_b1, *hy_f_freq1, *hy_f_w2, *hy_f_b2, *hy_f_freq2, *hy_f_w3, *hy_log_alpha, *hy_skip, *hy_w_out, *hy_b_out,
        *at_w_qkv, *at_lam, *at_g_sub, *at_w_o, *s5_lam_re, *s5_lam_im, *s5_log_dt, *s5_b_re, *s5_b_im, *s5_c_re, *s5_c_im, *s5_d, *s5_w_glu, *s5_b_glu;
    float* out;
    float *X, *MOD, *SCOND, *O, *HRAW, *H1, *H2, *KINV, *X0C, *VV, *YF, *YB;
    bf16 *XB, *H, *Z, *HID, *Wt_mlp_in, *Wt_mlp_out, *Wt_hy_in, *Wt_hy_out, *Wt_qkv, *Wt_wo, *Wt_glu;
    bf16 *KT, *TS, *X0Cb, *VT, *YT, *KC, *VTT, *S5BB, *S5CM, *Z0, *ZT;
    float *S5LB, *MV, *PS, *PM, *RS, *RT;
    bf16 *Ob, *ObA;
    unsigned* CTL;
};
constexpr size_t CTL_BYTES = 65536;
constexpr size_t OUT_YC = 0, OUT_YL = (size_t)MC * D, OUT_K = (size_t)M * D, OUT_V = OUT_K + (size_t)MC * D, OUT_SRE = OUT_V + (size_t)MC * D, OUT_SIM = OUT_SRE + (size_t)BATCH * NSS * 2 * SGS * SP,
                 OUT_END = OUT_SIM + (size_t)BATCH * NSS * 2 * SGS * SP;

HD float bf2f(bf16 b) { unsigned u = ((unsigned)b) << 16; float f; __builtin_memcpy(&f, &u, 4); return f; }
HD bf16 f2bf(float f) { unsigned u; __builtin_memcpy(&u, &f, 4); u += 0x7fffu + ((u >> 16) & 1u); return (bf16)(u >> 16); }
#ifdef HOST_EMU
static inline unsigned pk2bf(float lo, float hi) { return (unsigned)f2bf(lo) | ((unsigned)f2bf(hi) << 16); }
#else
__device__ __forceinline__ unsigned pk2bf(float lo, float hi) { unsigned r; asm volatile("v_cvt_pk_bf16_f32 %0, %1, %2" : "=v"(r) : "v"(lo), "v"(hi)); return r; }
#endif
HD float rsq(float x) { return 1.0f / sqrtf(x); }
HD float silu_f(float v) { return v / (1.0f + expf(-v)); }
#ifdef HOST_EMU
static inline float gelu_tanh_f(float x) { const float u = 0.7978845608028654f * (x + 0.044715f * x * x * x); return x / (1.0f + expf(-2.0f * u)); }
#else
__device__ __forceinline__ float gelu_tanh_f(float x) { const float u = 0.7978845608028654f * (x + 0.044715f * x * x * x); return x * __builtin_amdgcn_rcpf(1.0f + __builtin_amdgcn_exp2f(-2.8853900817779268f * u)); }
#endif
HD void row_info(int row, int& seq0, int& t, int& L, int& cls, int& b) {
    if (row < MC) { b = row / SEQ; t = row % SEQ; L = SEQ; cls = 0; } else { const int r = row - MC; b = r / DEC_SEQ; t = r % DEC_SEQ; L = DEC_SEQ; cls = 1; }
    seq0 = row - t;
}

#ifdef HOST_EMU
#define WAVE_FOR for (int lane = 0; lane < 64; ++lane)
#define LI lane
#define NL 64
#define WAVE_SYNC() do { } while (0)
#define WAVE_SYNC_LDS() do { } while (0)
static inline void wsum_h(float* v) { float s = 0.f; for (int l = 0; l < 64; ++l) s += v[l]; for (int l = 0; l < 64; ++l) v[l] = s; }
static inline void wmax_h(float* v) { float s = v[0]; for (int l = 1; l < 64; ++l) s = v[l] > s ? v[l] : s; for (int l = 0; l < 64; ++l) v[l] = s; }
#define wsum(a) wsum_h(a)
#define wmax(a) wmax_h(a)
#else
#define WAVE_FOR for (int lane = (int)(threadIdx.x & 63), _once = 1; _once; _once = 0)
#define LI 0
#define NL 1
#define WAVE_SYNC() do { asm volatile("s_waitcnt vmcnt(0) lgkmcnt(0)" ::: "memory"); __builtin_amdgcn_wave_barrier(); } while (0)
#define WAVE_SYNC_LDS() do { asm volatile("s_waitcnt lgkmcnt(0)" ::: "memory"); __builtin_amdgcn_wave_barrier(); } while (0)
__device__ __forceinline__ float wsum_d(float s) {
#pragma unroll
    for (int o = 1; o < 64; o <<= 1) s += __shfl_xor(s, o);
    return s; }
__device__ __forceinline__ float wmax_d(float s) {
#pragma unroll
    for (int o = 1; o < 64; o <<= 1) { const float t = __shfl_xor(s, o); s = t > s ? t : s; }
    return s; }
#define wsum(a) ((a)[0] = wsum_d((a)[0]))
#define wmax(a) ((a)[0] = wmax_d((a)[0]))
#endif

struct E_copyx { static HD void run(const P& p, int, int, size_t i) { p.X[i] = i < (size_t)MC * D ? p.x_prompt[i] : p.x_sample[i - (size_t)MC * D]; } };
struct E_scond { static HD void run(const P& p, int, int, size_t i) { const int r = (int)(i / D), k = (int)(i % D); const float v = r == 0 ? p.c_ctx[k] : p.c[(size_t)(r - 1) * D + k]; p.SCOND[i] = silu_f(v); } };
struct E_mod { static HD void run(const P& p, int, int, size_t i) {
    const int n = (int)(i % (6 * D)), r = (int)((i / (6 * D)) % NCND), l = (int)(i / ((size_t)6 * D * NCND));
    const float* w = p.w_mod + (size_t)l * D * 6 * D + n; const float* s = p.SCOND + (size_t)r * D;
    float acc = 0.f; for (int k = 0; k < D; ++k) acc += s[k] * w[(size_t)k * 6 * D];
    p.MOD[i] = acc + p.b_mod[(size_t)l * 6 * D + n]; } };
struct E_relu2 { static HD void run(const P& p, int, int, size_t i) { float v = bf2f(p.HID[i]); v = v > 0.f ? v : 0.f; p.HID[i] = f2bf(v * v); } };

struct E_filt1 { static HD void run(const P& p, int, int, size_t i) {
    const int w = (int)(i % FW), t = (int)((i / FW) % LMAX), j = (int)(i / ((size_t)FW * LMAX));
    float acc = p.hy_f_b1[j * FW + w];
    for (int k = 0; k < 2 * PEB; ++k) { const int band = k % PEB; const float per = 2.0f * powf(2048.0f, (float)band / (float)(PEB - 1)); const float ang = (float)t * (6.283185307179586f / per);
        const float pe = k < PEB ? sinf(ang) : cosf(ang); acc += pe * p.hy_f_w1[((size_t)j * 2 * PEB + k) * FW + w]; }
    p.H1[i] = sinf(p.hy_f_freq1[j * FW + w] * acc); } };
struct E_filt2 { static HD void run(const P& p, int, int, size_t i) {
    const int w = (int)(i % FW), t = (int)((i / FW) % LMAX), j = (int)(i / ((size_t)FW * LMAX));
    float acc = p.hy_f_b2[j * FW + w]; const float* h1 = p.H1 + ((size_t)j * LMAX + t) * FW;
    for (int v = 0; v < FW; ++v) acc += h1[v] * p.hy_f_w2[((size_t)j * FW + v) * FW + w];
    p.H2[i] = sinf(p.hy_f_freq2[j * FW + w] * acc); } };
struct E_filt3 { static HD void run(const P& p, int, int, size_t i) {
    const int col = (int)(i % (2 * D)), t = (int)((i / (2 * D)) % LMAX), j = (int)(i / ((size_t)2 * D * LMAX)), d = col % D;
    const float* h2 = p.H2 + ((size_t)j * LMAX + t) * FW; float acc = 0.f;
    for (int w = 0; w < FW; ++w) acc += h2[w] * p.hy_f_w3[((size_t)j * FW + w) * 2 * D + col];
    p.HRAW[i] = acc * expf(-expf(p.hy_log_alpha[j * D + d]) * (float)t); } };
struct E_filtnorm { static HD void run(const P& p, int, int, size_t i) {
    const int d = (int)(i % D), cls = (int)((i / D) % 2), j = (int)(i / (2 * D)), L = cls ? DEC_SEQ : SEQ;
    const float* h = p.HRAW + (size_t)j * LMAX * 2 * D; float s = 0.f;
    for (int t = 0; t < L; ++t) { s += fabsf(h[(size_t)t * 2 * D + d]); if (t >= 1) s += fabsf(h[(size_t)t * 2 * D + D + d]); }
    p.KINV[i] = 1.0f / (s + 1e-6f); } };
struct E_hconv1 { static HD void run(const P& p, int j, int, size_t i) {
    const int row = (int)(i / D), c = (int)(i % D); int seq0, t, L, cls, b; row_info(row, seq0, t, L, cls, b);
    float zc[3];
    for (int blk = 0; blk < 3; ++blk) { const int col = blk * D + c; const float* ws = p.hy_w_short + (size_t)j * 3 * 3 * D;
        const float zp = t > 0 ? bf2f(p.Z[(size_t)(row - 1) * 3 * D + col]) : 0.f, z0 = bf2f(p.Z[(size_t)row * 3 * D + col]), zn = t < L - 1 ? bf2f(p.Z[(size_t)(row + 1) * 3 * D + col]) : 0.f;
        zc[blk] = zp * ws[col] + z0 * ws[3 * D + col] + zn * ws[2 * 3 * D + col] + p.hy_b_short[(size_t)j * 3 * D + col]; }
    p.X0C[i] = zc[0]; p.VV[i] = zc[2] * zc[1]; } };
struct E_hconv2 { static HD void run(const P& p, int j, int, size_t i) {
    const int row = (int)(i / D), c = (int)(i % D); int seq0, t, L, cls, b; row_info(row, seq0, t, L, cls, b);
    const float* h = p.HRAW + (size_t)j * LMAX * 2 * D; float y = 0.f;
    for (int s = 0; s < L; ++s) { const int jj = t - s; const float k = jj >= 0 ? h[(size_t)jj * 2 * D + c] : h[(size_t)(-jj) * 2 * D + D + c]; y += k * p.VV[(size_t)(seq0 + s) * D + c]; }
    y *= p.KINV[((size_t)j * 2 + cls) * D + c]; y += p.VV[i] * p.hy_skip[j * D + c];
    p.H[i] = f2bf(p.X0C[i] * y); } };

struct E_newkv { static HD void run(const P& p, int, int, size_t i) { const int row = (int)(i / D), c = (int)(i % D);
    p.out[OUT_K + i] = bf2f(p.Z[(size_t)row * 3 * D + D + c]); p.out[OUT_V + i] = bf2f(p.Z[(size_t)row * 3 * D + 2 * D + c]); } };
struct E_rope { static HD void run(const P& p, int, int, size_t i) {
    size_t r = i; const int e = (int)(r % (2 * QD)); r /= 2 * QD; const int comp = (int)(r % 2); r /= 2; const int h = (int)(r % NH); r /= NH; const int which = (int)(r % 2); r /= 2; const int lrow = (int)r;
    const int grp = e / QD, ii = e % QD, t = lrow % DEC_SEQ, gr = t / GRID_W, gc = t % GRID_W;
    const float inv = powf(10000.0f, -(float)(2 * ii) / (float)(HDIM / 2)), ang = (float)(grp == 0 ? gr : gc) * inv, cs = cosf(ang), sn = sinf(ang);
    bf16* z = p.Z + (size_t)(MC + lrow) * 3 * D + which * D + h * 2 * HDIM + comp * HDIM + grp * 2 * QD + ii;
    const float a = bf2f(z[0]), bb = bf2f(z[QD]); z[0] = f2bf(a * cs - bb * sn); z[QD] = f2bf(bb * cs + a * sn); } };
struct E_s5comb { static HD void run(const P& p, int, int, size_t i) { const int c = (int)(i % D); const float u = bf2f(p.H[i]); p.H[i] = f2bf(gelu_tanh_f(p.s5_d[c] * u + p.YF[i] + p.YB[i])); } };
struct E_glu { static HD void run(const P& p, int, int, size_t i) { const int row = (int)(i / D), c = (int)(i % D); const float a = bf2f(p.Z[(size_t)row * 2 * D + c]), g = bf2f(p.Z[(size_t)row * 2 * D + D + c]);
    p.O[i] = a / (1.0f + expf(-g)); } };

struct W_thin { static constexpr int NITEMS = M; static HD void run(const P& p, int a0, int a1, int row, float*  ) {
    const int midx = row < MC ? 0 : 1 + (row - MC) / DEC_SEQ; const bool fin = a1 < 0; float* xout = fin ? p.out : p.X;
    float ss[NL];
    if (a0 >= 0) { const int l = a0 >> 3, wh = a0 & 7; const float* g = p.g_norm + ((size_t)l * 4 + (wh ? 3 : 1)) * D; const float* gate = p.MOD + (((size_t)l * NCND + midx) * 6 + (wh ? 5 : 2)) * D;
        WAVE_FOR { float s = 0.f; for (int c = lane; c < D; c += 64) { const float o = p.O[(size_t)row * D + c]; s += o * o; } ss[LI] = s; }
        wsum(ss);
        WAVE_FOR { const float rstd = rsq(ss[LI] / (float)D + NORM_EPS); for (int c = lane; c < D; c += 64) xout[(size_t)row * D + c] = p.X[(size_t)row * D + c] + gate[c] * (p.O[(size_t)row * D + c] * rstd * g[c]); } }
    if (a1 >= 0) { const int l = a1 >> 3, wh = a1 & 7; const float* g = p.g_norm + ((size_t)l * 4 + (wh ? 2 : 0)) * D; const float* sh = p.MOD + (((size_t)l * NCND + midx) * 6 + (wh ? 3 : 0)) * D; const float* sc = sh + D;
        WAVE_FOR { float s = 0.f; for (int c = lane; c < D; c += 64) { const float x = p.X[(size_t)row * D + c]; s += x * x; } ss[LI] = s; }
        wsum(ss);
        WAVE_FOR { const float rstd = rsq(ss[LI] / (float)D + NORM_EPS); for (int c = lane; c < D; c += 64) p.H[(size_t)row * D + c] = f2bf(p.X[(size_t)row * D + c] * rstd * g[c] * (1.0f + sc[c]) + sh[c]); } }
} };

constexpr int ATT_LDS_FLOATS = 2 * TMAX + 2 * HDIM + VD;
struct W_attn { static constexpr int NITEMS = M * NH; static HD void run(const P& p, int, int, int item, float* lds) {
    const int row = item / NH, h = item % NH; int seq0, t, L, cls, b; row_info(row, seq0, t, L, cls, b);
    const int T = cls ? PAST + DEC_SEQ : SEQ; const float scale = 1.0f / sqrtf((float)HDIM);
    const float lam_init = 0.8f - 0.6f * expf(-0.3f * (float)ATT_LAYER);
    float s01 = 0.f, s23 = 0.f; for (int d = 0; d < HDIM; ++d) { s01 += p.at_lam[d] * p.at_lam[HDIM + d]; s23 += p.at_lam[2 * HDIM + d] * p.at_lam[3 * HDIM + d]; }
    const float lam = expf(s01) - expf(s23) + lam_init;
    float* s0 = lds; float* s1 = lds + TMAX; float* q = lds + 2 * TMAX; float* ov = q + 2 * HDIM;
    WAVE_FOR { for (int d = lane; d < 2 * HDIM; d += 64) q[d] = bf2f(p.Z[(size_t)row * 3 * D + h * 2 * HDIM + d]); }
    WAVE_SYNC();
    float m0[NL], m1[NL], l0[NL], l1[NL];
    WAVE_FOR { float mx0 = -3.0e38f, mx1 = -3.0e38f;
        for (int kk = lane; kk < T; kk += 64) { float d0 = 0.f, d1 = 0.f;
            if (cls && kk < PAST) { const float* kp = p.cache_k + (((size_t)b * NAT * PAST + kk) * NH + h) * 2 * HDIM; for (int d = 0; d < HDIM; ++d) { d0 += q[d] * kp[d]; d1 += q[HDIM + d] * kp[HDIM + d]; } }
            else { const bf16* kp = p.Z + (size_t)(seq0 + (cls ? kk - PAST : kk)) * 3 * D + D + h * 2 * HDIM; for (int d = 0; d < HDIM; ++d) { d0 += q[d] * bf2f(kp[d]); d1 += q[HDIM + d] * bf2f(kp[HDIM + d]); } }
            d0 *= scale; d1 *= scale; s0[kk] = d0; s1[kk] = d1; mx0 = d0 > mx0 ? d0 : mx0; mx1 = d1 > mx1 ? d1 : mx1; }
        m0[LI] = mx0; m1[LI] = mx1; }
    wmax(m0); wmax(m1);
    WAVE_FOR { float a0 = 0.f, a1 = 0.f; for (int kk = lane; kk < T; kk += 64) { a0 += expf(s0[kk] - m0[LI]); a1 += expf(s1[kk] - m1[LI]); } l0[LI] = a0; l1[LI] = a1; }
    wsum(l0); wsum(l1);
    WAVE_FOR { for (int kk = lane; kk < T; kk += 64) s0[kk] = expf(s0[kk] - m0[LI]) / l0[LI] - lam * expf(s1[kk] - m1[LI]) / l1[LI]; }
    WAVE_SYNC();
    float sq[NL];
    WAVE_FOR { float ssq = 0.f;
        for (int e = lane; e < VD; e += 64) { float o = 0.f;
            for (int kk = 0; kk < T; ++kk) { float v;
                if (cls && kk < PAST) v = p.cache_v[(((size_t)b * NAT * PAST + kk) * NH + h) * VD + e];
                else v = bf2f(p.Z[(size_t)(seq0 + (cls ? kk - PAST : kk)) * 3 * D + 2 * D + h * VD + e]);
                o += s0[kk] * v; }
            ov[e] = o; ssq += o * o; }
        sq[LI] = ssq; }
    wsum(sq);
    WAVE_FOR { const float rstd = rsq(sq[LI] / (float)VD + NORM_EPS); for (int e = lane; e < VD; e += 64) p.H[(size_t)row * D + h * VD + e] = f2bf(ov[e] * rstd * p.at_g_sub[e] * (1.0f - lam_init)); }
    WAVE_SYNC();
} };

struct W_s5 { static constexpr int NITEMS = (BATCH + DEC_BATCH) * SGS * 2; static HD void run(const P& p, int, int, int item, float*  ) {
    const int dir = item & 1, g = (item >> 1) % SGS, sidx = (item >> 1) / SGS; const bool lat = sidx >= BATCH; const int b = lat ? sidx - BATCH : sidx;
    const int L = lat ? DEC_SEQ : SEQ, seq0 = lat ? MC + b * DEC_SEQ : b * SEQ;
    float lbr[NL], lbi[NL], xr[NL], xi[NL], bbr[NL][SG], bbi[NL][SG], cr[NL][SG], ci[NL][SG], part[SG][NL];
    WAVE_FOR { const int pp = lane; const size_t gp = ((size_t)dir * SGS + g) * SP + pp;
        float lre = p.s5_lam_re[gp]; lre = lre < -1e-4f ? lre : -1e-4f; const float lim = p.s5_lam_im[gp], dt = expf(p.s5_log_dt[dir * SGS + g]);
        const float er = expf(lre * dt), br_ = er * cosf(lim * dt), bi_ = er * sinf(lim * dt); lbr[LI] = br_; lbi[LI] = bi_;
        const float nr = br_ - 1.0f, ni = bi_, den = lre * lre + lim * lim, cfr = (nr * lre + ni * lim) / den, cfi = (ni * lre - nr * lim) / den;
#pragma unroll
        for (int h = 0; h < SG; ++h) { const float b_r = p.s5_b_re[gp * SG + h], b_i = p.s5_b_im[gp * SG + h]; bbr[LI][h] = cfr * b_r - cfi * b_i; bbi[LI][h] = cfr * b_i + cfi * b_r;
            cr[LI][h] = p.s5_c_re[(((size_t)dir * SGS + g) * SG + h) * SP + pp]; ci[LI][h] = p.s5_c_im[(((size_t)dir * SGS + g) * SG + h) * SP + pp]; }
        if (lat) { const size_t si = (((size_t)b * NSS) * 2 + dir) * SGS * SP + (size_t)g * SP + pp; xr[LI] = p.st_re[si]; xi[LI] = p.st_im[si]; } else { xr[LI] = 0.f; xi[LI] = 0.f; } }
    float* Y = dir ? p.YB : p.YF;
    for (int step = 0; step < L; ++step) { const int t = dir ? L - 1 - step : step; const size_t ro = (size_t)(seq0 + t) * D + g * SG;
        WAVE_FOR { float bur = 0.f, bui = 0.f;
#pragma unroll
            for (int h = 0; h < SG; ++h) { const float u = bf2f(p.H[ro + h]); bur += bbr[LI][h] * u; bui += bbi[LI][h] * u; }
            const float nxr = lbr[LI] * xr[LI] - lbi[LI] * xi[LI] + bur, nxi = lbr[LI] * xi[LI] + lbi[LI] * xr[LI] + bui; xr[LI] = nxr; xi[LI] = nxi;
#pragma unroll
            for (int h = 0; h < SG; ++h) part[h][LI] = nxr * cr[LI][h] - nxi * ci[LI][h]; }
#pragma unroll
        for (int h = 0; h < SG; ++h) wsum(part[h]);
        WAVE_FOR {
#pragma unroll
            for (int h = 0; h < SG; ++h) if (lane == h) Y[ro + h] = part[h][LI]; } }
    if (!lat) { WAVE_FOR { const size_t so = (((size_t)b * NSS) * 2 + dir) * SGS * SP + (size_t)g * SP + lane; p.out[OUT_SRE + so] = xr[LI]; p.out[OUT_SIM + so] = xi[LI]; } }
} };


#ifdef HOST_EMU
struct Frag8 { bf16 e[8]; bf16& operator[](int i) { return e[i]; } const bf16& operator[](int i) const { return e[i]; } };
struct Acc16 { float e[16]; float& operator[](int i) { return e[i]; } const float& operator[](int i) const { return e[i]; } };
struct Acc4 { float e[4]; float& operator[](int i) { return e[i]; } const float& operator[](int i) const { return e[i]; } };
static inline Frag8 ld_frag8(const bf16* p) { Frag8 f; memcpy(f.e, p, 16); return f; }
static inline Frag8 zero_frag8() { Frag8 f; memset(f.e, 0, 16); return f; }
static inline void st_frag8(bf16* p, const Frag8& f) { memcpy(p, f.e, 16); }
static inline void st4b(bf16* p, const float* v) { for (int e = 0; e < 4; ++e) p[e] = f2bf(v[e]); }
static inline Frag8 pack8(const float* v) { Frag8 f; for (int e = 0; e < 8; ++e) f.e[e] = f2bf(v[e]); return f; }
static inline void mfma32_h(Acc16* acc, const Frag8* a, const Frag8* b) {
    static float A[32][16], B[16][32];
    for (int l = 0; l < 64; ++l) for (int i = 0; i < 8; ++i) { A[l & 31][8 * (l >> 5) + i] = bf2f(a[l][i]); B[8 * (l >> 5) + i][l & 31] = bf2f(b[l][i]); }
    for (int l = 0; l < 64; ++l) for (int r = 0; r < 16; ++r) { const int row = (r & 3) + 8 * (r >> 2) + 4 * (l >> 5), col = l & 31; float s = acc[l][r]; for (int k = 0; k < 16; ++k) s += A[row][k] * B[k][col]; acc[l][r] = s; }
}
static inline void mfma16_h(Acc4* acc, const Frag8* a, const Frag8* b) {
    static float A[16][32], B[32][16];
    for (int l = 0; l < 64; ++l) for (int i = 0; i < 8; ++i) { A[l & 15][8 * (l >> 4) + i] = bf2f(a[l][i]); B[8 * (l >> 4) + i][l & 15] = bf2f(b[l][i]); }
    for (int l = 0; l < 64; ++l) for (int r = 0; r < 4; ++r) { const int row = 4 * (l >> 4) + r, col = l & 15; float s = acc[l][r]; for (int k = 0; k < 32; ++k) s += A[row][k] * B[k][col]; acc[l][r] = s; }
}
#define MFMA32(acc, a, b) mfma32_h(acc, a, b)
#define MFMA16(acc, a, b) mfma16_h(acc, a, b)
#else
typedef short Frag8 __attribute__((ext_vector_type(8)));
typedef float Acc16 __attribute__((ext_vector_type(16)));
typedef float Acc4 __attribute__((ext_vector_type(4)));
__device__ __forceinline__ Frag8 ld_frag8(const bf16* p) { return *(const Frag8*)p; }
__device__ __forceinline__ Frag8 zero_frag8() { return (Frag8){0, 0, 0, 0, 0, 0, 0, 0}; }
__device__ __forceinline__ void st_frag8(bf16* p, const Frag8& f) { *(Frag8*)p = f; }
__device__ __forceinline__ void st4b(bf16* p, const float* v) { uint2 o; o.x = pk2bf(v[0], v[1]); o.y = pk2bf(v[2], v[3]); *(uint2*)p = o; }
typedef unsigned U32x4v __attribute__((ext_vector_type(4)));
__device__ __forceinline__ Frag8 pack8(const float* v) { U32x4v u; u[0] = pk2bf(v[0], v[1]); u[1] = pk2bf(v[2], v[3]); u[2] = pk2bf(v[4], v[5]); u[3] = pk2bf(v[6], v[7]); return __builtin_bit_cast(Frag8, u); }
#define MFMA32(acc, a, b) ((acc)[0] = __builtin_amdgcn_mfma_f32_32x32x16_bf16((a)[0], (b)[0], (acc)[0], 0, 0, 0))
#define MFMA16(acc, a, b) ((acc)[0] = __builtin_amdgcn_mfma_f32_16x16x32_bf16((a)[0], (b)[0], (acc)[0], 0, 0, 0))
#endif

constexpr size_t KT_C = (size_t)D * 2 * SEQ, KT_L = (size_t)D * 2 * DEC_SEQ, KT_LAYER = KT_C + KT_L;
constexpr size_t TS_C = (size_t)D * 8 * 2 * SEQ, TS_L = (size_t)D * 8 * 2 * DEC_SEQ, TS_ALL = TS_C + TS_L;
HD size_t kt_off(int j, int cls, int c) { return (size_t)j * KT_LAYER + (cls ? KT_C + (size_t)c * 2 * DEC_SEQ : (size_t)c * 2 * SEQ); }
HD size_t ts_off(int cls, int c, int rho) { return cls ? TS_C + ((size_t)c * 8 + rho) * 2 * DEC_SEQ : ((size_t)c * 8 + rho) * 2 * SEQ; }
struct E_filtkt { static HD void run(const P& p, int, int, size_t i) {
    const int d = (int)(i % D), cls = (int)((i / D) % 2), j = (int)(i / (2 * D)), L = cls ? DEC_SEQ : SEQ;
    const float* h = p.HRAW + (size_t)j * LMAX * 2 * D; float s = 0.f;
    for (int t = 0; t < L; ++t) { s += fabsf(h[(size_t)t * 2 * D + d]); if (t >= 1) s += fabsf(h[(size_t)t * 2 * D + D + d]); }
    const float inv = 1.0f / (s + 1e-6f); p.KINV[i] = inv;
    bf16* kt = p.KT + kt_off(j, cls, d); kt[0] = 0;
    for (int t = 0; t < L; ++t) { kt[L + t] = f2bf(h[(size_t)t * 2 * D + d] * inv); if (t >= 1) kt[L - t] = f2bf(h[(size_t)t * 2 * D + D + d] * inv); } } };
struct E_taps { static HD void run(const P& p, int j, int, size_t i) {
    size_t e0 = i * 8; const int cls = e0 >= TS_C ? 1 : 0; if (cls) e0 -= TS_C; const int L = cls ? DEC_SEQ : SEQ;
    const int idx0 = (int)(e0 % (2 * L)), rho = (int)((e0 / (2 * L)) % 8), c = (int)(e0 / ((size_t)2 * L * 8));
    const bf16* kt = p.KT + kt_off(j, cls, c); bf16* ts = p.TS + ts_off(cls, c, rho) + idx0;
    for (int e = 0; e < 8; ++e) { const int jt = rho - (idx0 + e - L); ts[e] = (jt > -L && jt < L) ? kt[jt + L] : (bf16)0; } } };
struct W_hconv1t { static constexpr int NITEMS = (M / 64) * (D / 64); static HD void run(const P& p, int j, int, int item, float* ldsf) {
    bf16* tl = (bf16*)ldsf; const int ct = item % (D / 64), rt = item / (D / 64), row0 = rt * 64, c0 = ct * 64;
    int seq0, t0, L, cls, b; row_info(row0, seq0, t0, L, cls, b);
    WAVE_FOR { const int c = c0 + lane; float w[3][3], bs[3], prev[3], cur[3], nxt[3];
#pragma unroll
        for (int blk = 0; blk < 3; ++blk) { const int col = blk * D + c; const float* ws = p.hy_w_short + (size_t)j * 9 * D; w[blk][0] = ws[col]; w[blk][1] = ws[3 * D + col]; w[blk][2] = ws[6 * D + col]; bs[blk] = p.hy_b_short[(size_t)j * 3 * D + col];
            prev[blk] = t0 > 0 ? bf2f(p.Z[(size_t)(row0 - 1) * 3 * D + col]) : 0.f; cur[blk] = bf2f(p.Z[(size_t)row0 * 3 * D + col]); }
        for (int tt = 0; tt < 64; ++tt) { const int row = row0 + tt; float zc[3];
#pragma unroll
            for (int blk = 0; blk < 3; ++blk) { nxt[blk] = (t0 + tt < L - 1) ? bf2f(p.Z[(size_t)(row + 1) * 3 * D + blk * D + c]) : 0.f;
                zc[blk] = prev[blk] * w[blk][0] + cur[blk] * w[blk][1] + nxt[blk] * w[blk][2] + bs[blk]; prev[blk] = cur[blk]; cur[blk] = nxt[blk]; }
            p.X0Cb[(size_t)row * D + c] = f2bf(zc[0]); tl[lane * 66 + tt] = f2bf(zc[2] * zc[1]); } }
    WAVE_SYNC();
    WAVE_FOR { for (int ch = 0; ch < 64; ++ch) p.VT[(size_t)(c0 + ch) * M + row0 + lane] = tl[ch * 66 + lane]; }
    WAVE_SYNC();
} };
constexpr int CV_SPG_C = BATCH < 32 ? BATCH : 32, CV_TPG_C = 32 / CV_SPG_C, CV_NB_C = SEQ / 32, CV_NG_C = (BATCH / CV_SPG_C) * (CV_NB_C / CV_TPG_C);
constexpr int CV_SPG_L = DEC_BATCH < 32 ? DEC_BATCH : 32, CV_TPG_L = 32 / CV_SPG_L, CV_NB_L = DEC_SEQ / 32, CV_NG_L = (DEC_BATCH / CV_SPG_L) * (CV_NB_L / CV_TPG_L);
static_assert(CV_NG_C <= 8 && CV_NG_L <= 8 && CV_NB_C % CV_TPG_C == 0 && CV_NB_L % CV_TPG_L == 0 && D % 256 == 0, "conv grouping");
struct W_hconv2m { static constexpr int NITEMS = D * 16; static HD void run(const P& p, int j, int, int item, float*) {
    const int w8 = item & 7, rest = item >> 3, cls = (rest >> 8) & 1, c = (rest & 255) | ((rest >> 9) << 8);
    const int NG = cls ? CV_NG_L : CV_NG_C; if (w8 >= NG) return;
    const int SPG = cls ? CV_SPG_L : CV_SPG_C, TPG = cls ? CV_TPG_L : CV_TPG_C, NB = cls ? CV_NB_L : CV_NB_C, L = cls ? DEC_SEQ : SEQ;
    const int ntg = NB / TPG, sg = w8 / ntg, tg = w8 % ntg, dlo = tg * TPG - (NB - 1), dhi = tg * TPG + TPG - 1;
    const bf16* vt = p.VT + (size_t)c * M; const float skip = p.hy_skip[j * D + c];
    Acc16 acc[NL];
    WAVE_FOR { for (int r = 0; r < 16; ++r) acc[LI][r] = 0.f; }
    const int nIt = 2 * (dhi - dlo + 1);
    for (int i0 = 0; i0 < nIt; i0 += 8) {
        Frag8 fa8[8][NL], fb8[8][NL];
#pragma unroll
        for (int u = 0; u < 8; ++u) {
            WAVE_FOR { const int it = i0 + u, itc = it < nIt ? it : nIt - 1, dl = dlo + (itc >> 1), ks = itc & 1, q = 2 * dl - ks; const int r = lane & 31, h = lane >> 5, a = r >> 3, rho = r & 7;
                fa8[u][LI] = ld_frag8(p.TS + ts_off(cls, c, rho) + (8 * (h - a - 2 * q) + L));
                const int seq = sg * SPG + r / TPG, t1 = tg * TPG + r % TPG, s1 = t1 - dl; const int base = (cls ? MC + seq * DEC_SEQ : seq * SEQ);
                fb8[u][LI] = (it < nIt && s1 >= 0 && s1 < NB) ? ld_frag8(vt + base + 32 * s1 + 16 * ks + 8 * h) : zero_frag8(); } }
#pragma unroll
        for (int u = 0; u < 8; ++u) MFMA32(acc, fa8[u], fb8[u]);
    }
    WAVE_FOR { const int r = lane & 31, h = lane >> 5; const int seq = sg * SPG + r / TPG, t1 = tg * TPG + r % TPG; const int base = (cls ? MC + seq * DEC_SEQ : seq * SEQ) + 32 * t1;
        for (int rg = 0; rg < 4; ++rg) { const int tok = base + 8 * rg + 4 * h;
            for (int e = 0; e < 4; ++e) p.YT[(size_t)c * M + tok + e] = f2bf(acc[LI][4 * rg + e] + skip * bf2f(vt[tok + e])); } }
} };
struct W_hconv3t { static constexpr int NITEMS = (M / 64) * (D / 64); static HD void run(const P& p, int, int, int item, float* ldsf) {
    bf16* tl = (bf16*)ldsf; const int ct = item % (D / 64), rt = item / (D / 64), row0 = rt * 64, c0 = ct * 64;
    WAVE_FOR { for (int ch = 0; ch < 64; ++ch) tl[ch * 66 + lane] = p.YT[(size_t)(c0 + ch) * M + row0 + lane]; }
    WAVE_SYNC();
    WAVE_FOR { for (int tt = 0; tt < 64; ++tt) { const size_t o = (size_t)(row0 + tt) * D + c0 + lane; p.H[o] = f2bf(bf2f(p.X0Cb[o]) * bf2f(tl[lane * 66 + tt])); } }
    WAVE_SYNC();
} };

constexpr size_t VTT_C = (size_t)BATCH * NH * VD * SEQ, VTT_L = (size_t)DEC_BATCH * NH * VD * TMAX, VTT_ALL = VTT_C + VTT_L;
HD int kperm32(int k) { return 8 * ((k >> 2) & 3) + 4 * (k >> 4) + (k & 3); }
#ifdef HOST_EMU
static inline void gmax16_h(float* v) { for (int q = 0; q < 16; ++q) { float s = v[q]; for (int g = 1; g < 4; ++g) s = v[q + 16 * g] > s ? v[q + 16 * g] : s; for (int g = 0; g < 4; ++g) v[q + 16 * g] = s; } }
static inline void gsum16_h(float* v) { for (int q = 0; q < 16; ++q) { float s = 0.f; for (int g = 0; g < 4; ++g) s += v[q + 16 * g]; for (int g = 0; g < 4; ++g) v[q + 16 * g] = s; } }
#define gmax16(a) gmax16_h(a)
#define gsum16(a) gsum16_h(a)
#define SCHED_FENCE() do { } while (0)
#else
__device__ __forceinline__ float gmax16_d(float s) { auto a = __builtin_amdgcn_permlane16_swap(__float_as_uint(s), __float_as_uint(s), false, false); const unsigned a0 = a[0], a1 = a[1]; const float m = fmaxf(__uint_as_float(a0), __uint_as_float(a1));
    auto b = __builtin_amdgcn_permlane32_swap(__float_as_uint(m), __float_as_uint(m), false, false); const unsigned b0 = b[0], b1 = b[1]; return fmaxf(__uint_as_float(b0), __uint_as_float(b1)); }
__device__ __forceinline__ float gsum16_d(float s) { auto a = __builtin_amdgcn_permlane16_swap(__float_as_uint(s), __float_as_uint(s), false, false); const unsigned a0 = a[0], a1 = a[1]; const float m = __uint_as_float(a0) + __uint_as_float(a1);
    auto b = __builtin_amdgcn_permlane32_swap(__float_as_uint(m), __float_as_uint(m), false, false); const unsigned b0 = b[0], b1 = b[1]; return __uint_as_float(b0) + __uint_as_float(b1); }
#define SCHED_FENCE() __builtin_amdgcn_sched_barrier(0)
#define gmax16(a) ((a)[0] = gmax16_d((a)[0]))
#define gsum16(a) ((a)[0] = gsum16_d((a)[0]))
#endif
struct E_kcvt { static HD void run(const P& p, int, int, size_t i) { p.KC[i] = f2bf(p.cache_k[i]); } };
constexpr int VT_ITEMS_C = BATCH * NH * (SEQ / 64) * (VD / 64 > 0 ? VD / 64 : 1), VT_ITEMS_L = DEC_BATCH * NH * (TMAX / 64) * (VD / 64 > 0 ? VD / 64 : 1);
constexpr int VT_EW = VD < 64 ? VD : 64;
struct W_vtrans { static constexpr int NITEMS = VT_ITEMS_C + VT_ITEMS_L; static HD void run(const P& p, int, int, int item, float* ldsf) {
    bf16* tl = (bf16*)ldsf; const bool lat = item >= VT_ITEMS_C; int r = lat ? item - VT_ITEMS_C : item; const int T = lat ? TMAX : SEQ, net = VD / VT_EW, nkt = T / 64;
    const int et = r % net; r /= net; const int kt = r % nkt; r /= nkt; const int h = r % NH, b = r / NH, e0 = et * VT_EW, k0 = kt * 64;
    WAVE_FOR { if (lane < VT_EW) for (int kk = 0; kk < 64; ++kk) { const int key = k0 + kk; float v;
            if (lat && key < PAST) v = p.cache_v[(((size_t)b * NAT * PAST + key) * NH + h) * VD + e0 + lane];
            else v = bf2f(p.Z[(size_t)((lat ? MC + b * DEC_SEQ + key - PAST : b * SEQ + key)) * 3 * D + 2 * D + h * VD + e0 + lane]);
            tl[lane * 66 + 32 * (kk >> 5) + kperm32(kk & 31)] = f2bf(v); } }
    WAVE_SYNC();
    bf16* dst = p.VTT + (lat ? VTT_C + ((size_t)(b * NH + h) * VD) * TMAX : ((size_t)(b * NH + h) * VD) * SEQ);
    WAVE_FOR { for (int e = 0; e < VT_EW; ++e) dst[(size_t)(e0 + e) * T + k0 + lane] = tl[e * 66 + lane]; }
    WAVE_SYNC();
} };
constexpr int AT_NQC = SEQ / 16, AT_NQL = DEC_SEQ / 16, AT_ITEMS_C = BATCH * NH * AT_NQC, AT_ITEMS_L = DEC_BATCH * NH * AT_NQL;
constexpr int AT_KS = HDIM / 32 > 0 ? HDIM / 32 : 1, AT_ET = VD / 16;
static_assert(HDIM % 32 == 0 || HDIM == 16, "head dim");
struct W_attn2 { static constexpr int NITEMS = AT_ITEMS_C + AT_ITEMS_L; static HD void run(const P& p, int, int, int item, float*) {
    const bool lat = item >= AT_ITEMS_C; int r = lat ? item - AT_ITEMS_C : item; const int nq = lat ? AT_NQL : AT_NQC; const int qb = r % nq; r /= nq; const int h = r % NH, b = r / NH;
    const int T = lat ? TMAX : SEQ, seq0 = lat ? MC + b * DEC_SEQ : b * SEQ, row0 = seq0 + qb * 16;
    const bf16* vt = p.VTT + (lat ? VTT_C + ((size_t)(b * NH + h) * VD) * TMAX : ((size_t)(b * NH + h) * VD) * SEQ);
    const float scale = 1.0f / sqrtf((float)HDIM), lam_init = 0.8f - 0.6f * expf(-0.3f * (float)ATT_LAYER);
    float s01 = 0.f, s23 = 0.f; for (int d = 0; d < HDIM; ++d) { s01 += p.at_lam[d] * p.at_lam[HDIM + d]; s23 += p.at_lam[2 * HDIM + d] * p.at_lam[3 * HDIM + d]; }
    const float lam = expf(s01) - expf(s23) + lam_init;
    Frag8 fq[NL], fa[NL], pf[2][NL]; Acc4 oacc[2][AT_ET][NL], st[2][2][NL]; float mrow[2][NL], lrow[2][NL], tmx[2][NL];
    WAVE_FOR {
#pragma unroll
        for (int c = 0; c < 2; ++c) {
#pragma unroll
            for (int et = 0; et < AT_ET; ++et) for (int e = 0; e < 4; ++e) oacc[c][et][LI][e] = 0.f;
            mrow[c][LI] = -1.0e30f; lrow[c][LI] = 0.f; } }
    for (int k0 = 0; k0 < T; k0 += 32) {
#pragma unroll
        for (int c = 0; c < 2; ++c)
#pragma unroll
            for (int tau = 0; tau < 2; ++tau) { WAVE_FOR { for (int e = 0; e < 4; ++e) st[c][tau][LI][e] = 0.f; }
#pragma unroll
                for (int ks = 0; ks < AT_KS; ++ks) {
                    WAVE_FOR { const int kg = lane >> 4, key = k0 + 16 * tau + (lane & 15);
                        const bf16* kp = (lat && key < PAST) ? p.KC + (((size_t)b * NAT * PAST + key) * NH + h) * 2 * HDIM : p.Z + (size_t)(seq0 + key - (lat ? PAST : 0)) * 3 * D + D + h * 2 * HDIM;
                        if (HDIM >= 32 || kg < 2) { fa[LI] = ld_frag8(kp + c * HDIM + 32 * ks + 8 * kg); fq[LI] = ld_frag8(p.Z + (size_t)(row0 + (lane & 15)) * 3 * D + h * 2 * HDIM + c * HDIM + 32 * ks + 8 * kg); }
                        else { fa[LI] = zero_frag8(); fq[LI] = zero_frag8(); } }
                    MFMA16(st[c][tau], fa, fq); }
                SCHED_FENCE(); }
        WAVE_FOR {
#pragma unroll
            for (int c = 0; c < 2; ++c) { float mx = -1.0e30f;
#pragma unroll
                for (int tau = 0; tau < 2; ++tau) for (int e = 0; e < 4; ++e) { const float v = st[c][tau][LI][e] * scale; mx = v > mx ? v : mx; }
                tmx[c][LI] = mx; } }
        gmax16(tmx[0]); gmax16(tmx[1]);
        WAVE_FOR {
#pragma unroll
            for (int c = 0; c < 2; ++c) { const float mn = tmx[c][LI] > mrow[c][LI] ? tmx[c][LI] : mrow[c][LI], alpha = expf(mrow[c][LI] - mn); mrow[c][LI] = mn; float ps = 0.f;
#pragma unroll
                for (int tau = 0; tau < 2; ++tau) for (int e = 0; e < 4; ++e) { const float pv = expf(st[c][tau][LI][e] * scale - mn); ps += pv; pf[c][LI][4 * tau + e] = (short)f2bf(pv); }
                lrow[c][LI] = lrow[c][LI] * alpha + ps;
#pragma unroll
                for (int et = 0; et < AT_ET; ++et) for (int e = 0; e < 4; ++e) oacc[c][et][LI][e] *= alpha; } }
#pragma unroll
        for (int et = 0; et < AT_ET; ++et) {
            WAVE_FOR { fa[LI] = ld_frag8(vt + (size_t)(16 * et + (lane & 15)) * T + k0 + 8 * (lane >> 4)); }
            MFMA16(oacc[0][et], fa, pf[0]); MFMA16(oacc[1][et], fa, pf[1]); if ((et & 3) == 3) SCHED_FENCE(); }
    }
    gsum16(lrow[0]); gsum16(lrow[1]);
    float ssq[NL];
    WAVE_FOR { const float i0 = 1.0f / lrow[0][LI], i1 = lam / lrow[1][LI]; float s = 0.f;
#pragma unroll
        for (int et = 0; et < AT_ET; ++et) for (int e = 0; e < 4; ++e) { const float o = oacc[0][et][LI][e] * i0 - oacc[1][et][LI][e] * i1; oacc[0][et][LI][e] = o; s += o * o; }
        ssq[LI] = s; }
    gsum16(ssq);
    WAVE_FOR { const int q = lane & 15, kg = lane >> 4; const float rstd = rsq(ssq[LI] / (float)VD + NORM_EPS) * (1.0f - lam_init);
#pragma unroll
        for (int et = 0; et < AT_ET; ++et) for (int e = 0; e < 4; ++e) { const int ee = 16 * et + 4 * kg + e; p.H[(size_t)(row0 + q) * D + h * VD + ee] = f2bf(oacc[0][et][LI][e] * rstd * p.at_g_sub[ee]); } }
} };

constexpr size_t S5_BBT = (size_t)2 * SGS * 128 * SG, S5_CMT = (size_t)2 * SGS * SG * 128;
struct E_s5tab { static HD void run(const P& p, int, int, size_t i) {
    const int pp = (int)(i % SP); const size_t dg = i / SP;
    float lre = p.s5_lam_re[i]; lre = lre < -1e-4f ? lre : -1e-4f; const float lim = p.s5_lam_im[i], dt = expf(p.s5_log_dt[dg]);
    const float er = expf(lre * dt), br_ = er * cosf(lim * dt), bi_ = er * sinf(lim * dt); p.S5LB[2 * i] = br_; p.S5LB[2 * i + 1] = bi_;
    const float nr = br_ - 1.0f, ni = bi_, den = lre * lre + lim * lim, cfr = (nr * lre + ni * lim) / den, cfi = (ni * lre - nr * lim) / den;
    for (int h = 0; h < SG; ++h) { const float b_r = p.s5_b_re[i * SG + h], b_i = p.s5_b_im[i * SG + h];
        p.S5BB[(dg * 128 + pp) * SG + h] = f2bf(cfr * b_r - cfi * b_i); p.S5BB[(dg * 128 + 64 + pp) * SG + h] = f2bf(cfr * b_i + cfi * b_r);
        p.S5CM[(dg * SG + h) * 128 + 2 * pp] = f2bf(p.s5_c_re[(dg * SG + h) * SP + pp]); p.S5CM[(dg * SG + h) * 128 + 2 * pp + 1] = f2bf(-p.s5_c_im[(dg * SG + h) * SP + pp]); } } };
#ifdef HOST_EMU
static inline void swap32_h(Acc16* a, Acc16* b) { for (int r = 0; r < 16; ++r) for (int n = 0; n < 32; ++n) { const float t = a[32 + n][r]; a[32 + n][r] = b[n][r]; b[n][r] = t; } }
#define SWAP32(a, b) swap32_h(a, b)
#else
__device__ __forceinline__ void swap32_d(Acc16& a, Acc16& b) {
#pragma unroll
    for (int r = 0; r < 16; ++r) { const float x = a[r], y = b[r];
        auto v = __builtin_amdgcn_permlane32_swap(__float_as_uint(x), __float_as_uint(y), false, false); const unsigned v0 = v[0], v1 = v[1]; a[r] = __uint_as_float(v0); b[r] = __uint_as_float(v1); } }
#define SWAP32(a, b) swap32_d((a)[0], (b)[0])
#endif
constexpr int S5_ROWW = 68;
struct W_s5m { static constexpr int NITEMS = (BATCH + DEC_BATCH) * SGS * 2; static HD void run(const P& p, int, int, int item, float* ldsf) {
    const int dir = item & 1, g = (item >> 1) % SGS, sidx = (item >> 1) / SGS; const bool lat = sidx >= BATCH; const int b = lat ? sidx - BATCH : sidx;
    const int L = lat ? DEC_SEQ : SEQ, seq0 = lat ? MC + b * DEC_SEQ : b * SEQ; const size_t dg = (size_t)dir * SGS + g;
    unsigned* tl = (unsigned*)ldsf; float* Y = dir ? p.YB : p.YF;
    Frag8 fb[4][NL], fc[4][NL], fa[NL], fx[NL]; Acc16 bu[4][NL]; Acc4 yv[2][NL]; float lbr[NL], lbi[NL], xr[NL], xi[NL];
    WAVE_FOR { const int n = lane & 31, hh = lane >> 5, pp = n + 32 * hh;
#pragma unroll
        for (int q = 0; q < 4; ++q) { fb[q][LI] = ld_frag8(p.S5BB + (dg * 128 + 32 * q + n) * SG + 8 * hh); fc[q][LI] = ld_frag8(p.S5CM + (dg * SG + (lane & 15)) * 128 + 32 * q + 8 * (lane >> 4)); }
        lbr[LI] = p.S5LB[2 * (dg * SP + pp)]; lbi[LI] = p.S5LB[2 * (dg * SP + pp) + 1];
        if (lat) { const size_t si = (((size_t)b * NSS) * 2 + dir) * SGS * SP + (size_t)g * SP + pp; xr[LI] = p.st_re[si]; xi[LI] = p.st_im[si]; } else { xr[LI] = 0.f; xi[LI] = 0.f; } }
    WAVE_FOR { const int m = lane & 31, hh = lane >> 5, pos = 16 * ((m >> 2) & 1) + 4 * (m >> 3) + (m & 3), t = dir ? L - 1 - pos : pos; fa[LI] = ld_frag8(p.H + (size_t)(seq0 + t) * D + g * SG + 8 * hh); }
    for (int ch = 0; ch < L / 32; ++ch) {
        WAVE_FOR {
#pragma unroll
            for (int q = 0; q < 4; ++q) for (int r = 0; r < 16; ++r) bu[q][LI][r] = 0.f; }
#pragma unroll
        for (int q = 0; q < 4; ++q) MFMA32(bu[q], fa, fb[q]);
        if (ch + 1 < L / 32) { WAVE_FOR { const int m = lane & 31, hh = lane >> 5, pos = (ch + 1) * 32 + 16 * ((m >> 2) & 1) + 4 * (m >> 3) + (m & 3), t = dir ? L - 1 - pos : pos;
            fa[LI] = ld_frag8(p.H + (size_t)(seq0 + t) * D + g * SG + 8 * hh); } }
        SWAP32(bu[0], bu[1]); SWAP32(bu[2], bu[3]);
        WAVE_FOR { const int pp = (lane & 31) + 32 * (lane >> 5); float ar = xr[LI], ai = xi[LI]; const float cr_ = lbr[LI], ci_ = lbi[LI];
#pragma unroll
            for (int s = 0; s < 32; ++s) { const float ur = bu[s >> 4][LI][s & 15], ui = bu[2 + (s >> 4)][LI][s & 15];
                const float nr = cr_ * ar - ci_ * ai + ur, ni = cr_ * ai + ci_ * ar + ui; ar = nr; ai = ni;
                tl[s * S5_ROWW + pp] = pk2bf(nr, ni); }
            xr[LI] = ar; xi[LI] = ai; }
        WAVE_SYNC_LDS();
#pragma unroll
        for (int pt = 0; pt < 2; ++pt) { WAVE_FOR { for (int e = 0; e < 4; ++e) yv[pt][LI][e] = 0.f; }
#pragma unroll
            for (int ks = 0; ks < 4; ++ks) { WAVE_FOR { fx[LI] = ld_frag8((const bf16*)(tl + (16 * pt + (lane & 15)) * S5_ROWW) + 32 * ks + 8 * (lane >> 4)); }
                MFMA16(yv[pt], fc[ks], fx); } }
        WAVE_FOR { const int kg = lane >> 4;
#pragma unroll
            for (int pt = 0; pt < 2; ++pt) { const int pos = ch * 32 + 16 * pt + (lane & 15), t = dir ? L - 1 - pos : pos; float* yo = Y + (size_t)(seq0 + t) * D + g * SG + 4 * kg;
                for (int e = 0; e < 4; ++e) yo[e] = yv[pt][LI][e]; } }
        WAVE_SYNC_LDS();
    }
    if (!lat) { WAVE_FOR { const size_t so = (((size_t)b * NSS) * 2 + dir) * SGS * SP + (size_t)g * SP + (lane & 31) + 32 * (lane >> 5); p.out[OUT_SRE + so] = xr[LI]; p.out[OUT_SIM + so] = xi[LI]; } }
} };


#ifdef HOST_EMU
static inline void ld8f(const float* p, float* v) { for (int e = 0; e < 8; ++e) v[e] = p[e]; }
static inline void st8f(float* p, const float* v) { for (int e = 0; e < 8; ++e) p[e] = v[e]; }
static inline void ld8b(const bf16* p, float* v) { for (int e = 0; e < 8; ++e) v[e] = bf2f(p[e]); }
static inline void st8b(bf16* p, const float* v) { for (int e = 0; e < 8; ++e) p[e] = f2bf(v[e]); }
#else
__device__ __forceinline__ void ld8f(const float* p, float* v) { const float4 a = ((const float4*)p)[0], b = ((const float4*)p)[1]; v[0] = a.x; v[1] = a.y; v[2] = a.z; v[3] = a.w; v[4] = b.x; v[5] = b.y; v[6] = b.z; v[7] = b.w; }
__device__ __forceinline__ void st8f(float* p, const float* v) { ((float4*)p)[0] = make_float4(v[0], v[1], v[2], v[3]); ((float4*)p)[1] = make_float4(v[4], v[5], v[6], v[7]); }
__device__ __forceinline__ void ld8b(const bf16* p, float* v) { const uint4 a = *(const uint4*)p; v[0] = __uint_as_float(a.x << 16); v[1] = __uint_as_float(a.x & 0xffff0000u); v[2] = __uint_as_float(a.y << 16); v[3] = __uint_as_float(a.y & 0xffff0000u);
    v[4] = __uint_as_float(a.z << 16); v[5] = __uint_as_float(a.z & 0xffff0000u); v[6] = __uint_as_float(a.w << 16); v[7] = __uint_as_float(a.w & 0xffff0000u); }
__device__ __forceinline__ void st8b(bf16* p, const float* v) { uint4 o; o.x = pk2bf(v[0], v[1]); o.y = pk2bf(v[2], v[3]); o.z = pk2bf(v[4], v[5]); o.w = pk2bf(v[6], v[7]); *(uint4*)p = o; }
#endif
HD size_t mv_off(int l, int wh, int midx, int k) { return ((((size_t)l * 2 + wh) * NCND + midx) * 3 + k) * D; }
struct E_modvec { static HD void run(const P& p, int, int, size_t i) {
    const int c = (int)(i % D); size_t r = i / D; const int k = (int)(r % 3); r /= 3; const int midx = (int)(r % NCND); r /= NCND; const int wh = (int)(r % 2), l = (int)(r / 2);
    const float* mod = p.MOD + ((size_t)l * NCND + midx) * 6 * D; const float* g = p.g_norm + (size_t)l * 4 * D; float v;
    if (k == 0) v = mod[(wh ? 5 : 2) * D + c] * g[(wh ? 3 : 1) * D + c]; else if (k == 1) v = g[(wh ? 2 : 0) * D + c] * (1.0f + mod[(wh ? 4 : 1) * D + c]); else v = mod[(wh ? 3 : 0) * D + c];
    p.MV[i] = v; } };
constexpr int TH_K = (D + 511) / 512;
#define TH_ON(k) (512 * (k) + 8 * lane < D)
constexpr int TH_MODE_A = 0x100, TH_MODE_B = 0x200, TH_SRC_IN = 0x400;
struct W_thin2 { static constexpr int NITEMS = M; static HD void run(const P& p, int a0, int a1, int row, float*) {
    const int midx = row < MC ? 0 : 1 + (row - MC) / DEC_SEQ; const bool fin = a1 < 0, first = a0 < 0; const bool modeA = !first && (a0 & TH_MODE_A), modeB = !first && (a0 & TH_MODE_B); const int ps = first ? 0 : (a0 & 0xff);
    const bool srcin = first || (a0 & TH_SRC_IN);
    const float* xin = row < MC ? p.x_prompt + (size_t)row * D : p.x_sample + (size_t)(row - MC) * D; const bf16* xbin = p.XB + (size_t)row * D; float* xout = p.out + (size_t)row * D; bf16* xbout = p.XB + (size_t)row * D;
    float x[NL][TH_K * 8], ss[NL];
    WAVE_FOR {
#pragma unroll
        for (int k = 0; k < TH_K; ++k) { if (TH_ON(k)) { if (srcin) ld8f(xin + 512 * k + 8 * lane, &x[LI][8 * k]); else ld8b(xbin + 512 * k + 8 * lane, &x[LI][8 * k]); } else for (int e = 0; e < 8; ++e) x[LI][8 * k + e] = 0.f; } }
    if (modeB) { const float* gpa = p.MV + mv_off(ps >> 3, 0, midx, 0); const float rsa = p.RS[2 * (size_t)row];
        WAVE_FOR {
#pragma unroll
            for (int k = 0; k < TH_K; ++k) if (TH_ON(k)) { float g8[8], o8[8]; ld8f(gpa + 512 * k + 8 * lane, g8); ld8b(p.ObA + (size_t)row * D + 512 * k + 8 * lane, o8); for (int e = 0; e < 8; ++e) x[LI][8 * k + e] += g8[e] * (o8[e] * rsa); } } }
    if (!first) { const float* gp = p.MV + mv_off(ps >> 3, ps & 7, midx, 0); const bf16* ob = (modeA ? p.ObA : p.Ob) + (size_t)row * D; float o[NL][TH_K * 8];
        WAVE_FOR { float s = 0.f;
#pragma unroll
            for (int k = 0; k < TH_K; ++k) { if (TH_ON(k)) ld8b(ob + 512 * k + 8 * lane, &o[LI][8 * k]); else for (int e = 0; e < 8; ++e) o[LI][8 * k + e] = 0.f; for (int e = 0; e < 8; ++e) s += o[LI][8 * k + e] * o[LI][8 * k + e]; }
            ss[LI] = s; }
        wsum(ss);
        WAVE_FOR { const float rstd = rsq(ss[LI] / (float)D + NORM_EPS); if (modeA && lane == 0) p.RS[2 * (size_t)row] = rstd;
#pragma unroll
            for (int k = 0; k < TH_K; ++k) if (TH_ON(k)) { float g8[8]; ld8f(gp + 512 * k + 8 * lane, g8); for (int e = 0; e < 8; ++e) x[LI][8 * k + e] += g8[e] * (o[LI][8 * k + e] * rstd); } } }
    if (!first && !modeA) { WAVE_FOR {
#pragma unroll
        for (int k = 0; k < TH_K; ++k) if (TH_ON(k)) { if (fin) st8f(xout + 512 * k + 8 * lane, &x[LI][8 * k]); else st8b(xbout + 512 * k + 8 * lane, &x[LI][8 * k]); } } }
    if (!fin) { const float* av = p.MV + mv_off(a1 >> 3, a1 & 7, midx, 1); const float* bv = av + D;
        WAVE_FOR { float s = 0.f;
#pragma unroll
            for (int k = 0; k < TH_K * 8; ++k) s += x[LI][k] * x[LI][k];
            ss[LI] = s; }
        wsum(ss);
        WAVE_FOR { const float rstd = rsq(ss[LI] / (float)D + NORM_EPS);
#pragma unroll
            for (int k = 0; k < TH_K; ++k) if (TH_ON(k)) { float a8[8], b8[8], h8[8]; ld8f(av + 512 * k + 8 * lane, a8); ld8f(bv + 512 * k + 8 * lane, b8); for (int e = 0; e < 8; ++e) h8[e] = x[LI][8 * k + e] * rstd * a8[e] + b8[e];
                st8b(p.H + (size_t)row * D + 512 * k + 8 * lane, h8); } } }
} };
constexpr int F3_NCH = LMAX / 32;
struct E_filt3c { static HD void run(const P& p, int, int, size_t i) {
    const int col = (int)(i % (2 * D)), ch = (int)((i / (2 * D)) % F3_NCH), j = (int)(i / ((size_t)2 * D * F3_NCH)), d = col % D, dir = col / D;
    float w[FW];
#pragma unroll
    for (int k = 0; k < FW; ++k) w[k] = p.hy_f_w3[((size_t)j * FW + k) * 2 * D + col];
    const float dcy = expf(p.hy_log_alpha[j * D + d]); float ps = 0.f;
    for (int tt = 0; tt < 32; ++tt) { const int t = ch * 32 + tt; const float* h2 = p.H2 + ((size_t)j * LMAX + t) * FW; float acc = 0.f;
#pragma unroll
        for (int k = 0; k < FW; ++k) acc += h2[k] * w[k];
        const float v = acc * expf(-dcy * (float)t); p.HRAW[((size_t)j * LMAX + t) * 2 * D + col] = v; if (!(dir == 1 && t == 0)) ps += fabsf(v); }
    p.PS[i] = ps; } };
constexpr int FK_NC0 = SEQ / 32, FK_NC1 = DEC_SEQ / 32;
struct E_fk2 { static HD void run(const P& p, int, int, size_t i) {
    const int d = (int)(i % D); int r = (int)((i / D) % (FK_NC0 + FK_NC1)); const int j = (int)(i / ((size_t)D * (FK_NC0 + FK_NC1))); const int cls = r >= FK_NC0 ? 1 : 0; const int ch = cls ? r - FK_NC0 : r, L = cls ? DEC_SEQ : SEQ;
    float s = 0.f; for (int c2 = 0; c2 < L / 32; ++c2) s += p.PS[((size_t)j * F3_NCH + c2) * 2 * D + d] + p.PS[((size_t)j * F3_NCH + c2) * 2 * D + D + d];
    const float inv = 1.0f / (s + 1e-6f); const float* h = p.HRAW + (size_t)j * LMAX * 2 * D; bf16* kt = p.KT + kt_off(j, cls, d);
    if (ch == 0) p.KINV[((size_t)j * 2 + cls) * D + d] = inv;
    for (int tt = 0; tt < 32; ++tt) { const int t = ch * 32 + tt, tb = t + 1; kt[L + t] = f2bf(h[(size_t)t * 2 * D + d] * inv); kt[L - tb] = tb < L ? f2bf(h[(size_t)tb * 2 * D + D + d] * inv) : (bf16)0; } } };
struct E_kcvt8 { static HD void run(const P& p, int, int, size_t i) { float v[8]; ld8f(p.cache_k + 8 * i, v); st8b(p.KC + 8 * i, v); } };
struct E_s5comb8 { static HD void run(const P& p, int, int, size_t i) { const int c = (int)((8 * i) % D); float u[8], yf[8], yb[8], dd[8]; ld8b(p.H + 8 * i, u); ld8f(p.YF + 8 * i, yf); ld8f(p.YB + 8 * i, yb); ld8f(p.s5_d + c, dd);
    for (int e = 0; e < 8; ++e) u[e] = gelu_tanh_f(dd[e] * u[e] + yf[e] + yb[e]); st8b(p.H + 8 * i, u); } };

#ifdef HOST_EMU
static inline void ld4b(const bf16* p, float* v) { for (int e = 0; e < 4; ++e) v[e] = bf2f(p[e]); }
static inline void ld4f(const float* p, float* v) { for (int e = 0; e < 4; ++e) v[e] = p[e]; }
static inline void st4f(float* p, const float* v) { for (int e = 0; e < 4; ++e) p[e] = v[e]; }
#else
__device__ __forceinline__ void ld4b(const bf16* p, float* v) { const uint2 a = *(const uint2*)p; v[0] = __uint_as_float(a.x << 16); v[1] = __uint_as_float(a.x & 0xffff0000u); v[2] = __uint_as_float(a.y << 16); v[3] = __uint_as_float(a.y & 0xffff0000u); }
__device__ __forceinline__ void ld4f(const float* p, float* v) { const float4 a = *(const float4*)p; v[0] = a.x; v[1] = a.y; v[2] = a.z; v[3] = a.w; }
__device__ __forceinline__ void st4f(float* p, const float* v) { *(float4*)p = make_float4(v[0], v[1], v[2], v[3]); }
#endif
#ifdef HOST_EMU
static inline void ld2b(const bf16* p, float* v) { v[0] = bf2f(p[0]); v[1] = bf2f(p[1]); }
static inline void ld2f(const float* p, float* v) { v[0] = p[0]; v[1] = p[1]; }
static inline void st2b(bf16* p, const float* v) { p[0] = f2bf(v[0]); p[1] = f2bf(v[1]); }
#else
__device__ __forceinline__ void ld2b(const bf16* p, float* v) { const unsigned a = *(const unsigned*)p; v[0] = __uint_as_float(a << 16); v[1] = __uint_as_float(a & 0xffff0000u); }
__device__ __forceinline__ void ld2f(const float* p, float* v) { const float2 a = *(const float2*)p; v[0] = a.x; v[1] = a.y; }
__device__ __forceinline__ void st2b(bf16* p, const float* v) { *(unsigned*)p = pk2bf(v[0], v[1]); }
#endif
struct W_hconv1v { static constexpr int NITEMS = (M / 64) * (D / 128); static HD void run(const P& p, int j, int, int item, float*) {
    const int cb = item % (D / 128), rt = item / (D / 128), row0 = rt * 64; int seq0, t0, L, cls, b; row_info(row0, seq0, t0, L, cls, b);
    WAVE_FOR { const int c = cb * 128 + 2 * lane; float w[3][3][2], bs[3][2], prev[3][2], cur[3][2];
#pragma unroll
        for (int blk = 0; blk < 3; ++blk) { const float* ws = p.hy_w_short + (size_t)j * 9 * D + blk * D + c; ld2f(ws, w[blk][0]); ld2f(ws + 3 * D, w[blk][1]); ld2f(ws + 6 * D, w[blk][2]); ld2f(p.hy_b_short + (size_t)j * 3 * D + blk * D + c, bs[blk]);
            if (t0 > 0) ld2b(p.Z + (size_t)(row0 - 1) * 3 * D + blk * D + c, prev[blk]); else { prev[blk][0] = 0.f; prev[blk][1] = 0.f; }
            ld2b(p.Z + (size_t)row0 * 3 * D + blk * D + c, cur[blk]); }
        for (int tb = 0; tb < 8; ++tb) { float zn[8][3][2], vv[2][8];
#pragma unroll
            for (int u = 0; u < 8; ++u) { const int tt = 8 * tb + u;
#pragma unroll
                for (int blk = 0; blk < 3; ++blk) { if (t0 + tt < L - 1) ld2b(p.Z + (size_t)(row0 + tt + 1) * 3 * D + blk * D + c, zn[u][blk]); else { zn[u][blk][0] = 0.f; zn[u][blk][1] = 0.f; } } }
#pragma unroll
            for (int u = 0; u < 8; ++u) { float zc[3][2];
#pragma unroll
                for (int blk = 0; blk < 3; ++blk) for (int e = 0; e < 2; ++e) { zc[blk][e] = prev[blk][e] * w[blk][0][e] + cur[blk][e] * w[blk][1][e] + zn[u][blk][e] * w[blk][2][e] + bs[blk][e]; prev[blk][e] = cur[blk][e]; cur[blk][e] = zn[u][blk][e]; }
                st2b(p.X0Cb + (size_t)(row0 + 8 * tb + u) * D + c, zc[0]);
                for (int e = 0; e < 2; ++e) vv[e][u] = zc[2][e] * zc[1][e]; }
#pragma unroll
            for (int e = 0; e < 2; ++e) st8b(p.VT + (size_t)(c + e) * M + row0 + 8 * tb, vv[e]); } }
} };
struct W_hconv3v { static constexpr int NITEMS = (M / 64) * (D / 256); static HD void run(const P& p, int, int, int item, float*) {
    const int cb = item % (D / 256), rt = item / (D / 256), row0 = rt * 64;
    WAVE_FOR { const int c = cb * 256 + 4 * lane;
        for (int tb = 0; tb < 8; ++tb) { float y[4][8], x0[8][4];
#pragma unroll
            for (int e = 0; e < 4; ++e) ld8b(p.YT + (size_t)(c + e) * M + row0 + 8 * tb, y[e]);
#pragma unroll
            for (int u = 0; u < 8; ++u) ld4b(p.X0Cb + (size_t)(row0 + 8 * tb + u) * D + c, x0[u]);
#pragma unroll
            for (int u = 0; u < 8; ++u) { float o4[4]; for (int e = 0; e < 4; ++e) o4[e] = x0[u][e] * y[e][u]; st4b(p.H + (size_t)(row0 + 8 * tb + u) * D + c, o4); } } }
} };
struct W_hconv3x { static constexpr int NITEMS = (M / 64) * (D / 256); static HD void run(const P& p, int j, int, int item, float*) {
    const int cb = item % (D / 256), rt = item / (D / 256), row0 = rt * 64; int seq0, t0, L, cls, b; row_info(row0, seq0, t0, L, cls, b);
    WAVE_FOR { const int c = cb * 256 + 4 * lane; float w[3][4], bs[4], prev[4], cur[4]; const float* ws = p.hy_w_short + (size_t)j * 9 * D + c;
        ld4f(ws, w[0]); ld4f(ws + 3 * D, w[1]); ld4f(ws + 6 * D, w[2]); ld4f(p.hy_b_short + (size_t)j * 3 * D + c, bs);
        if (t0 > 0) ld4b(p.Z0 + (size_t)(row0 - 1) * D + c, prev); else for (int e = 0; e < 4; ++e) prev[e] = 0.f;
        ld4b(p.Z0 + (size_t)row0 * D + c, cur);
        for (int tb = 0; tb < 8; ++tb) { float y[4][8], zn[8][4];
#pragma unroll
            for (int e = 0; e < 4; ++e) ld8b(p.YT + (size_t)(c + e) * M + row0 + 8 * tb, y[e]);
#pragma unroll
            for (int u = 0; u < 8; ++u) { if (t0 + 8 * tb + u < L - 1) ld4b(p.Z0 + (size_t)(row0 + 8 * tb + u + 1) * D + c, zn[u]); else for (int e = 0; e < 4; ++e) zn[u][e] = 0.f; }
#pragma unroll
            for (int u = 0; u < 8; ++u) { float o4[4]; for (int e = 0; e < 4; ++e) { const float x0 = prev[e] * w[0][e] + cur[e] * w[1][e] + zn[u][e] * w[2][e] + bs[e]; prev[e] = cur[e]; cur[e] = zn[u][e]; o4[e] = x0 * y[e][u]; }
                st4b(p.H + (size_t)(row0 + 8 * tb + u) * D + c, o4); } } }
} };
constexpr int V3_ITEMS_C = BATCH * NH * (SEQ / 32), V3_ITEMS_L = DEC_BATCH * NH * (TMAX / 32);
struct W_vtrans3 { static constexpr int NITEMS = V3_ITEMS_C + V3_ITEMS_L; static HD void run(const P& p, int, int, int item, float*) {
    const bool lat = item >= V3_ITEMS_C; int r = lat ? item - V3_ITEMS_C : item; const int T = lat ? TMAX : SEQ, nkb = T / 32; const int kb = r % nkb; r /= nkb; const int h = r % NH, b = r / NH, k0 = kb * 32;
    bf16* dst = p.VTT + (lat ? VTT_C + ((size_t)(b * NH + h) * VD) * TMAX : ((size_t)(b * NH + h) * VD) * SEQ);
    WAVE_FOR { if (4 * lane < VD) { const int e0 = 4 * lane; float v[32][4];
#pragma unroll
            for (int kk = 0; kk < 32; ++kk) { const int key = k0 + kk;
                if (lat && key < PAST) ld4f(p.cache_v + (((size_t)b * NAT * PAST + key) * NH + h) * VD + e0, v[kk]);
                else ld4b(p.Z + (size_t)((lat ? MC + b * DEC_SEQ + key - PAST : b * SEQ + key)) * 3 * D + 2 * D + h * VD + e0, v[kk]); }
#pragma unroll
            for (int e = 0; e < 4; ++e)
#pragma unroll
                for (int kg = 0; kg < 4; ++kg) { float o8[8]; for (int jx = 0; jx < 8; ++jx) o8[jx] = v[16 * (jx >> 2) + 4 * kg + (jx & 3)][e]; st8b(dst + (size_t)(e0 + e) * T + k0 + 8 * kg, o8); } } }
} };

struct W_vtransc { static constexpr int NITEMS = DEC_BATCH * NH * (PAST / 32); static HD void run(const P& p, int, int, int item, float*) {
    int r = item; const int kb = r % (PAST / 32); r /= (PAST / 32); const int h = r % NH, b = r / NH, k0 = kb * 32;
    bf16* dst = p.VTT + VTT_C + ((size_t)(b * NH + h) * VD) * TMAX;
    WAVE_FOR { if (4 * lane < VD) { const int e0 = 4 * lane; float v[32][4];
#pragma unroll
            for (int kk = 0; kk < 32; ++kk) ld4f(p.cache_v + (((size_t)b * NAT * PAST + k0 + kk) * NH + h) * VD + e0, v[kk]);
#pragma unroll
            for (int e = 0; e < 4; ++e)
#pragma unroll
                for (int kg = 0; kg < 4; ++kg) { float o8[8]; for (int jx = 0; jx < 8; ++jx) o8[jx] = v[16 * (jx >> 2) + 4 * kg + (jx & 3)][e]; st8b(dst + (size_t)(e0 + e) * TMAX + k0 + 8 * kg, o8); } } }
} };
struct W_hconv3y { static constexpr int NITEMS = (M / 64) * (D / 64); static HD void run(const P& p, int j, int, int item, float*) {
    const int cb = item % (D / 64), rt = item / (D / 64), row0 = rt * 64; int seq0, t0, L, cls, b; row_info(row0, seq0, t0, L, cls, b);
    WAVE_FOR { const int g = lane >> 3, tg = lane & 7, c = cb * 64 + 8 * g, tk0 = 8 * tg; float w[3][8], bs[8], y[8][8], z[10][8]; const float* ws = p.hy_w_short + (size_t)j * 9 * D + c;
        ld8f(ws, w[0]); ld8f(ws + 3 * D, w[1]); ld8f(ws + 6 * D, w[2]); ld8f(p.hy_b_short + (size_t)j * 3 * D + c, bs);
#pragma unroll
        for (int i = 0; i < 8; ++i) ld8b(p.YT + (size_t)(c + i) * M + row0 + tk0, y[i]);
#pragma unroll
        for (int u = 0; u < 10; ++u) { const int tl = t0 + tk0 + u - 1;
            if (tl >= 0 && tl < L) ld8b(p.Z0 + (size_t)(row0 + tk0 + u - 1) * D + c, z[u]); else for (int e = 0; e < 8; ++e) z[u][e] = 0.f; }
#pragma unroll
        for (int u = 0; u < 8; ++u) { float o8[8]; for (int e = 0; e < 8; ++e) o8[e] = (z[u][e] * w[0][e] + z[u + 1][e] * w[1][e] + z[u + 2][e] * w[2][e] + bs[e]) * y[e][u];
            st8b(p.H + (size_t)(row0 + tk0 + u) * D + c, o8); } }
} };

struct E_taps8 { static HD void run(const P& p, int j, int, size_t i) {
    size_t e0 = i * 8; const int cls = e0 >= TS_C ? 1 : 0; if (cls) e0 -= TS_C; const int L = cls ? DEC_SEQ : SEQ;
    const int idx0 = (int)(e0 % (2 * L)), rho = (int)((e0 / (2 * L)) % 8), c = (int)(e0 / ((size_t)2 * L * 8));
    const bf16* kt = p.KT + kt_off(j, cls, c); Frag8 f;
#pragma unroll
    for (int e = 0; e < 8; ++e) { const int jt = rho - (idx0 + e - L); f[e] = (jt > -L && jt < L) ? kt[jt + L] : (bf16)0; }
    st_frag8(p.TS + ts_off(cls, c, rho) + idx0, f); } };
constexpr size_t RT_LAM = (size_t)DEC_SEQ * 2 * QD * 2;
struct E_ropetab { static HD void run(const P& p, int, int, size_t i) { const int k = (int)(i % (2 * QD)), t = (int)(i / (2 * QD)), ii = k % QD; const float pos = (float)(k < QD ? t / GRID_W : t % GRID_W);
    if (i == 0) { float s01 = 0.f, s23 = 0.f; for (int d = 0; d < HDIM; ++d) { s01 += p.at_lam[d] * p.at_lam[HDIM + d]; s23 += p.at_lam[2 * HDIM + d] * p.at_lam[3 * HDIM + d]; }
        p.RT[RT_LAM] = expf(s01) - expf(s23) + (0.8f - 0.6f * expf(-0.3f * (float)ATT_LAYER)); }
    const float inv = powf(10000.0f, -(float)(2 * ii) / (float)(HDIM / 2)), ang = pos * inv; p.RT[2 * i] = cosf(ang); p.RT[2 * i + 1] = sinf(ang); } };
constexpr int RV = QD % 8 == 0 ? 8 : 4;
static_assert(QD % RV == 0, "rope vector width");
struct E_ropev { static HD void run(const P& p, int, int, size_t i) {
    size_t r = i; const int e = (int)(r % (2 * QD / RV)) * RV; r /= 2 * QD / RV; const int comp = (int)(r % 2); r /= 2; const int h = (int)(r % NH); r /= NH; const int which = (int)(r % 2); r /= 2; const int lrow = (int)r;
    const int grp = e / QD, ii0 = e % QD, t = lrow % DEC_SEQ, gr = t / GRID_W, gc = t % GRID_W; const float pos = (float)(grp == 0 ? gr : gc);
    bf16* z = p.Z + (size_t)(MC + lrow) * 3 * D + which * D + h * 2 * HDIM + comp * HDIM + grp * 2 * QD + ii0;
    float a[8], bb[8], oa[8], ob[8];
    if (RV == 8) { ld8b(z, a); ld8b(z + QD, bb); } else { ld4b(z, a); ld4b(z + QD, bb); }
#pragma unroll
    for (int k = 0; k < RV; ++k) { const float inv = powf(10000.0f, -(float)(2 * (ii0 + k)) / (float)(HDIM / 2)), ang = pos * inv, cs = cosf(ang), sn = sinf(ang); oa[k] = a[k] * cs - bb[k] * sn; ob[k] = bb[k] * cs + a[k] * sn; }
    if (RV == 8) { st8b(z, oa); st8b(z + QD, ob); } else { st4b(z, oa); st4b(z + QD, ob); } } };
constexpr int MOD_KS = 8;
struct E_modp { static HD void run(const P& p, int, int, size_t i) { body(p, p.SCOND, i); }
  static HD void body(const P& p, const float* sc, size_t i) {
    const int n4 = (int)(i % (6 * D / 4)); size_t r0 = i / (6 * D / 4); const int ks = (int)(r0 % MOD_KS), l = (int)(r0 / MOD_KS), kb = ks * (D / MOD_KS);
    float acc[NCND][4];
#pragma unroll
    for (int r = 0; r < NCND; ++r) for (int e = 0; e < 4; ++e) acc[r][e] = 0.f;
    const float* w = p.w_mod + ((size_t)l * D + kb) * 6 * D + 4 * n4;
    for (int k = 0; k < D / MOD_KS; ++k) { float w4[4]; ld4f(w + (size_t)k * 6 * D, w4);
#pragma unroll
        for (int r = 0; r < NCND; ++r) { const float s = sc[(size_t)r * D + kb + k]; for (int e = 0; e < 4; ++e) acc[r][e] += s * w4[e]; } }
#pragma unroll
    for (int r = 0; r < NCND; ++r) { float* o = p.PM + (((size_t)ks * DEPTH + l) * NCND + r) * 6 * D + 4 * n4; for (int e = 0; e < 4; ++e) o[e] = acc[r][e]; } } };
HD float mod_at(const P& p, int l, int midx, int k, int c) { const size_t o = ((size_t)l * NCND + midx) * 6 * D + (size_t)k * D + c; float s = p.b_mod[(size_t)l * 6 * D + (size_t)k * D + c];
    for (int ks = 0; ks < MOD_KS; ++ks) s += p.PM[(size_t)ks * DEPTH * NCND * 6 * D + o]; return s; }
struct E_modvec2 { static HD void run(const P& p, int, int, size_t i) {
    const int c = (int)(i % D); size_t r = i / D; const int k = (int)(r % 3); r /= 3; const int midx = (int)(r % NCND); r /= NCND; const int wh = (int)(r % 2), l = (int)(r / 2);
    const float* g = p.g_norm + (size_t)l * 4 * D; float v;
    if (k == 0) v = mod_at(p, l, midx, wh ? 5 : 2, c) * g[(wh ? 3 : 1) * D + c]; else if (k == 1) v = g[(wh ? 2 : 0) * D + c] * (1.0f + mod_at(p, l, midx, wh ? 4 : 1, c)); else v = mod_at(p, l, midx, wh ? 3 : 0, c);
    p.MV[i] = v; } };

#ifdef HOST_EMU
#define BLOCK_WAVES for (int wv = 0; wv < 8; ++wv)
#define WI wv
#define NW 8
#define BLOCK_SYNC() do { } while (0)
#define BTID (wv * 64 + lane)
static inline bool wany_h(const int* f) { for (int l = 0; l < 64; ++l) if (f[l]) return true; return false; }
#define WANY(f) wany_h(f)
#define EXP2F(x) exp2f(x)
#define BA_DMA16(gptr, ldsbase) memcpy((ldsbase) + 8 * lane, (gptr), 16)
#define BA_DMA_WAIT() do { } while (0)
#else
#define BLOCK_WAVES for (int wv = (int)__builtin_amdgcn_readfirstlane(threadIdx.x >> 6), _ow = 1; _ow; _ow = 0)
#define WI 0
#define NW 1
#define BLOCK_SYNC() do { asm volatile("s_waitcnt lgkmcnt(0)" ::: "memory"); __builtin_amdgcn_s_barrier(); asm volatile("" ::: "memory"); } while (0)
#define BTID ((int)threadIdx.x)
#define WANY(f) (__any((f)[0]) != 0)
#define EXP2F(x) __builtin_amdgcn_exp2f(x)
#define BA_DMA16(gptr, ldsbase) __builtin_amdgcn_global_load_lds((const unsigned*)(gptr), (__attribute__((address_space(3))) unsigned*)(ldsbase), 16, 0, 0)
#define BA_DMA_WAIT() asm volatile("s_waitcnt vmcnt(0)" ::: "memory")
#endif
constexpr int BA_QB = 128, BA_NQC = SEQ / BA_QB, BA_NQL = DEC_SEQ / BA_QB, BA_ITEMS_C = BATCH * NH * BA_NQC, BA_ITEMS_L = DEC_BATCH * NH * BA_NQL;
constexpr int BA_KROW = 2 * HDIM, BA_VROW = 32;
constexpr int BA_KSW = (2 * HDIM / 8 >= 16) ? 15 : (2 * HDIM / 8 - 1);
#define BA_VSW(row) (((row) & 8) ? 3 : 0)
constexpr int BA_KT = 32 * BA_KROW, BA_VT = VD * BA_VROW, BA_STAGE = BA_KT + BA_VT;
constexpr int BA_KCH = 32 * (2 * HDIM / 8), BA_VCH = VD * 4;
constexpr int BA_KPT = (BA_KCH + 511) / 512, BA_VPT = (BA_VCH + 511) / 512;
constexpr int BA_QOFF = 2 * BA_STAGE, BA_QW = 16 * BA_KROW;
static_assert((BA_QOFF + 8 * BA_QW) * 2 <= 146944, "attention LDS");
struct B_attn { static constexpr int NITEMS = BA_ITEMS_C + BA_ITEMS_L; static HD void run(const P& p, int, int, int item, float* ldsf) {
    bf16* lds = (bf16*)ldsf;
    const bool lat = item >= BA_ITEMS_C; int r = lat ? item - BA_ITEMS_C : item; const int nq = lat ? BA_NQL : BA_NQC; int qb = r % nq, gi = r / nq;
    if ((lat ? BA_ITEMS_L : BA_ITEMS_C) % 256 == 0 && 32 % nq == 0) { const int wg = r % 256, rnd = r / 256, x = wg % 8, slot = wg / 8, li = rnd * 32 + slot; gi = x + 8 * (li / nq); qb = li % nq; }
    const int h = gi % NH, b = gi / NH;
    const int T = lat ? TMAX : SEQ, seq0 = lat ? MC + b * DEC_SEQ : b * SEQ, nst = T / 32;
    const bf16* vt = p.VTT + (lat ? VTT_C + ((size_t)(b * NH + h) * VD) * TMAX : ((size_t)(b * NH + h) * VD) * SEQ);
    const float scale = 1.4426950408889634f / sqrtf((float)HDIM), lam_init = 0.8f - 0.6f * expf(-0.3f * (float)ATT_LAYER);
    const float lam = p.RT[RT_LAM];
    Frag8 fq[2][NW][NL], fr[4][NW][NL], pf[2][NW][NL]; Acc4 oacc[2][AT_ET][NW][NL], st[2][2][NW][NL]; float mrow[2][NW][NL], lrow[2][NW][NL], tmx[2][NW][NL], alp[2][NW][NL]; int rfl[NW][NL];
    constexpr int CPR = 2 * HDIM / 8, KRJ = 512 / CPR;
    static_assert(512 % CPR == 0 && KRJ % (BA_KSW + 1) == 0 && (BA_KSW & (BA_KSW + 1)) == 0, "key-row chunks");
    int okc[NW][NL], okz[NW][NL], ogv[NW][NL];
    BLOCK_WAVES { WAVE_FOR { const int kr = BTID / CPR, part = (BTID % CPR) ^ (kr & BA_KSW), vr = BTID / 4, vp = (BTID % 4) ^ BA_VSW(vr);
        okc[WI][LI] = kr * (NH * 2 * HDIM) + 8 * part; okz[WI][LI] = kr * (3 * D) + 8 * part; ogv[WI][LI] = vr * T + 8 * vp; } }
#define BA_FETCH(s) do { const int k0 = (s) * 32; const bool cached = lat && k0 < PAST;            \
        const bf16* kb = cached ? p.KC + (((size_t)b * NAT * PAST + k0) * NH + h) * 2 * HDIM : p.Z + (size_t)(seq0 + k0 - (lat ? PAST : 0)) * 3 * D + D + h * 2 * HDIM; const bf16* vb = vt + k0; \
        BLOCK_WAVES { bf16* kl = lds + ((s) & 1) * BA_STAGE + 512 * wv; bf16* vl = lds + ((s) & 1) * BA_STAGE + BA_KT + 512 * wv; WAVE_FOR { \
        _Pragma("unroll") for (int j = 0; j < BA_KPT; ++j) { if (64 * wv + 512 * j < BA_KCH) BA_DMA16(kb + (cached ? okc[WI][LI] + j * KRJ * (NH * 2 * HDIM) : okz[WI][LI] + j * KRJ * (3 * D)), kl + j * 4096); } \
        _Pragma("unroll") for (int j = 0; j < BA_VPT; ++j) { if (64 * wv + 512 * j < BA_VCH) BA_DMA16(vb + ogv[WI][LI] + j * 128 * T, vl + j * 4096); } } } } while (0);
    constexpr float BA_LAZY = 8.0f;
    BLOCK_WAVES { WAVE_FOR {
#pragma unroll
        for (int c = 0; c < 2; ++c) {
#pragma unroll
            for (int et = 0; et < AT_ET; ++et) for (int e = 0; e < 4; ++e) oacc[c][et][WI][LI][e] = 0.f;
            mrow[c][WI][LI] = -1.0e30f; lrow[c][WI][LI] = 0.f; } } }
    BLOCK_SYNC();
    BA_FETCH(0)
    BLOCK_WAVES { WAVE_FOR { const int row0 = seq0 + qb * BA_QB + 16 * wv; bf16* ql = lds + BA_QOFF + wv * BA_QW;
        for (int ci = lane; ci < 16 * (2 * HDIM / 8); ci += 64) { const int rr = ci / (2 * HDIM / 8), part = ci % (2 * HDIM / 8); float q8[8]; ld8b(p.Z + (size_t)(row0 + rr) * 3 * D + h * 2 * HDIM + 8 * part, q8); for (int e = 0; e < 8; ++e) q8[e] *= scale; st_frag8(ql + rr * BA_KROW + 8 * (part ^ (rr & BA_KSW)), pack8(q8)); } } }
    BA_DMA_WAIT();
    BLOCK_SYNC();
    for (int s = 0; s < nst; ++s) {
        if (s + 1 < nst) { BA_FETCH(s + 1) }
        BLOCK_WAVES {
            const bf16* kl = lds + (s & 1) * BA_STAGE; const bf16* vl = kl + BA_KT;
#define BA_KADDR(i) (kl + (16 * ((i) & 1) + (lane & 15)) * BA_KROW + 8 * (((((i) / (2 * AT_KS)) * (HDIM / 8)) + 4 * (((i) >> 1) % AT_KS) + (lane >> 4)) ^ (lane & BA_KSW)))
#define BA_QADDR(j) (lds + BA_QOFF + wv * BA_QW + (lane & 15) * BA_KROW + 8 * (((((j) / AT_KS) * (HDIM / 8)) + 4 * ((j) % AT_KS) + (lane >> 4)) ^ (lane & BA_KSW)))
#define BA_VADDR(et) (vl + (16 * (et) + (lane & 15)) * BA_VROW + 8 * ((lane >> 4) ^ BA_VSW(lane)))
            WAVE_FOR { const bool on = HDIM >= 32 || (lane >> 4) < 2;
#pragma unroll
                for (int c = 0; c < 2; ++c) for (int e = 0; e < 4; ++e) { st[c][0][WI][LI][e] = 0.f; st[c][1][WI][LI][e] = 0.f; }
#pragma unroll
                for (int j = 0; j < 2 && j < 2 * AT_KS; ++j) fq[j][WI][LI] = on ? ld_frag8(BA_QADDR(j)) : zero_frag8();
#pragma unroll
                for (int i = 0; i < 4 && i < 4 * AT_KS; ++i) fr[i][WI][LI] = on ? ld_frag8(BA_KADDR(i)) : zero_frag8(); }
            SCHED_FENCE();
#pragma unroll
            for (int i = 0; i < 4 * AT_KS; ++i) {
                MFMA16(st[i / (2 * AT_KS)][i & 1][WI], fr[i % 4][WI], fq[(i >> 1) & 1][WI]);
                SCHED_FENCE();
                WAVE_FOR { const bool on = HDIM >= 32 || (lane >> 4) < 2;
                    if (i + 4 < 4 * AT_KS) fr[i % 4][WI][LI] = on ? ld_frag8(BA_KADDR(i + 4)) : zero_frag8();
                    if ((i & 1) && (i >> 1) + 2 < 2 * AT_KS) fq[(i >> 1) & 1][WI][LI] = on ? ld_frag8(BA_QADDR((i >> 1) + 2)) : zero_frag8(); }
                SCHED_FENCE(); }
            WAVE_FOR {
#pragma unroll
                for (int i = 0; i < 4 && i < AT_ET; ++i) fr[i][WI][LI] = ld_frag8(BA_VADDR(i)); }
            SCHED_FENCE();
            WAVE_FOR {
#pragma unroll
                for (int c = 0; c < 2; ++c) { float mx = -1.0e30f;
#pragma unroll
                    for (int tau = 0; tau < 2; ++tau) for (int e = 0; e < 4; ++e) { const float v = st[c][tau][WI][LI][e]; mx = v > mx ? v : mx; }
                    tmx[c][WI][LI] = mx; } }
            gmax16(tmx[0][WI]); gmax16(tmx[1][WI]);
            WAVE_FOR { rfl[WI][LI] = 0;
#pragma unroll
                for (int c = 0; c < 2; ++c) { const float mn = tmx[c][WI][LI] > mrow[c][WI][LI] + BA_LAZY ? tmx[c][WI][LI] : mrow[c][WI][LI], alpha = EXP2F(mrow[c][WI][LI] - mn); rfl[WI][LI] |= (mn != mrow[c][WI][LI]) ? 1 : 0; mrow[c][WI][LI] = mn; alp[c][WI][LI] = alpha; float ps = 0.f, p8[8];
#pragma unroll
                    for (int tau = 0; tau < 2; ++tau) for (int e = 0; e < 4; ++e) { const float pvv = EXP2F(st[c][tau][WI][LI][e] - mn); ps += pvv; p8[4 * tau + e] = pvv; }
                    pf[c][WI][LI] = pack8(p8); lrow[c][WI][LI] = lrow[c][WI][LI] * alpha + ps; } }
            if (WANY(rfl[WI])) {
                WAVE_FOR {
#pragma unroll
                    for (int c = 0; c < 2; ++c) { const float alpha = alp[c][WI][LI];
#pragma unroll
                        for (int et = 0; et < AT_ET; ++et) for (int e = 0; e < 4; ++e) oacc[c][et][WI][LI][e] *= alpha; } } }
            SCHED_FENCE();
#pragma unroll
            for (int et = 0; et < AT_ET; ++et) {
                MFMA16(oacc[0][et][WI], fr[et % 4][WI], pf[0][WI]); MFMA16(oacc[1][et][WI], fr[et % 4][WI], pf[1][WI]);
                SCHED_FENCE();
                if (et + 4 < AT_ET) { WAVE_FOR { fr[et % 4][WI][LI] = ld_frag8(BA_VADDR(et + 4)); } }
                SCHED_FENCE(); }
#undef BA_KADDR
#undef BA_QADDR
#undef BA_VADDR
        }
        BA_DMA_WAIT();
        BLOCK_SYNC();
    }
    BLOCK_WAVES {
        gsum16(lrow[0][WI]); gsum16(lrow[1][WI]);
        float ssq[NL];
        WAVE_FOR { const float i0 = 1.0f / lrow[0][WI][LI], i1 = lam / lrow[1][WI][LI]; float sq = 0.f;
#pragma unroll
            for (int et = 0; et < AT_ET; ++et) for (int e = 0; e < 4; ++e) { const float o = oacc[0][et][WI][LI][e] * i0 - oacc[1][et][WI][LI][e] * i1; oacc[0][et][WI][LI][e] = o; sq += o * o; }
            ssq[LI] = sq; }
        gsum16(ssq);
        WAVE_FOR { const int q = lane & 15, kg = lane >> 4, row0 = seq0 + qb * BA_QB + 16 * wv; const float rstd = rsq(ssq[LI] / (float)VD + NORM_EPS) * (1.0f - lam_init);
#pragma unroll
            for (int et = 0; et < AT_ET; ++et) { float o4[4]; for (int e = 0; e < 4; ++e) o4[e] = oacc[0][et][WI][LI][e] * rstd * p.at_g_sub[16 * et + 4 * kg + e]; st4b(p.H + (size_t)(row0 + q) * D + h * VD + 16 * et + 4 * kg, o4); } }
    }
#undef BA_FETCH
#undef BA_VSW
} };

constexpr int BC_VROW_L = DEC_SEQ + 8, BC_TROW_L = 2 * DEC_SEQ + 16, BC_VROW_C = SEQ + 8, BC_TROW_C = 2 * SEQ + 16;
constexpr int BC_RA = DEC_BATCH * BC_VROW_L + 8 * BC_TROW_L + 2 * DEC_SEQ, BC_RB = BATCH * BC_VROW_C + 8 * BC_TROW_C + 2 * SEQ;
constexpr int BC_VCH_L = DEC_BATCH * DEC_SEQ / 8, BC_TCH_L = 2 * DEC_SEQ / 8, BC_VCH_C = BATCH * SEQ / 8, BC_TCH_C = 2 * SEQ / 8;
constexpr int BC_CPT_L = (BC_VCH_L + BC_TCH_L + 511) / 512, BC_CPT_C = (BC_VCH_C + BC_TCH_C + 511) / 512, BC_CPT = BC_CPT_L > BC_CPT_C ? BC_CPT_L : BC_CPT_C;
static_assert((BC_RA + BC_RB) * 2 <= 146944, "conv LDS");
#ifdef HOST_EMU
static inline void unpack8(const Frag8& f, float* v) { for (int e = 0; e < 8; ++e) v[e] = bf2f(f.e[e]); }
#else
__device__ __forceinline__ void unpack8(const Frag8& f, float* v) { const U32x4v u = __builtin_bit_cast(U32x4v, f);
    _Pragma("unroll") for (int i = 0; i < 4; ++i) { const unsigned w = u[i]; v[2 * i] = __uint_as_float(w << 16); v[2 * i + 1] = __uint_as_float(w & 0xffff0000u); } }
#endif
struct B_conv { static constexpr int NITEMS = 1; static HD void run(const P& p, int j, int stride_, int first, float* ldsf) {
    bf16* lds = (bf16*)ldsf; const int stride = stride_ > 0 ? stride_ : 1; int c = first; if (c >= D) return;
    float wsx[4], wsv[4], nsx[4], nsv[4]; const float* ws = p.hy_w_short + (size_t)j * 9 * D; const float* bsb = p.hy_b_short + (size_t)j * 3 * D;
#define BC_LOADW(cc, WX, WV) do { for (int tp = 0; tp < 3; ++tp) { WX[tp] = ws[(size_t)tp * 3 * D + D + (cc)]; WV[tp] = ws[(size_t)tp * 3 * D + 2 * D + (cc)]; } WX[3] = bsb[D + (cc)]; WV[3] = bsb[2 * D + (cc)]; } while (0)
    BC_LOADW(c, wsx, wsv);
    Frag8 rx[2][BC_CPT][NW][NL], rv[2][BC_CPT][NW][NL]; unsigned hxa[2][BC_CPT][NW][NL], hxb[2][BC_CPT][NW][NL], hva[2][BC_CPT][NW][NL], hvb[2][BC_CPT][NW][NL];
#define BC_FETCH(cls, cc) BLOCK_WAVES { WAVE_FOR { const int vch = (cls) ? BC_VCH_L : BC_VCH_C, tch = (cls) ? BC_TCH_L : BC_TCH_C, Lc = (cls) ? DEC_SEQ : SEQ; \
        _Pragma("unroll") for (int k = 0; k < BC_CPT; ++k) { const int ci = BTID + 512 * k; \
            if (ci < vch) { const int gt = ((cls) ? MC : 0) + 8 * ci, tl = (8 * ci) % Lc; const bf16* xr = p.ZT + (size_t)(cc) * M + gt; const bf16* vr = p.ZT + (size_t)(D + (cc)) * M + gt; \
                rx[cls][k][WI][LI] = ld_frag8(xr); rv[cls][k][WI][LI] = ld_frag8(vr); \
                const int oa = tl > 0 ? -1 : 0, ob = tl + 8 < Lc ? 4 : 3;     \
                hxa[cls][k][WI][LI] = ((const unsigned*)xr)[oa]; hxb[cls][k][WI][LI] = ((const unsigned*)xr)[ob]; hva[cls][k][WI][LI] = ((const unsigned*)vr)[oa]; hvb[cls][k][WI][LI] = ((const unsigned*)vr)[ob]; } \
            else if (ci < vch + tch) { const int t = ci - vch; rx[cls][k][WI][LI] = ld_frag8(p.KT + kt_off(j, (cls), (cc)) + 8 * (size_t)t); } } (void)Lc; } }
#define BC_COMMIT(cls, WX, WV) BLOCK_WAVES { WAVE_FOR { const int vch = (cls) ? BC_VCH_L : BC_VCH_C, tch = (cls) ? BC_TCH_L : BC_TCH_C, Lc = (cls) ? DEC_SEQ : SEQ, vrow = (cls) ? BC_VROW_L : BC_VROW_C, trow = (cls) ? BC_TROW_L : BC_TROW_C; \
        bf16* reg = lds + ((cls) ? 0 : BC_RA); bf16* tsl = reg + ((cls) ? DEC_BATCH : BATCH) * vrow; \
        _Pragma("unroll") for (int k = 0; k < BC_CPT; ++k) { const int ci = BTID + 512 * k; \
            if (ci < vch) { const int e0 = 8 * ci; float xx[10], vv[10], g8[8]; unpack8(rx[cls][k][WI][LI], xx + 1); unpack8(rv[cls][k][WI][LI], vv + 1); const int tl = e0 % Lc; const bool ea = tl > 0, eb = tl + 8 < Lc; \
                xx[0] = ea ? bf2f((bf16)(hxa[cls][k][WI][LI] >> 16)) : 0.f; xx[9] = eb ? bf2f((bf16)(hxb[cls][k][WI][LI] & 0xffffu)) : 0.f; vv[0] = ea ? bf2f((bf16)(hva[cls][k][WI][LI] >> 16)) : 0.f; vv[9] = eb ? bf2f((bf16)(hvb[cls][k][WI][LI] & 0xffffu)) : 0.f; \
                for (int e = 0; e < 8; ++e) { const float x1 = xx[e] * WX[0] + xx[e + 1] * WX[1] + xx[e + 2] * WX[2] + WX[3], v1 = vv[e] * WV[0] + vv[e + 1] * WV[1] + vv[e + 2] * WV[2] + WV[3]; g8[e] = x1 * v1; } \
                st_frag8(reg + (e0 / Lc) * vrow + (e0 % Lc), pack8(g8)); } \
            else if (ci < vch + tch) { st_frag8(tsl + 8 * trow + 8 * (ci - vch), rx[cls][k][WI][LI]); } } } }
#define BC_BUILD(cls) BLOCK_WAVES { WAVE_FOR { const int Lc = (cls) ? DEC_SEQ : SEQ, vrow = (cls) ? BC_VROW_L : BC_VROW_C, trow = (cls) ? BC_TROW_L : BC_TROW_C; \
        bf16* tsl = lds + ((cls) ? 0 : BC_RA) + ((cls) ? DEC_BATCH : BATCH) * vrow; const bf16* ktl = tsl + 8 * trow; \
        for (int ci = BTID; ci < 2 * Lc; ci += 512) { const int rho = ci / (2 * Lc / 8), idx0 = 8 * (ci % (2 * Lc / 8)); Frag8 f; \
            _Pragma("unroll") for (int e = 0; e < 8; ++e) { const int jt = rho - (idx0 + e - Lc); f[e] = (jt > -Lc && jt < Lc) ? (short)ktl[jt + Lc] : (short)0; } \
            st_frag8(tsl + rho * trow + idx0, f); } } }
#define BC_LOADG(SET, grp) WAVE_FOR { const int r = lane & 31, h = lane >> 5, a = r >> 3, rho = r & 7, sl = sg * SPG + r / TPG, t1 = tg * TPG + r % TPG; \
        _Pragma("unroll") for (int u = 0; u < 4; ++u) { const int dl = dlo + 2 * (grp) + (u >> 1), ks = u & 1, q = 2 * dl - ks, s1 = t1 - dl; const bool dv = dl <= dhi; \
            ga[SET][u][LI] = ld_frag8(tsl + rho * trow + (dv ? 8 * (h - a - 2 * q) + L : 0)); \
            gb[SET][u][LI] = ld_frag8((dv && s1 >= 0 && s1 < NB) ? reg + sl * vrow + 32 * s1 + 16 * ks + 8 * h : reg + L); } }
#define BC_MFMAG(SET) _Pragma("unroll") for (int u = 0; u < 4; ++u) MFMA32(acc, ga[SET][u], gb[SET][u]);
#define BC_COMPUTE(cls) BLOCK_WAVES { const int NG = (cls) ? CV_NG_L : CV_NG_C; if (wv < NG) { \
        const int SPG = (cls) ? CV_SPG_L : CV_SPG_C, TPG = (cls) ? CV_TPG_L : CV_TPG_C, NB = (cls) ? CV_NB_L : CV_NB_C, L = (cls) ? DEC_SEQ : SEQ, vrow = (cls) ? BC_VROW_L : BC_VROW_C, trow = (cls) ? BC_TROW_L : BC_TROW_C; \
        const bf16* reg = lds + ((cls) ? 0 : BC_RA); const bf16* tsl = reg + ((cls) ? DEC_BATCH : BATCH) * vrow; \
        const int ntg = NB / TPG, sg = wv / ntg, tg = wv % ntg, dlo = tg * TPG - (NB - 1), dhi = tg * TPG + TPG - 1, ngrp = (((TPG + NB - 1) + 1) / 2 + 1) & ~1; \
        Acc16 acc[NL]; Frag8 ga[2][4][NL], gb[2][4][NL]; \
        WAVE_FOR { for (int r = 0; r < 16; ++r) acc[LI][r] = 0.f; } \
        BC_LOADG(0, 0) \
        SCHED_FENCE(); \
        _Pragma("unroll 1") for (int g = 0; g < ngrp; g += 2) { BC_LOADG(1, g + 1) SCHED_FENCE(); BC_MFMAG(0) SCHED_FENCE(); BC_LOADG(0, g + 2) SCHED_FENCE(); BC_MFMAG(1) SCHED_FENCE(); } \
        WAVE_FOR { const int r = lane & 31, h = lane >> 5; const int sl = sg * SPG + r / TPG, t1 = tg * TPG + r % TPG; const int gbase = ((cls) ? MC + sl * DEC_SEQ : sl * SEQ) + 32 * t1; \
            _Pragma("unroll") for (int rg = 0; rg < 4; ++rg) { const int to = 8 * rg + 4 * h; float o4[4]; \
                for (int e = 0; e < 4; ++e) o4[e] = acc[LI][4 * rg + e] + skip * bf2f(reg[sl * vrow + 32 * t1 + to + e]); \
                st4b(p.YT + (size_t)c * M + gbase + to, o4); } } } }
    BLOCK_WAVES { WAVE_FOR { if (BTID < 8) { lds[DEC_SEQ + BTID] = 0; lds[BC_RA + SEQ + BTID] = 0; } } }
    float skip = p.hy_skip[j * D + c], nskip = 0.f;
    BC_FETCH(1, c) BC_FETCH(0, c)
    for (;;) { const int cn = c + stride; const bool more = cn < D;
        BC_COMMIT(1, wsx, wsv)
        if (more) { BC_LOADW(cn, nsx, nsv); nskip = p.hy_skip[j * D + cn]; BC_FETCH(1, cn) }
        BLOCK_SYNC();
        BC_BUILD(1)
        BLOCK_SYNC();
        BC_COMPUTE(1)
        BC_COMMIT(0, wsx, wsv)
        if (more) { BC_FETCH(0, cn) }
        BLOCK_SYNC();
        BC_BUILD(0)
        BLOCK_SYNC();
        BC_COMPUTE(0)
        if (!more) break;
        c = cn; skip = nskip; for (int tp = 0; tp < 4; ++tp) { wsx[tp] = nsx[tp]; wsv[tp] = nsv[tp]; }
    }
#undef BC_LOADW
#undef BC_FETCH
#undef BC_COMMIT
#undef BC_COMPUTE
#undef BC_LOADG
#undef BC_MFMAG
#undef BC_BUILD
} };

constexpr int S5_NLONG = DEC_BATCH * SGS, S5_NSHORT = BATCH * SGS, S5_R = S5_NSHORT / S5_NLONG;
static_assert(S5_NSHORT % S5_NLONG == 0, "S5 item balance");
#ifdef HOST_EMU
static inline void ld4f_nc(const float* p, float* v) { for (int e = 0; e < 4; ++e) v[e] = p[e]; }
#else
__device__ __forceinline__ void ld4f_nc(const float* p, float* v) { const unsigned long long a = __hip_atomic_load((const unsigned long long*)p, __ATOMIC_RELAXED, __HIP_MEMORY_SCOPE_AGENT), b = __hip_atomic_load((const unsigned long long*)p + 1, __ATOMIC_RELAXED, __HIP_MEMORY_SCOPE_AGENT);
    v[0] = __uint_as_float((unsigned)a); v[1] = __uint_as_float((unsigned)(a >> 32)); v[2] = __uint_as_float((unsigned)b); v[3] = __uint_as_float((unsigned)(b >> 32)); }
#endif
struct W_s5f { static constexpr int NITEMS = 2 * S5_NLONG * S5_R; static HD void run(const P& p, int, int, int item, float* ldsf) {
    const int vs = item / (2 * S5_NLONG), vw = item % (2 * S5_NLONG); int sg;
    if (vw < S5_NLONG) { if (vs != 0) return; sg = BATCH * SGS + vw; } else sg = vs * S5_NLONG + (vw - S5_NLONG);
    const int g = sg % SGS, sidx = sg / SGS; const bool lat = sidx >= BATCH; const int b = lat ? sidx - BATCH : sidx;
  for (int dir = 0; dir < 2; ++dir) {
    const int L = lat ? DEC_SEQ : SEQ, seq0 = lat ? MC + b * DEC_SEQ : b * SEQ; const size_t dg = (size_t)dir * SGS + g;
    unsigned* tl = (unsigned*)ldsf; float* Y = p.YF;
    Frag8 fb[4][NL], fc[4][NL], fa[NL], fx[NL]; Acc16 bu[4][NL]; Acc4 yv[2][NL]; float lbr[NL], lbi[NL], xr[NL], xi[NL];
    WAVE_FOR { const int n = lane & 31, hh = lane >> 5, pp = n + 32 * hh;
#pragma unroll
        for (int q = 0; q < 4; ++q) { fb[q][LI] = ld_frag8(p.S5BB + (dg * 128 + 32 * q + n) * SG + 8 * hh); fc[q][LI] = ld_frag8(p.S5CM + (dg * SG + (lane & 15)) * 128 + 32 * q + 8 * (lane >> 4)); }
        lbr[LI] = p.S5LB[2 * (dg * SP + pp)]; lbi[LI] = p.S5LB[2 * (dg * SP + pp) + 1];
        if (lat) { const size_t si = (((size_t)b * NSS) * 2 + dir) * SGS * SP + (size_t)g * SP + pp; xr[LI] = p.st_re[si]; xi[LI] = p.st_im[si]; } else { xr[LI] = 0.f; xi[LI] = 0.f; } }
    WAVE_FOR { const int m = lane & 31, hh = lane >> 5, pos = 16 * ((m >> 2) & 1) + 4 * (m >> 3) + (m & 3), t = dir ? L - 1 - pos : pos; fa[LI] = ld_frag8(p.H + (size_t)(seq0 + t) * D + g * SG + 8 * hh); }
    for (int ch = 0; ch < L / 32; ++ch) {
        WAVE_FOR {
#pragma unroll
            for (int q = 0; q < 4; ++q) for (int r = 0; r < 16; ++r) bu[q][LI][r] = 0.f; }
#pragma unroll
        for (int q = 0; q < 4; ++q) MFMA32(bu[q], fa, fb[q]);
        if (ch + 1 < L / 32) { WAVE_FOR { const int m = lane & 31, hh = lane >> 5, pos = (ch + 1) * 32 + 16 * ((m >> 2) & 1) + 4 * (m >> 3) + (m & 3), t = dir ? L - 1 - pos : pos;
            fa[LI] = ld_frag8(p.H + (size_t)(seq0 + t) * D + g * SG + 8 * hh); } }
        SWAP32(bu[0], bu[1]); SWAP32(bu[2], bu[3]);
        WAVE_FOR { const int pp = (lane & 31) + 32 * (lane >> 5); float ar = xr[LI], ai = xi[LI]; const float cr_ = lbr[LI], ci_ = lbi[LI];
#pragma unroll
            for (int s = 0; s < 32; ++s) { const float ur = bu[s >> 4][LI][s & 15], ui = bu[2 + (s >> 4)][LI][s & 15];
                const float nr = fmaf(cr_, ar, fmaf(-ci_, ai, ur)), ni = fmaf(cr_, ai, fmaf(ci_, ar, ui)); ar = nr; ai = ni;
                tl[s * S5_ROWW + pp] = pk2bf(nr, ni); }
            xr[LI] = ar; xi[LI] = ai; }
        WAVE_SYNC_LDS();
#pragma unroll
        for (int pt = 0; pt < 2; ++pt) { WAVE_FOR { for (int e = 0; e < 4; ++e) yv[pt][LI][e] = 0.f; }
#pragma unroll
            for (int ks = 0; ks < 4; ++ks) { WAVE_FOR { fx[LI] = ld_frag8((const bf16*)(tl + (16 * pt + (lane & 15)) * S5_ROWW) + 32 * ks + 8 * (lane >> 4)); }
                MFMA16(yv[pt], fc[ks], fx); } }
        WAVE_FOR { const int kg = lane >> 4;
#pragma unroll
            for (int pt = 0; pt < 2; ++pt) { const int pos = ch * 32 + 16 * pt + (lane & 15), t = dir ? L - 1 - pos : pos; const size_t o = (size_t)(seq0 + t) * D + g * SG + 4 * kg; float* yo = Y + o;
                if (dir == 0) { for (int e = 0; e < 4; ++e) yo[e] = yv[pt][LI][e]; }
                else { float yf[4], u4[4], d4[4], o4[4]; ld4f_nc(yo, yf); ld4b(p.H + o, u4); ld4f(p.s5_d + g * SG + 4 * kg, d4);
                    for (int e = 0; e < 4; ++e) o4[e] = gelu_tanh_f(d4[e] * u4[e] + yf[e] + yv[pt][LI][e]); st4b(p.H + o, o4); } } }
        WAVE_SYNC_LDS();
    }
    if (!lat) { WAVE_FOR { const size_t so = (((size_t)b * NSS) * 2 + dir) * SGS * SP + (size_t)g * SP + (lane & 31) + 32 * (lane >> 5); p.out[OUT_SRE + so] = xr[LI]; p.out[OUT_SIM + so] = xi[LI]; } }
    WAVE_SYNC();
  }
} };


#ifdef HOST_EMU
template <class F> static void run_elem(const P& p, int a0, int a1, size_t n) { for (size_t i = 0; i < n; ++i) F::run(p, a0, a1, i); }
template <class F> static void run_block(const P& p, int a0, int a1) { std::vector<float> lds(65536); for (int it = 0; it < F::NITEMS; ++it) F::run(p, a0, a1, it, lds.data()); }
template <class F> static void run_wave(const P& p, int a0, int a1) { std::vector<float> lds(65536); for (int it = 0; it < F::NITEMS; ++it) F::run(p, a0, a1, it, lds.data()); }
static int wt_dst_row(int n, int N, int mode) { if (mode == 0) return n; const int Dm = N / 2, half = n / Dm, j = n % Dm; return 256 * (j / 128) + 128 * half + (j % 128); }
static void run_wtrans(const float* W, int K, int N, bf16* WT, int mode = 0) { for (int n = 0; n < N; ++n) for (int k = 0; k < K; ++k) WT[(size_t)wt_dst_row(n, N, mode) * K + k] = f2bf(W[(size_t)k * N + n]); }
enum { EP_B16 = 1, EP_RELU2 = 2, EP_QKV = 3, EP_GLU = 4, EP_B16R = 5 };
static void run_gemm(const P& p, const bf16* A, const bf16* Bt, int M_, int N, int K, int mode, bf16* Cb, int ldc, const float* bias) {
    std::vector<float> a((size_t)M_ * K), bt((size_t)N * K), accr(N); for (size_t i = 0; i < a.size(); ++i) a[i] = bf2f(A[i]); for (size_t i = 0; i < bt.size(); ++i) bt[i] = bf2f(Bt[i]);
    for (int m = 0; m < M_; ++m) { for (int n = 0; n < N; ++n) { float acc = 0.f; const float* ar = &a[(size_t)m * K]; const float* br = &bt[(size_t)n * K]; for (int k = 0; k < K; ++k) acc += ar[k] * br[k]; accr[n] = acc; }
        if (mode == EP_B16) for (int n = 0; n < N; ++n) Cb[(size_t)m * ldc + n] = f2bf(accr[n] + (bias ? bias[n] : 0.f));
        else if (mode == EP_B16R) for (int n = 0; n < N; ++n) Cb[(size_t)m * ldc + n] = f2bf(accr[n] + bias[m]);
        else if (mode == EP_RELU2) for (int n = 0; n < N; ++n) { const float v = accr[n] > 0.f ? accr[n] : 0.f; Cb[(size_t)m * ldc + n] = f2bf(v * v); }
        else if (mode == EP_QKV) { if (m >= MC) { const int t = (m - MC) % DEC_SEQ; for (int n = 0; n < 2 * D; ++n) { const int w = n % HDIM, grp = w / (2 * QD), ii = w % QD; if ((w / QD) % 2 == 0) { const float cs = p.RT[((size_t)t * 2 * QD + grp * QD + ii) * 2], sn = p.RT[((size_t)t * 2 * QD + grp * QD + ii) * 2 + 1], a = accr[n], bq = accr[n + QD]; accr[n] = a * cs - bq * sn; accr[n + QD] = bq * cs + a * sn; } } }
          for (int n = 0; n < N; ++n) { if (n < 2 * D) { Cb[(size_t)m * ldc + n] = f2bf(accr[n]); if (m < MC && n >= D) p.out[OUT_K + (size_t)m * D + (n % D)] = accr[n]; }
            else { const bool ctx = m < MC; const int vc = n - 2 * D, b = ctx ? m / SEQ : (m - MC) / DEC_SEQ, key = ctx ? m % SEQ : PAST + (m - MC) % DEC_SEQ, T = ctx ? SEQ : TMAX, pos = 32 * (key >> 5) + kperm32(key & 31);
                if (ctx) p.out[OUT_V + (size_t)m * D + vc] = accr[n]; p.VTT[(ctx ? (size_t)0 : VTT_C) + (size_t)b * NH * VD * T + (size_t)vc * T + pos] = f2bf(accr[n]); } } }
        else if (mode == EP_GLU) for (int pn = 0; pn < N / 256; ++pn) for (int jj = 0; jj < 128; ++jj) { const int j = 128 * pn + jj; const float av = accr[256 * pn + jj] + bias[j], gv = accr[256 * pn + 128 + jj] + bias[N / 2 + j]; Cb[(size_t)m * ldc + j] = f2bf(av / (1.0f + expf(-gv))); } }
}

static void forward(const P& p) {
    run_elem<E_ropetab>(p, 0, 0, (size_t)DEC_SEQ * 2 * QD); run_elem<E_kcvt8>(p, 0, 0, (size_t)DEC_BATCH * NAT * PAST * NH * 2 * HDIM / 8); run_wave<W_vtransc>(p, 0, 0);
    run_elem<E_scond>(p, 0, 0, (size_t)NCND * D); run_elem<E_s5tab>(p, 0, 0, (size_t)2 * SGS * SP); run_elem<E_filt1>(p, 0, 0, (size_t)NHY * LMAX * FW);
    for (int l = 0; l < DEPTH; ++l) { run_wtrans(p.w_mlp_in + (size_t)l * D * DFF, D, DFF, p.Wt_mlp_in + (size_t)l * D * DFF); run_wtrans(p.w_mlp_out + (size_t)l * D * DFF, DFF, D, p.Wt_mlp_out + (size_t)l * D * DFF); }
    for (int j = 0; j < NHY; ++j) { run_wtrans(p.hy_w_in + (size_t)j * D * 3 * D, D, 3 * D, p.Wt_hy_in + (size_t)j * D * 3 * D); run_wtrans(p.hy_w_out + (size_t)j * D * D, D, D, p.Wt_hy_out + (size_t)j * D * D); }
    run_wtrans(p.at_w_qkv, D, 3 * D, p.Wt_qkv); run_wtrans(p.at_w_o, D, D, p.Wt_wo); run_wtrans(p.s5_w_glu, D, 2 * D, p.Wt_glu, 1);
    run_elem<E_modp>(p, 0, 0, (size_t)DEPTH * MOD_KS * 6 * D / 4); run_elem<E_filt2>(p, 0, 0, (size_t)NHY * LMAX * FW);
    run_elem<E_modvec2>(p, 0, 0, (size_t)DEPTH * 2 * NCND * 3 * D); run_elem<E_filt3c>(p, 0, 0, (size_t)NHY * F3_NCH * 2 * D);
    run_elem<E_fk2>(p, 0, 0, (size_t)NHY * (FK_NC0 + FK_NC1) * D);
    for (int i = 0; i < DEPTH; ++i) {
        const int kind = i % 3, j = i / 3;
        run_wave<W_thin2>(p, i > 0 ? (((i - 1) * 8 + 1) | TH_MODE_B | (i == 1 ? TH_SRC_IN : 0)) : -1, i * 8 + 0);
        if (kind == 0) {
            run_gemm(p, p.H, p.Wt_hy_in + (size_t)j * D * 3 * D, M, D, D, EP_B16, p.Z0, D, p.hy_b_in + (size_t)j * 3 * D);
            run_gemm(p, p.Wt_hy_in + (size_t)j * D * 3 * D + (size_t)D * D, p.H, 2 * D, M, D, EP_B16R, p.ZT, M, p.hy_b_in + (size_t)j * 3 * D + D);
            run_block<B_conv>(p, j, 0);
            run_wave<W_hconv3y>(p, j, 0);
            run_gemm(p, p.H, p.Wt_hy_out + (size_t)j * D * D, M, D, D, EP_B16, p.ObA, D, p.hy_b_out + (size_t)j * D);
        } else if (kind == 1) {
            run_gemm(p, p.H, p.Wt_qkv, M, 3 * D, D, EP_QKV, p.Z, 3 * D, nullptr);
            run_block<B_attn>(p, 0, 0);
            run_gemm(p, p.H, p.Wt_wo, M, D, D, EP_B16, p.ObA, D, nullptr);
        } else {
            run_wave<W_s5f>(p, 0, 0);
            run_gemm(p, p.H, p.Wt_glu, M, 2 * D, D, EP_GLU, p.ObA, D, p.s5_b_glu);
        }
        run_wave<W_thin2>(p, (i * 8 + 0) | TH_MODE_A | (i == 0 ? TH_SRC_IN : 0), i * 8 + 1);
        run_gemm(p, p.H, p.Wt_mlp_in + (size_t)i * D * DFF, M, DFF, D, EP_RELU2, p.HID, DFF, nullptr);
        run_gemm(p, p.HID, p.Wt_mlp_out + (size_t)i * D * DFF, M, D, DFF, EP_B16, p.Ob, D, nullptr);
    }
    run_wave<W_thin2>(p, ((DEPTH - 1) * 8 + 1) | TH_MODE_B, -1);
}

struct Bump { unsigned char* base; size_t off; template <class T> T* take(size_t n) { T* r = (T*)(base + off); off += (n * sizeof(T) + 255) & ~(size_t)255; return r; } };
static size_t carve(P& p, unsigned char* ws) {
    Bump b{ws, 0};
    p.CTL = b.take<unsigned>(CTL_BYTES / 4);
    p.Wt_mlp_in = b.take<bf16>((size_t)DEPTH * D * DFF); p.Wt_mlp_out = b.take<bf16>((size_t)DEPTH * D * DFF); p.Wt_hy_in = b.take<bf16>((size_t)NHY * D * 3 * D); p.Wt_hy_out = b.take<bf16>((size_t)NHY * D * D);
    p.Wt_qkv = b.take<bf16>((size_t)D * 3 * D); p.Wt_wo = b.take<bf16>((size_t)D * D); p.Wt_glu = b.take<bf16>((size_t)D * 2 * D);
    p.X = b.take<float>((size_t)M * D); p.MOD = b.take<float>((size_t)DEPTH * NCND * 6 * D); p.SCOND = b.take<float>((size_t)NCND * D); p.O = b.take<float>((size_t)M * D);
    p.HRAW = b.take<float>((size_t)NHY * LMAX * 2 * D); p.H1 = b.take<float>((size_t)NHY * LMAX * FW); p.H2 = b.take<float>((size_t)NHY * LMAX * FW); p.KINV = b.take<float>((size_t)NHY * 2 * D);
    p.KT = b.take<bf16>((size_t)NHY * KT_LAYER); p.S5BB = b.take<bf16>(S5_BBT); p.S5CM = b.take<bf16>(S5_CMT); p.S5LB = b.take<float>((size_t)2 * SGS * SP * 2); p.MV = b.take<float>((size_t)DEPTH * 2 * NCND * 3 * D); p.PS = b.take<float>((size_t)NHY * F3_NCH * 2 * D); p.PM = b.take<float>((size_t)MOD_KS * DEPTH * NCND * 6 * D); p.Ob = (bf16*)p.O; p.ObA = p.Ob + (size_t)M * D; p.RS = b.take<float>((size_t)2 * M); p.RT = b.take<float>((size_t)DEC_SEQ * 2 * QD * 2 + 16);
    p.KC = b.take<bf16>((size_t)DEC_BATCH * NAT * PAST * NH * 2 * HDIM); p.VTT = b.take<bf16>(VTT_ALL);
    p.XB = b.take<bf16>((size_t)M * D);
    p.H = b.take<bf16>((size_t)M * D); p.Z = b.take<bf16>((size_t)M * 3 * D); p.Z0 = p.Z; p.ZT = p.Z + (size_t)M * D;
    const size_t hid_off = b.off; p.HID = b.take<bf16>((size_t)M * DFF); const size_t hid_end = b.off;
    Bump o{ws, hid_off}; p.YF = o.take<float>((size_t)M * D); p.YB = o.take<float>((size_t)M * D); p.X0C = p.YF; p.VV = p.YB;
    Bump o2{ws, hid_off}; p.YT = o2.take<bf16>((size_t)D * M); p.TS = o2.take<bf16>(TS_ALL); p.X0Cb = p.YT; p.VT = p.YT;
    size_t end = hid_end; if (o.off > end) end = o.off; if (o2.off > end) end = o2.off; return end;
}
static void set_inputs(P& p, void* const* in) {
    const float** f = (const float**)&p.x_prompt; for (int i = 0; i < 42; ++i) f[i] = (const float*)in[i];
}


int main(int argc, char** argv) {
    const size_t G_ = SGS, P_ = SP, H_ = SG;
    const size_t sizes[42] = {(size_t)MC * D, (size_t)ML * D, (size_t)DEC_BATCH * NAT * PAST * NH * 2 * HDIM, (size_t)DEC_BATCH * NAT * PAST * NH * VD, (size_t)DEC_BATCH * NSS * 2 * G_ * P_, (size_t)DEC_BATCH * NSS * 2 * G_ * P_,
        (size_t)DEC_BATCH * D, (size_t)D, (size_t)DEPTH * D * 6 * D, (size_t)DEPTH * 6 * D, (size_t)DEPTH * 4 * D, (size_t)DEPTH * D * DFF, (size_t)DEPTH * DFF * D,
        (size_t)NHY * D * 3 * D, (size_t)NHY * 3 * D, (size_t)NHY * 3 * 3 * D, (size_t)NHY * 3 * D, (size_t)NHY * 32 * FW, (size_t)NHY * FW, (size_t)NHY * FW, (size_t)NHY * FW * FW, (size_t)NHY * FW, (size_t)NHY * FW,
        (size_t)NHY * FW * 2 * D, (size_t)NHY * D, (size_t)NHY * D, (size_t)NHY * D * D, (size_t)NHY * D,
        (size_t)NAT * D * 3 * D, (size_t)NAT * 4 * HDIM, (size_t)NAT * VD, (size_t)NAT * D * D,
        (size_t)NSS * 2 * G_ * P_, (size_t)NSS * 2 * G_ * P_, (size_t)NSS * 2 * G_, (size_t)NSS * 2 * G_ * P_ * H_, (size_t)NSS * 2 * G_ * P_ * H_, (size_t)NSS * 2 * G_ * H_ * P_, (size_t)NSS * 2 * G_ * H_ * P_,
        (size_t)NSS * D, (size_t)NSS * D * 2 * D, (size_t)NSS * 2 * D};
    FILE* f = fopen(argc > 1 ? argv[1] : "in_small.bin", "rb"); if (!f) { printf("no input\n"); return 1; }
    std::vector<std::vector<float>> ins(42); void* inp[42];
    for (int i = 0; i < 42; ++i) { ins[i].resize(sizes[i]); if (fread(ins[i].data(), 4, sizes[i], f) != sizes[i]) { printf("short read %d\n", i); return 1; } inp[i] = ins[i].data(); }
    fclose(f);
    P p; memset(&p, 0, sizeof(p)); set_inputs(p, inp);
    P tmp = p; const size_t need = carve(tmp, nullptr);
    std::vector<unsigned char> ws(need + 256, 0xAA); std::vector<float> out(OUT_END, -7.f);
    carve(p, ws.data()); p.out = out.data();
    forward(p);
    FILE* g = fopen(argc > 2 ? argv[2] : "emu_out.bin", "wb"); fwrite(out.data(), 4, out.size(), g); fclose(g);
    printf("host emulation done: %zu outputs, ws %zu bytes\n", out.size(), need);
    return 0;
}

#else
namespace pg8 {
#define PG8_LAS __attribute__((address_space(3)))
typedef unsigned short bf16_t;
typedef short bf16x8 __attribute__((ext_vector_type(8)));
typedef float f32x4 __attribute__((ext_vector_type(4)));
typedef unsigned u32x4 __attribute__((ext_vector_type(4)));
constexpr int BM = 256, BK = 64, HALF = 128, HTB = HALF * BK * 2  , STAGE_BYTES = 8 * HTB, NXCD = 8, WGM = 8;

__host__ __device__ __forceinline__ int lds_byte(int r, int c) { const int st = (r >> 4) * 2 + (c >> 5), rr = r & 15, cc = c & 31, ob = rr * 64 + cc * 2; return st * 1024 + (ob ^ (((ob >> 9) & 1) << 5)); }
__host__ __device__ __forceinline__ void stage_rc(int b, int& R, int& C) { const int st = b / 1024, sb = b % 1024, swz = sb ^ (((sb >> 9) & 1) << 5); R = (st >> 1) * 16 + swz / 64; C = (st & 1) * 32 + (swz % 64) / 2; }
__host__ __device__ __forceinline__ int perm32(int rho) { const int n = rho >> 4, i = rho & 15; return 8 * (i >> 2) + 4 * n + (i & 3); }

struct Unit { int pm, pn; };
struct Gemm { const bf16_t* A; const bf16_t* Bt; int M, N, K, pad; };

struct StaticOrder {
    int nM, nN, nwg, G, c;
    __host__ __device__ void init(int M, int N, int G_, int c_) { nM = M / BM; nN = N / BM; nwg = nM * nN; G = G_; c = c_; }
    __host__ __device__ bool next(int i, Unit& u) const {
        const long L = (long)i * G + c; if (L >= nwg) return false;
        int wgid = (int)L; { const int q = nwg / NXCD, r = nwg % NXCD, xcd = wgid % NXCD, off = wgid / NXCD; wgid = (xcd < r ? xcd * (q + 1) : r * (q + 1) + (xcd - r) * q) + off; }
        const int nig = WGM * nN, gid = wgid / nig, fm = gid * WGM, gsz = (nM - fm) < WGM ? (nM - fm) : WGM;
        u.pm = fm + ((wgid % nig) % gsz); u.pn = (wgid % nig) / gsz; return true;
    }
    __device__ __forceinline__ void a_ready(const Unit&) const {}
    __device__ __forceinline__ void done(const Unit&) const {}
};

__device__ __forceinline__ unsigned cvt_pk_bf16(float lo, float hi) { unsigned r; asm volatile("v_cvt_pk_bf16_f32 %0, %1, %2" : "=v"(r) : "v"(lo), "v"(hi)); return r; }
typedef float f32x2 __attribute__((ext_vector_type(2)));
template <class Epi, class Sched, bool ALIGN_EPI = false, bool SP2 = false>
__device__ __forceinline__ void gemm_phase(PG8_LAS unsigned char* lds, const Gemm g, const Sched& S, const Epi& E) {
    const int tid = threadIdx.x, wid = __builtin_amdgcn_readfirstlane(tid >> 6), lane = tid & 63, wr = wid >> 2, wc = wid & 3, fr = lane & 15, fq = lane >> 4;
    const int K = g.K, nt = K / BK;
    unsigned voffA[2], voffB[2];
#pragma unroll
    for (int i = 0; i < 2; ++i) { int R, C; stage_rc(tid * 16 + i * 8192, R, C); const int Rb = Epi::PERM ? ((R & ~31) + perm32(R & 31)) : R;
        voffA[i] = (unsigned)(R * K + C) * 2u; voffB[i] = (unsigned)(Rb * K + C) * 2u; }
    const size_t kstep = (size_t)(BK * 2);
    const size_t hstep = (size_t)HALF * K * 2;
    const size_t tstep = 2 * hstep;
    const unsigned ldsw = (unsigned)wid * 1024u;
    const int aoff = lds_byte(wr * 64 + fr, fq * 8), boff = lds_byte(wc * 32 + fr, fq * 8);
#define PG8_SA(b, h) (((b) * 2 + (h)) * HTB)
#define PG8_SB(b, h) ((4 + (b) * 2 + (h)) * HTB)
#define PG8_STAGE(bufoff, gbase, voff) do { _Pragma("unroll") for (int _i = 0; _i < 2; ++_i) \
        __builtin_amdgcn_global_load_lds((const unsigned*)((const char*)(gbase) + (voff)[_i]), (PG8_LAS unsigned*)(lds + (bufoff) + ldsw + _i * 8192), 16, 0, 0); } while (0)
#define PG8_LDA(dst, b, h) do { _Pragma("unroll") for (int m = 0; m < 4; ++m) _Pragma("unroll") for (int k = 0; k < 2; ++k) dst[m][k] = *(const PG8_LAS bf16x8*)(lds + PG8_SA(b, h) + aoff + m * 2048 + k * 1024); } while (0)
#define PG8_LDB(dst, b, h) do { _Pragma("unroll") for (int n = 0; n < 2; ++n) _Pragma("unroll") for (int k = 0; k < 2; ++k) dst[n][k] = *(const PG8_LAS bf16x8*)(lds + PG8_SB(b, h) + boff + n * 2048 + k * 1024); } while (0)
#define PG8_MMA(ai, bj, At, Bt) do { __builtin_amdgcn_s_setprio(1); _Pragma("unroll") for (int m = 0; m < 4; ++m) _Pragma("unroll") for (int n = 0; n < 2; ++n) _Pragma("unroll") for (int k = 0; k < 2; ++k) \
        acc[ai][bj][m][n] = __builtin_amdgcn_mfma_f32_16x16x32_bf16(Bt[n][k], At[m][k], acc[ai][bj][m][n], 0, 0, 0); __builtin_amdgcn_s_setprio(0); } while (0)
#define PG8_WAIT_V(n) asm volatile("s_waitcnt vmcnt(" #n ")" ::: "memory")
#define PG8_WAIT_L(n) asm volatile("s_waitcnt lgkmcnt(" #n ")" ::: "memory")
#define PG8_BAR __builtin_amdgcn_s_barrier()
#define PG8_SCHED __builtin_amdgcn_sched_barrier(0)
    Unit cur, nxt; int ui = 0;
    if (!S.next(0, cur)) return;
    f32x4 acc[2][2][4][2];
#pragma unroll
    for (int a = 0; a < 2; ++a)
#pragma unroll
        for (int b = 0; b < 2; ++b)
#pragma unroll
            for (int m = 0; m < 4; ++m)
#pragma unroll
                for (int n = 0; n < 2; ++n) acc[a][b][m][n] = (f32x4){0.f, 0.f, 0.f, 0.f};
    bf16x8 At[4][2], B0[2][2], B1[2][2];
    const char* cA = (const char*)g.A + (size_t)cur.pm * tstep; const char* cB = (const char*)g.Bt + (size_t)cur.pn * tstep;
    S.a_ready(cur);
    if constexpr (SP2) {
        PG8_STAGE(PG8_SB(0, 0), cB, voffB); PG8_STAGE(PG8_SB(0, 1), cB + hstep, voffB); PG8_STAGE(PG8_SA(0, 0), cA, voffA); PG8_STAGE(PG8_SA(0, 1), cA + hstep, voffA);
        if (wr == 1) PG8_BAR;
        PG8_WAIT_V(2); PG8_BAR;
        PG8_STAGE(PG8_SB(1, 0), cB + kstep, voffB); PG8_STAGE(PG8_SA(1, 0), cA + kstep, voffA); PG8_STAGE(PG8_SB(1, 1), cB + hstep + kstep, voffB);
        PG8_WAIT_V(6); PG8_BAR;
    } else {
        PG8_STAGE(PG8_SB(0, 0), cB, voffB); PG8_STAGE(PG8_SA(0, 0), cA, voffA); PG8_STAGE(PG8_SB(0, 1), cB + hstep, voffB); PG8_STAGE(PG8_SA(0, 1), cA + hstep, voffA);
        if (wr == 1) PG8_BAR;
        PG8_WAIT_V(4); PG8_BAR;
        PG8_STAGE(PG8_SB(1, 0), cB + kstep, voffB); PG8_STAGE(PG8_SA(1, 0), cA + kstep, voffA); PG8_STAGE(PG8_SB(1, 1), cB + hstep + kstep, voffB);
        PG8_WAIT_V(6); PG8_BAR;
    }
    for (;;) {
        const bool has_next = S.next(ui + 1, nxt);
        const char* nA = has_next ? (const char*)g.A + (size_t)nxt.pm * tstep : cA; const char* nB = has_next ? (const char*)g.Bt + (size_t)nxt.pn * tstep : cB;
        for (int t = 0; t < nt; t += 2) {
            const bool last = (t == nt - 2);
            const char* a1 = cA + (size_t)(t + 1) * kstep;
            const char* a2 = last ? nA : cA + (size_t)(t + 2) * kstep; const char* b2 = last ? nB : cB + (size_t)(t + 2) * kstep;
            const char* a3 = a2 + kstep; const char* b3 = b2 + kstep;
            if (last && has_next) S.a_ready(nxt);
            if constexpr (SP2) {
            PG8_LDB(B0, 0, 0); PG8_LDB(B1, 0, 1); PG8_SCHED; PG8_LDA(At, 0, 0); PG8_STAGE(PG8_SA(1, 1), a1 + hstep, voffA);
            PG8_WAIT_V(8); PG8_WAIT_L(0); PG8_BAR; PG8_MMA(0, 0, At, B0); PG8_MMA(0, 1, At, B1); PG8_BAR; PG8_SCHED;
            PG8_LDA(At, 0, 1); PG8_STAGE(PG8_SB(0, 0), b2, voffB); PG8_STAGE(PG8_SB(0, 1), b2 + hstep, voffB); PG8_STAGE(PG8_SA(0, 0), a2, voffA);
            PG8_WAIT_V(8); PG8_WAIT_L(0); PG8_BAR; PG8_MMA(1, 0, At, B0); PG8_MMA(1, 1, At, B1); PG8_BAR; PG8_SCHED;
            PG8_LDB(B0, 1, 0); PG8_LDB(B1, 1, 1); PG8_SCHED; PG8_LDA(At, 1, 0); PG8_STAGE(PG8_SA(0, 1), a2 + hstep, voffA);
            PG8_WAIT_V(8); PG8_WAIT_L(0); PG8_BAR; PG8_MMA(0, 0, At, B0); PG8_MMA(0, 1, At, B1); PG8_BAR; PG8_SCHED;
            PG8_LDA(At, 1, 1); PG8_STAGE(PG8_SB(1, 0), b3, voffB); PG8_STAGE(PG8_SB(1, 1), b3 + hstep, voffB); PG8_STAGE(PG8_SA(1, 0), a3, voffA);
            PG8_WAIT_V(8); PG8_WAIT_L(0); PG8_BAR; PG8_MMA(1, 0, At, B0); PG8_MMA(1, 1, At, B1); PG8_BAR; PG8_SCHED;
            } else {
            PG8_LDB(B0, 0, 0); PG8_SCHED; PG8_LDA(At, 0, 0); PG8_STAGE(PG8_SA(1, 1), a1 + hstep, voffA);
            PG8_WAIT_L(8); PG8_BAR; PG8_WAIT_L(0); PG8_MMA(0, 0, At, B0); PG8_BAR; PG8_SCHED;
            PG8_LDB(B1, 0, 1); PG8_STAGE(PG8_SB(0, 0), b2, voffB);
            PG8_BAR; PG8_WAIT_L(0); PG8_MMA(0, 1, At, B1); PG8_BAR;
            PG8_LDA(At, 0, 1); PG8_STAGE(PG8_SA(0, 0), a2, voffA);
            PG8_BAR; PG8_WAIT_L(0); PG8_MMA(1, 0, At, B0); PG8_BAR; PG8_SCHED;
            PG8_STAGE(PG8_SB(0, 1), b2 + hstep, voffB);
            PG8_WAIT_V(6); PG8_BAR; PG8_MMA(1, 1, At, B1); PG8_BAR;
            PG8_LDB(B0, 1, 0); PG8_SCHED; PG8_LDA(At, 1, 0); PG8_STAGE(PG8_SA(0, 1), a2 + hstep, voffA);
            PG8_WAIT_L(8); PG8_BAR; PG8_WAIT_L(0); PG8_MMA(0, 0, At, B0); PG8_BAR; PG8_SCHED;
            PG8_LDB(B1, 1, 1); PG8_STAGE(PG8_SB(1, 0), b3, voffB);
            PG8_BAR; PG8_WAIT_L(0); PG8_MMA(0, 1, At, B1); PG8_BAR;
            PG8_LDA(At, 1, 1); PG8_STAGE(PG8_SA(1, 0), a3, voffA);
            PG8_BAR; PG8_WAIT_L(0); PG8_MMA(1, 0, At, B0); PG8_BAR; PG8_SCHED;
            PG8_STAGE(PG8_SB(1, 1), b3 + hstep, voffB);
            PG8_WAIT_V(6); PG8_BAR; PG8_MMA(1, 1, At, B1); PG8_BAR;
            }
        }
        if constexpr (ALIGN_EPI) { if (wr == 0) PG8_BAR; }
        if constexpr (!Epi::AFTER_DRAIN) { E(acc, cur, wr, wc, fr, fq); S.done(cur); }
        if (!has_next) break;
#pragma unroll
        for (int a = 0; a < 2; ++a)
#pragma unroll
            for (int b = 0; b < 2; ++b)
#pragma unroll
                for (int m = 0; m < 4; ++m)
#pragma unroll
                    for (int n = 0; n < 2; ++n) acc[a][b][m][n] = (f32x4){0.f, 0.f, 0.f, 0.f};
        cur = nxt; cA = nA; cB = nB; ++ui;
        if constexpr (ALIGN_EPI) { if (wr == 1) PG8_BAR; }
    }
    PG8_WAIT_V(0);
    if constexpr (!ALIGN_EPI) { if (wr == 0) PG8_BAR; }
    PG8_BAR;
    if constexpr (Epi::AFTER_DRAIN) { E.fused(acc, cur, wr, wc, fr, fq, lds, wid, lane); S.done(cur); }
#undef PG8_SA
#undef PG8_SB
#undef PG8_STAGE
#undef PG8_LDA
#undef PG8_LDB
#undef PG8_MMA
#undef PG8_WAIT_V
#undef PG8_WAIT_L
#undef PG8_BAR
#undef PG8_SCHED
}
}

namespace pg8 {
struct EpiF32 {
    static constexpr bool PERM = false, AFTER_DRAIN = false;
    float* C; const float* bias; int ldc; int pad;
    __device__ __forceinline__ void operator()(const f32x4 (&acc)[2][2][4][2], const Unit& u, int wr, int wc, int fr, int fq) const {
        const int row0 = u.pm * BM + wr * 64 + fr, col0 = u.pn * BM + wc * 32 + 4 * fq;
        f32x4 bv[2][2];
#pragma unroll
        for (int bj = 0; bj < 2; ++bj)
#pragma unroll
            for (int n = 0; n < 2; ++n) bv[bj][n] = bias ? *(const f32x4*)(bias + col0 + bj * HALF + n * 16) : (f32x4){0.f, 0.f, 0.f, 0.f};
#pragma unroll
        for (int ai = 0; ai < 2; ++ai)
#pragma unroll
            for (int m = 0; m < 4; ++m) { float* rowp = C + (size_t)(row0 + ai * HALF + m * 16) * ldc + col0;
#pragma unroll
                for (int bj = 0; bj < 2; ++bj)
#pragma unroll
                    for (int n = 0; n < 2; ++n) *(f32x4*)(rowp + bj * HALF + n * 16) = acc[ai][bj][m][n] + bv[bj][n]; }
    }
};
struct EpiB16 {
    static constexpr bool PERM = true, AFTER_DRAIN = false;
    bf16_t* O; const float* bias; int ldc; int pad;
    __device__ __forceinline__ void operator()(const f32x4 (&acc)[2][2][4][2], const Unit& u, int wr, int wc, int fr, int fq) const {
        const int row0 = u.pm * BM + wr * 64 + fr, col0 = u.pn * BM + wc * 32 + 8 * fq;
        f32x4 bv[2][2];
#pragma unroll
        for (int bj = 0; bj < 2; ++bj)
#pragma unroll
            for (int n = 0; n < 2; ++n) bv[bj][n] = bias ? *(const f32x4*)(bias + col0 + bj * HALF + 4 * n) : (f32x4){0.f, 0.f, 0.f, 0.f};
#pragma unroll
        for (int ai = 0; ai < 2; ++ai)
#pragma unroll
            for (int m = 0; m < 4; ++m) { bf16_t* rowp = O + (size_t)(row0 + ai * HALF + m * 16) * ldc + col0;
#pragma unroll
                for (int bj = 0; bj < 2; ++bj) { const f32x4 v0 = acc[ai][bj][m][0] + bv[bj][0], v1 = acc[ai][bj][m][1] + bv[bj][1];
                    u32x4 w; w.x = cvt_pk_bf16(v0[0], v0[1]); w.y = cvt_pk_bf16(v0[2], v0[3]); w.z = cvt_pk_bf16(v1[0], v1[1]); w.w = cvt_pk_bf16(v1[2], v1[3]);
                    *(u32x4*)(rowp + bj * HALF) = w; } }
    }
};
struct EpiB16R {
    static constexpr bool PERM = true, AFTER_DRAIN = false;
    bf16_t* O; const float* bias; int ldc; int pad;
    __device__ __forceinline__ void operator()(const f32x4 (&acc)[2][2][4][2], const Unit& u, int wr, int wc, int fr, int fq) const {
        const int row0 = u.pm * BM + wr * 64 + fr, col0 = u.pn * BM + wc * 32 + 8 * fq;
        float bvr[2][4];
#pragma unroll
        for (int ai = 0; ai < 2; ++ai)
#pragma unroll
            for (int m = 0; m < 4; ++m) bvr[ai][m] = bias[row0 + ai * HALF + m * 16];
#pragma unroll
        for (int ai = 0; ai < 2; ++ai)
#pragma unroll
            for (int m = 0; m < 4; ++m) { const int row = row0 + ai * HALF + m * 16; bf16_t* rowp = O + (size_t)row * ldc + col0;
#pragma unroll
                for (int bj = 0; bj < 2; ++bj) { const f32x4 v0 = acc[ai][bj][m][0] + bvr[ai][m], v1 = acc[ai][bj][m][1] + bvr[ai][m];
                    u32x4 w; w.x = cvt_pk_bf16(v0[0], v0[1]); w.y = cvt_pk_bf16(v0[2], v0[3]); w.z = cvt_pk_bf16(v1[0], v1[1]); w.w = cvt_pk_bf16(v1[2], v1[3]);
                    *(u32x4*)(rowp + bj * HALF) = w; } }
    }
};
struct EpiRelu2 {
    static constexpr bool PERM = true, AFTER_DRAIN = false;
    bf16_t* O; int ldc; int pad;
    __device__ __forceinline__ void operator()(const f32x4 (&acc)[2][2][4][2], const Unit& u, int wr, int wc, int fr, int fq) const {
        const int row0 = u.pm * BM + wr * 64 + fr, col0 = u.pn * BM + wc * 32 + 8 * fq;
#pragma unroll
        for (int ai = 0; ai < 2; ++ai)
#pragma unroll
            for (int m = 0; m < 4; ++m) { bf16_t* rowp = O + (size_t)(row0 + ai * HALF + m * 16) * ldc + col0;
#pragma unroll
                for (int bj = 0; bj < 2; ++bj) { f32x4 v0 = acc[ai][bj][m][0], v1 = acc[ai][bj][m][1];
#pragma unroll
                    for (int e = 0; e < 4; ++e) { const float a = v0[e] > 0.f ? v0[e] : 0.f, b = v1[e] > 0.f ? v1[e] : 0.f; v0[e] = a * a; v1[e] = b * b; }
                    u32x4 w; w.x = cvt_pk_bf16(v0[0], v0[1]); w.y = cvt_pk_bf16(v0[2], v0[3]); w.z = cvt_pk_bf16(v1[0], v1[1]); w.w = cvt_pk_bf16(v1[2], v1[3]);
                    *(u32x4*)(rowp + bj * HALF) = w; } }
    }
};
struct EpiQKV {
    static constexpr bool PERM = true, AFTER_DRAIN = false;
    bf16_t* O; float* outk; float* outv; bf16_t* vtt; const float* rope; int ldc, dmodel, mc, pad;
    __device__ __forceinline__ void operator()(const f32x4 (&acc)[2][2][4][2], const Unit& u, int wr, int wc, int fr, int fq) const {
        const int row0 = u.pm * BM + wr * 64 + fr, col0 = u.pn * BM + wc * 32 + 8 * fq; const int sect = (u.pn * BM) / dmodel;
        const bool ctx = u.pm * BM < mc; const int fcol0 = col0 - sect * dmodel;
        if (sect < 2) {
            const int gi = wc >> 1, blk0 = 2 * (wc & 1), off = 8 * fq;
            const int ocol = u.pn * BM + gi * HALF + blk0 * 32 + off, ofc = ocol - sect * dmodel;
#pragma unroll
            for (int ai = 0; ai < 2; ++ai)
#pragma unroll
                for (int m = 0; m < 4; ++m) { const int row = row0 + ai * HALF + m * 16; bf16_t* rowp = O + (size_t)row * ldc + ocol;
                    f32x4 x0 = acc[ai][0][m][0], x1 = acc[ai][0][m][1], y0 = acc[ai][1][m][0], y1 = acc[ai][1][m][1];
                    if (!ctx) { const float* rt = rope + ((size_t)((row - mc) % DEC_SEQ) * 64 + (blk0 ? 32 : 0) + off) * 2;
                        const f32x4 t0 = *(const f32x4*)rt, t1 = *(const f32x4*)(rt + 4), t2 = *(const f32x4*)(rt + 8), t3 = *(const f32x4*)(rt + 12);
                        const float cs[8] = {t0[0], t0[2], t1[0], t1[2], t2[0], t2[2], t3[0], t3[2]}, sn[8] = {t0[1], t0[3], t1[1], t1[3], t2[1], t2[3], t3[1], t3[3]};
#pragma unroll
                        for (int e = 0; e < 4; ++e) { const float a0 = x0[e], b0 = y0[e], a1 = x1[e], b1 = y1[e];
                            x0[e] = a0 * cs[e] - b0 * sn[e]; y0[e] = b0 * cs[e] + a0 * sn[e]; x1[e] = a1 * cs[4 + e] - b1 * sn[4 + e]; y1[e] = b1 * cs[4 + e] + a1 * sn[4 + e]; } }
                    u32x4 w; w.x = cvt_pk_bf16(x0[0], x0[1]); w.y = cvt_pk_bf16(x0[2], x0[3]); w.z = cvt_pk_bf16(x1[0], x1[1]); w.w = cvt_pk_bf16(x1[2], x1[3]); *(u32x4*)rowp = w;
                    w.x = cvt_pk_bf16(y0[0], y0[1]); w.y = cvt_pk_bf16(y0[2], y0[3]); w.z = cvt_pk_bf16(y1[0], y1[1]); w.w = cvt_pk_bf16(y1[2], y1[3]); *(u32x4*)(rowp + 32) = w;
                    if (sect == 1 && ctx) { float* fp = outk + (size_t)row * dmodel + ofc; *(f32x4*)fp = x0; *(f32x4*)(fp + 4) = x1; *(f32x4*)(fp + 32) = y0; *(f32x4*)(fp + 36) = y1; } }
        } else {
#pragma unroll
            for (int ai = 0; ai < 2; ++ai)
#pragma unroll
                for (int m = 0; m < 4; ++m) { const int row = row0 + ai * HALF + m * 16;
                    const int b = ctx ? row / SEQ : (row - mc) / DEC_SEQ, key = ctx ? row % SEQ : PAST + (row - mc) % DEC_SEQ, T = ctx ? SEQ : TMAX, pos = 32 * (key >> 5) + kperm32(key & 31);
                    bf16_t* vb = vtt + (ctx ? (size_t)0 : VTT_C) + (size_t)b * NH * VD * T + pos;
#pragma unroll
                    for (int bj = 0; bj < 2; ++bj) { const f32x4 v0 = acc[ai][bj][m][0], v1 = acc[ai][bj][m][1]; const int vc = fcol0 + bj * HALF;
                        if (ctx) { float* fp = outv + (size_t)row * dmodel + vc; *(f32x4*)fp = v0; *(f32x4*)(fp + 4) = v1; }
                        const unsigned w0 = cvt_pk_bf16(v0[0], v0[1]), w1 = cvt_pk_bf16(v0[2], v0[3]), w2 = cvt_pk_bf16(v1[0], v1[1]), w3 = cvt_pk_bf16(v1[2], v1[3]);
                        bf16_t* vp = vb + (size_t)vc * T;
                        vp[0] = (bf16_t)w0; vp[(size_t)T] = (bf16_t)(w0 >> 16); vp[(size_t)2 * T] = (bf16_t)w1; vp[(size_t)3 * T] = (bf16_t)(w1 >> 16);
                        vp[(size_t)4 * T] = (bf16_t)w2; vp[(size_t)5 * T] = (bf16_t)(w2 >> 16); vp[(size_t)6 * T] = (bf16_t)w3; vp[(size_t)7 * T] = (bf16_t)(w3 >> 16); } }
        }
    }
};
struct EpiGLU {
    static constexpr bool PERM = true, AFTER_DRAIN = false;
    bf16_t* O; const float* bias; int ldc, dmodel;
    __device__ __forceinline__ void operator()(const f32x4 (&acc)[2][2][4][2], const Unit& u, int wr, int wc, int fr, int fq) const {
        const int row0 = u.pm * BM + wr * 64 + fr, j0 = u.pn * HALF + wc * 32 + 8 * fq;
        f32x4 ba[2], bg[2];
#pragma unroll
        for (int n = 0; n < 2; ++n) { ba[n] = *(const f32x4*)(bias + j0 + 4 * n); bg[n] = *(const f32x4*)(bias + dmodel + j0 + 4 * n); }
#pragma unroll
        for (int ai = 0; ai < 2; ++ai)
#pragma unroll
            for (int m = 0; m < 4; ++m) { bf16_t* rowp = O + (size_t)(row0 + ai * HALF + m * 16) * ldc + j0; f32x4 r[2];
#pragma unroll
                for (int n = 0; n < 2; ++n) { const f32x4 a = acc[ai][0][m][n] + ba[n], g = acc[ai][1][m][n] + bg[n];
#pragma unroll
                    for (int e = 0; e < 4; ++e) r[n][e] = a[e] / (1.0f + __expf(-g[e])); }
                u32x4 w; w.x = cvt_pk_bf16(r[0][0], r[0][1]); w.y = cvt_pk_bf16(r[0][2], r[0][3]); w.z = cvt_pk_bf16(r[1][0], r[1][1]); w.w = cvt_pk_bf16(r[1][2], r[1][3]);
                *(u32x4*)rowp = w; }
    }
};
}

#define LAS __attribute__((address_space(3)))
#define XB_TMO      128
#define XB_XCNT(j)  (256  + 64 * (j))
#define XB_XSUB(j)  (1280 + 64 * (j))
#define XB_XGEN(j)  (2304 + 64 * (j))
#define XB_TOP      3328
#define XB_TOPGEN   3392
#define XCD_BAR_WORDS 3456
#define XB_SPIN_CAP (1u << 18)

__device__ __forceinline__ unsigned xb_ld(unsigned* p)              { return __hip_atomic_load(p, __ATOMIC_RELAXED, __HIP_MEMORY_SCOPE_AGENT); }
__device__ __forceinline__ unsigned xb_add(unsigned* p, unsigned v) { return __hip_atomic_fetch_add(p, v, __ATOMIC_RELAXED, __HIP_MEMORY_SCOPE_AGENT); }
__device__ __forceinline__ unsigned xb_xcc_id() { return (unsigned)__builtin_amdgcn_s_getreg((3 << 11) | 20) & 0xFu; }
#define XB_SPIN(cond, bar) do { unsigned _sp = 0; while (cond) { __builtin_amdgcn_s_sleep(1); \
    if ((++_sp & 255u) == 0u) { if (xb_ld(&(bar)[XB_TMO])) break; if (_sp > XB_SPIN_CAP) { atomicAdd(&(bar)[XB_TMO], 1u); break; } } } } while (0)

struct XcdBarrier {
    unsigned* bar; unsigned x;
    volatile LAS unsigned* st;
};

__device__ __forceinline__ XcdBarrier xcd_barrier_post(unsigned* bar, volatile LAS unsigned* st) {
    XcdBarrier b; b.bar = bar; b.x = xb_xcc_id(); b.st = st;
    if (threadIdx.x == 0) (void)xb_add(&bar[XB_XCNT(b.x)], 1u);
    return b;
}
__device__ __forceinline__ void xcd_barrier_complete(unsigned* bar, unsigned x, unsigned& nloc, unsigned& nx) {
    const unsigned G = gridDim.x * gridDim.y * gridDim.z;
    unsigned sum, cnt, mine, sp = 0u;
    for (;;) {
        sum = 0u; cnt = 0u; mine = 0u;
#pragma unroll
        for (unsigned j = 0; j < 16; ++j) { const unsigned c = xb_ld(&bar[XB_XCNT(j)]); sum += c; cnt += (c > 0u) ? 1u : 0u; mine = (j == x) ? c : mine; }
        if (sum == G) break;
        __builtin_amdgcn_s_sleep(1);
        if ((++sp & 255u) == 0u) { if (xb_ld(&bar[XB_TMO])) break; if (sp > XB_SPIN_CAP) { atomicAdd(&bar[XB_TMO], 1u); break; } }
    }
    nloc = mine > 0u ? mine : 1u; nx = cnt > 0u ? cnt : 1u;
}

__device__ __forceinline__ void xcd_barrier(const XcdBarrier& b) {
    asm volatile("s_waitcnt vmcnt(0)" ::: "memory");
    __syncthreads();
    if (threadIdx.x == 0) {
        unsigned* bar = b.bar;
        __builtin_amdgcn_s_waitcnt(0);
        unsigned nloc = b.st[0], nx = b.st[1];
        if (nloc == 0u) { xcd_barrier_complete(bar, b.x, nloc, nx); b.st[0] = nloc; b.st[1] = nx; }
        const unsigned old = xb_add(&bar[XB_XSUB(b.x)], 1u);
        const unsigned gen = old / nloc;
        if (old + 1u == (gen + 1u) * nloc) {
            __builtin_amdgcn_fence(__ATOMIC_RELEASE, "agent");
            asm volatile("s_waitcnt vmcnt(0)" ::: "memory");
            const unsigned og = xb_add(&bar[XB_TOP], 1u);
            const unsigned tg = og / nx;
            if (og + 1u == (tg + 1u) * nx) xb_add(&bar[XB_TOPGEN], 1u);
            else XB_SPIN(xb_ld(&bar[XB_TOPGEN]) == tg, bar);
            __builtin_amdgcn_fence(__ATOMIC_ACQUIRE, "agent");
            xb_add(&bar[XB_XGEN(b.x)], 1u);
            asm volatile("s_waitcnt vmcnt(0)" ::: "memory");
        } else {
            XB_SPIN(xb_ld(&bar[XB_XGEN(b.x)]) == gen, bar);
            __builtin_amdgcn_fence(__ATOMIC_ACQUIRE, "agent");
            asm volatile("s_waitcnt vmcnt(0)" ::: "memory");
        }
    }
    __syncthreads();
}

struct Bump { unsigned char* base; size_t off; template <class T> T* take(size_t n) { T* r = (T*)(base + off); off += (n * sizeof(T) + 255) & ~(size_t)255; return r; } };
static size_t carve(P& p, unsigned char* ws) {
    Bump b{ws, 0};
    p.CTL = b.take<unsigned>(CTL_BYTES / 4);
    p.Wt_mlp_in = b.take<bf16>((size_t)DEPTH * D * DFF); p.Wt_mlp_out = b.take<bf16>((size_t)DEPTH * D * DFF); p.Wt_hy_in = b.take<bf16>((size_t)NHY * D * 3 * D); p.Wt_hy_out = b.take<bf16>((size_t)NHY * D * D);
    p.Wt_qkv = b.take<bf16>((size_t)D * 3 * D); p.Wt_wo = b.take<bf16>((size_t)D * D); p.Wt_glu = b.take<bf16>((size_t)D * 2 * D);
    p.X = b.take<float>((size_t)M * D); p.MOD = b.take<float>((size_t)DEPTH * NCND * 6 * D); p.SCOND = b.take<float>((size_t)NCND * D); p.O = b.take<float>((size_t)M * D);
    p.HRAW = b.take<float>((size_t)NHY * LMAX * 2 * D); p.H1 = b.take<float>((size_t)NHY * LMAX * FW); p.H2 = b.take<float>((size_t)NHY * LMAX * FW); p.KINV = b.take<float>((size_t)NHY * 2 * D);
    p.KT = b.take<bf16>((size_t)NHY * KT_LAYER); p.S5BB = b.take<bf16>(S5_BBT); p.S5CM = b.take<bf16>(S5_CMT); p.S5LB = b.take<float>((size_t)2 * SGS * SP * 2); p.MV = b.take<float>((size_t)DEPTH * 2 * NCND * 3 * D); p.PS = b.take<float>((size_t)NHY * F3_NCH * 2 * D); p.PM = b.take<float>((size_t)MOD_KS * DEPTH * NCND * 6 * D); p.Ob = (bf16*)p.O; p.ObA = p.Ob + (size_t)M * D; p.RS = b.take<float>((size_t)2 * M); p.RT = b.take<float>((size_t)DEC_SEQ * 2 * QD * 2 + 16);
    p.KC = b.take<bf16>((size_t)DEC_BATCH * NAT * PAST * NH * 2 * HDIM); p.VTT = b.take<bf16>(VTT_ALL);
    p.XB = b.take<bf16>((size_t)M * D);
    p.H = b.take<bf16>((size_t)M * D); p.Z = b.take<bf16>((size_t)M * 3 * D); p.Z0 = p.Z; p.ZT = p.Z + (size_t)M * D;
    const size_t hid_off = b.off; p.HID = b.take<bf16>((size_t)M * DFF); const size_t hid_end = b.off;
    Bump o{ws, hid_off}; p.YF = o.take<float>((size_t)M * D); p.YB = o.take<float>((size_t)M * D); p.X0C = p.YF; p.VV = p.YB;
    Bump o2{ws, hid_off}; p.YT = o2.take<bf16>((size_t)D * M); p.TS = o2.take<bf16>(TS_ALL); p.X0Cb = p.YT; p.VT = p.YT;
    size_t end = hid_end; if (o.off > end) end = o.off; if (o2.off > end) end = o2.off; return end;
}
static void set_inputs(P& p, void* const* in) {
    const float** f = (const float**)&p.x_prompt; for (int i = 0; i < 42; ++i) f[i] = (const float*)in[i];
}


constexpr int LDS_BYTES = 147456;
constexpr int LDS_CTL_OFF = 146944;
constexpr int WAVE_LDS_BYTES = 16384;
static_assert(ATT_LDS_FLOATS * 4 <= WAVE_LDS_BYTES && 64 * 33 * 4 <= WAVE_LDS_BYTES, "per-wave scratch");

__device__ __forceinline__ void wtrans_items(const float* W, int K, int N, bf16* WT, float*, int gw, int nw, int lane, int mode = 0) {
    const int nblk = N / 64, nitems = (K / 64) * nblk, nq = lane & 15, kb = lane >> 4;
    for (int item = gw; item < nitems; item += nw) {
        const int kt = item / nblk, nb = item % nblk, k0 = 64 * kt + 16 * kb, n0 = 64 * nb; int r0 = n0; if (mode == 1) { const int Dm = N / 2, half = n0 / Dm, j = n0 % Dm; r0 = 256 * (j / 128) + 128 * half + (j % 128); }
        float4 v[16]; const float* src = W + (size_t)k0 * N + n0 + 4 * nq;
#pragma unroll
        for (int i = 0; i < 16; ++i) v[i] = *(const float4*)(src + (size_t)i * N);
        int rl = r0 + 4 * nq;
        if (mode == 2) { const int n = n0 + 4 * nq;
            if (n < 2 * (N / 3)) { const int r = n % 256, gi = r / 128, blk = (r % 128) / 32, off = r % 32; rl = (n - r) + (blk & 1) * 128 + gi * 64 + (blk >> 1) * 32 + off; } }
        bf16* dst = WT + (size_t)rl * K + k0;
#pragma unroll
        for (int e = 0; e < 4; ++e) {
#pragma unroll
            for (int hf = 0; hf < 2; ++hf) { uint4 o; const int b8 = 8 * hf;
#define WT_EL(i) (e == 0 ? v[i].x : e == 1 ? v[i].y : e == 2 ? v[i].z : v[i].w)
                o.x = f2bf(WT_EL(b8 + 0)) | ((unsigned)f2bf(WT_EL(b8 + 1)) << 16); o.y = f2bf(WT_EL(b8 + 2)) | ((unsigned)f2bf(WT_EL(b8 + 3)) << 16);
                o.z = f2bf(WT_EL(b8 + 4)) | ((unsigned)f2bf(WT_EL(b8 + 5)) << 16); o.w = f2bf(WT_EL(b8 + 6)) | ((unsigned)f2bf(WT_EL(b8 + 7)) << 16);
#undef WT_EL
                *(uint4*)(dst + (size_t)e * K + b8) = o; } }
    }
}

struct Args { P p; int ph_lo, ph_hi, li, pad; };

__global__ void __launch_bounds__(512, 2) fwd(Args args) {
    extern __shared__ __attribute__((aligned(16))) unsigned char lds[];
    const P& p = args.p;
    const int tid = threadIdx.x, lane = tid & 63, wave = __builtin_amdgcn_readfirstlane(tid >> 6), G = gridDim.x;
    volatile LAS unsigned* lctl = (volatile LAS unsigned*)((LAS unsigned char*)lds + LDS_CTL_OFF);
    if (tid < 64) lctl[tid] = 0u;
    __syncthreads();
    XcdBarrier bar = xcd_barrier_post(p.CTL + args.li * 4096, lctl + 8);
    float* wscr = (float*)(lds + wave * WAVE_LDS_BYTES);
    const int gw = blockIdx.x * 8 + wave, nw = G * 8;
    const int lo = args.ph_lo, hi = args.ph_hi;
    int ph = 0;
#define PH_BEGIN if (lo <= ph && ph < hi) {
#define PH_END   if (ph + 1 < hi) xcd_barrier(bar); } ++ph;
#define ELEM(F, a0, a1, n) do { for (size_t i = (size_t)blockIdx.x * 512 + tid; i < (size_t)(n); i += (size_t)G * 512) F::run(p, a0, a1, i); } while (0)
#define WAVE(F, a0, a1) do { for (int it = gw; it < F::NITEMS; it += nw) F::run(p, a0, a1, it, wscr); } while (0)
#define BLOCK(F, a0, a1) do { for (int it = blockIdx.x; it < F::NITEMS; it += G) F::run(p, a0, a1, it, (float*)lds); } while (0)
#define BLOCK1(F, a0) F::run(p, a0, G, (int)blockIdx.x, (float*)lds)
#define WTR(W, K, N, WT) wtrans_items(W, K, N, WT, wscr, gw, nw, lane)
#define WTRM(W, K, N, WT, mode) wtrans_items(W, K, N, WT, wscr, gw, nw, lane, mode)
#define GEMM_RUNM(EPI, A, Bt, MM, N, K, ...) do { pg8::Gemm g{A, Bt, MM, N, K, 0}; pg8::StaticOrder S; S.init(MM, N, G, (int)blockIdx.x); pg8::EPI E{__VA_ARGS__}; \
        pg8::gemm_phase<pg8::EPI, pg8::StaticOrder, true, true>((PG8_LAS unsigned char*)lds, g, S, E); } while (0)
#define GEMM_RUN(EPI, A, Bt, N, K, ...) do { pg8::Gemm g{A, Bt, M, N, K, 0}; pg8::StaticOrder S; S.init(M, N, G, (int)blockIdx.x); pg8::EPI E{__VA_ARGS__}; \
        pg8::gemm_phase<pg8::EPI, pg8::StaticOrder, true, true>((PG8_LAS unsigned char*)lds, g, S, E); } while (0)
#define GEMM_B16(A, Bt, N, K, C, ldc, bias) GEMM_RUN(EpiB16, A, Bt, N, K, C, bias, ldc, 0)
#define GEMM_RELU2(A, Bt, N, K, C, ldc) GEMM_RUN(EpiRelu2, A, Bt, N, K, C, ldc, 0)
#define GEMM_QKV(A, Bt, C) GEMM_RUN(EpiQKV, A, Bt, 3 * D, D, C, p.out + OUT_K, p.out + OUT_V, p.VTT, p.RT, 3 * D, D, MC, 0)
#define GEMM_GLU(A, Bt, C, bias) GEMM_RUN(EpiGLU, A, Bt, 2 * D, D, C, bias, D, D)

    PH_BEGIN
        { float* sc = (float*)lds;
          for (int i = tid; i < NCND * D; i += 512) { const int r = i / D, k = i % D; sc[i] = silu_f(r == 0 ? p.c_ctx[k] : p.c[(size_t)(r - 1) * D + k]); }
          __syncthreads();
          for (size_t i = (size_t)blockIdx.x * 512 + tid; i < (size_t)DEPTH * MOD_KS * 6 * D / 4; i += (size_t)G * 512) E_modp::body(p, sc, i);
          __syncthreads(); }
        ELEM(E_ropetab, 0, 0, (size_t)DEC_SEQ * 2 * QD); ELEM(E_kcvt8, 0, 0, (size_t)DEC_BATCH * NAT * PAST * NH * 2 * HDIM / 8); WAVE(W_vtransc, 0, 0); ELEM(E_s5tab, 0, 0, (size_t)2 * SGS * SP); ELEM(E_filt1, 0, 0, (size_t)NHY * LMAX * FW);
#pragma unroll 1
        for (int l = 0; l < DEPTH; ++l) { WTR(p.w_mlp_in + (size_t)l * D * DFF, D, DFF, p.Wt_mlp_in + (size_t)l * D * DFF); WTR(p.w_mlp_out + (size_t)l * D * DFF, DFF, D, p.Wt_mlp_out + (size_t)l * D * DFF); }
#pragma unroll 1
        for (int j = 0; j < NHY; ++j) { WTR(p.hy_w_in + (size_t)j * D * 3 * D, D, 3 * D, p.Wt_hy_in + (size_t)j * D * 3 * D); WTR(p.hy_w_out + (size_t)j * D * D, D, D, p.Wt_hy_out + (size_t)j * D * D); }
        WTRM(p.at_w_qkv, D, 3 * D, p.Wt_qkv, 2); WTR(p.at_w_o, D, D, p.Wt_wo); WTRM(p.s5_w_glu, D, 2 * D, p.Wt_glu, 1);
    PH_END
    PH_BEGIN ELEM(E_modvec2, 0, 0, (size_t)DEPTH * 2 * NCND * 3 * D); ELEM(E_filt2, 0, 0, (size_t)NHY * LMAX * FW); PH_END
    PH_BEGIN ELEM(E_filt3c, 0, 0, (size_t)NHY * F3_NCH * 2 * D); WAVE(W_thin2, -1, 0 * 8 + 0); PH_END
    PH_BEGIN ELEM(E_fk2, 0, 0, (size_t)NHY * (FK_NC0 + FK_NC1) * D); GEMM_B16(p.H, p.Wt_hy_in + (size_t)0 * D * 3 * D, D, D, p.Z0, D, p.hy_b_in + (size_t)0 * 3 * D); __syncthreads();
        GEMM_RUNM(EpiB16R, p.Wt_hy_in + (size_t)0 * D * 3 * D + (size_t)D * D, p.H, 2 * D, M, D, p.ZT, p.hy_b_in + (size_t)0 * 3 * D + D, M, 0); PH_END
    PH_BEGIN BLOCK1(B_conv, 0); PH_END
    PH_BEGIN WAVE(W_hconv3y, 0, 0); PH_END
    PH_BEGIN GEMM_B16(p.H, p.Wt_hy_out + (size_t)0 * D * D, D, D, p.ObA, D, p.hy_b_out + (size_t)0 * D); PH_END
    PH_BEGIN WAVE(W_thin2, (0 * 8 + 0) | TH_MODE_A | TH_SRC_IN, 0 * 8 + 1); PH_END
    PH_BEGIN GEMM_RUNM(EpiRelu2, p.H + (size_t)0 * (M / 2) * D, p.Wt_mlp_in + (size_t)0 * D * DFF, M / 2, DFF, D, p.HID + (size_t)0 * (M / 2) * DFF, DFF, 0); PH_END
    PH_BEGIN GEMM_RUNM(EpiB16, p.HID + (size_t)0 * (M / 2) * DFF, p.Wt_mlp_out + (size_t)0 * D * DFF, M / 2, D, DFF, p.Ob + (size_t)0 * (M / 2) * D, nullptr, D, 0); __syncthreads();
        GEMM_RUNM(EpiRelu2, p.H + (size_t)1 * (M / 2) * D, p.Wt_mlp_in + (size_t)0 * D * DFF, M / 2, DFF, D, p.HID + (size_t)1 * (M / 2) * DFF, DFF, 0); PH_END
    PH_BEGIN GEMM_RUNM(EpiB16, p.HID + (size_t)1 * (M / 2) * DFF, p.Wt_mlp_out + (size_t)0 * D * DFF, M / 2, D, DFF, p.Ob + (size_t)1 * (M / 2) * D, nullptr, D, 0); PH_END
    PH_BEGIN WAVE(W_thin2, (0 * 8 + 1) | TH_MODE_B | TH_SRC_IN, 1 * 8 + 0); PH_END
    PH_BEGIN GEMM_QKV(p.H, p.Wt_qkv, p.Z); PH_END
    PH_BEGIN BLOCK(B_attn, 0, 0); PH_END
    PH_BEGIN GEMM_B16(p.H, p.Wt_wo, D, D, p.ObA, D, nullptr); PH_END
    PH_BEGIN WAVE(W_thin2, (1 * 8 + 0) | TH_MODE_A, 1 * 8 + 1); PH_END
    PH_BEGIN GEMM_RUNM(EpiRelu2, p.H + (size_t)0 * (M / 2) * D, p.Wt_mlp_in + (size_t)1 * D * DFF, M / 2, DFF, D, p.HID + (size_t)0 * (M / 2) * DFF, DFF, 0); PH_END
    PH_BEGIN GEMM_RUNM(EpiB16, p.HID + (size_t)0 * (M / 2) * DFF, p.Wt_mlp_out + (size_t)1 * D * DFF, M / 2, D, DFF, p.Ob + (size_t)0 * (M / 2) * D, nullptr, D, 0); __syncthreads();
        GEMM_RUNM(EpiRelu2, p.H + (size_t)1 * (M / 2) * D, p.Wt_mlp_in + (size_t)1 * D * DFF, M / 2, DFF, D, p.HID + (size_t)1 * (M / 2) * DFF, DFF, 0); PH_END
    PH_BEGIN GEMM_RUNM(EpiB16, p.HID + (size_t)1 * (M / 2) * DFF, p.Wt_mlp_out + (size_t)1 * D * DFF, M / 2, D, DFF, p.Ob + (size_t)1 * (M / 2) * D, nullptr, D, 0); PH_END
    PH_BEGIN WAVE(W_thin2, (1 * 8 + 1) | TH_MODE_B, 2 * 8 + 0); PH_END
    PH_BEGIN WAVE(W_s5f, 0, 0); PH_END
    PH_BEGIN GEMM_GLU(p.H, p.Wt_glu, p.ObA, p.s5_b_glu); PH_END
    PH_BEGIN WAVE(W_thin2, (2 * 8 + 0) | TH_MODE_A, 2 * 8 + 1); PH_END
    PH_BEGIN GEMM_RUNM(EpiRelu2, p.H + (size_t)0 * (M / 2) * D, p.Wt_mlp_in + (size_t)2 * D * DFF, M / 2, DFF, D, p.HID + (size_t)0 * (M / 2) * DFF, DFF, 0); PH_END
    PH_BEGIN GEMM_RUNM(EpiB16, p.HID + (size_t)0 * (M / 2) * DFF, p.Wt_mlp_out + (size_t)2 * D * DFF, M / 2, D, DFF, p.Ob + (size_t)0 * (M / 2) * D, nullptr, D, 0); __syncthreads();
        GEMM_RUNM(EpiRelu2, p.H + (size_t)1 * (M / 2) * D, p.Wt_mlp_in + (size_t)2 * D * DFF, M / 2, DFF, D, p.HID + (size_t)1 * (M / 2) * DFF, DFF, 0); PH_END
    PH_BEGIN GEMM_RUNM(EpiB16, p.HID + (size_t)1 * (M / 2) * DFF, p.Wt_mlp_out + (size_t)2 * D * DFF, M / 2, D, DFF, p.Ob + (size_t)1 * (M / 2) * D, nullptr, D, 0); PH_END
    PH_BEGIN WAVE(W_thin2, (2 * 8 + 1) | TH_MODE_B, 3 * 8 + 0); PH_END
    PH_BEGIN GEMM_B16(p.H, p.Wt_hy_in + (size_t)1 * D * 3 * D, D, D, p.Z0, D, p.hy_b_in + (size_t)1 * 3 * D); __syncthreads();
        GEMM_RUNM(EpiB16R, p.Wt_hy_in + (size_t)1 * D * 3 * D + (size_t)D * D, p.H, 2 * D, M, D, p.ZT, p.hy_b_in + (size_t)1 * 3 * D + D, M, 0); PH_END
    PH_BEGIN BLOCK1(B_conv, 1); PH_END
    PH_BEGIN WAVE(W_hconv3y, 1, 0); PH_END
    PH_BEGIN GEMM_B16(p.H, p.Wt_hy_out + (size_t)1 * D * D, D, D, p.ObA, D, p.hy_b_out + (size_t)1 * D); PH_END
    PH_BEGIN WAVE(W_thin2, (3 * 8 + 0) | TH_MODE_A, 3 * 8 + 1); PH_END
    PH_BEGIN GEMM_RUNM(EpiRelu2, p.H + (size_t)0 * (M / 2) * D, p.Wt_mlp_in + (size_t)3 * D * DFF, M / 2, DFF, D, p.HID + (size_t)0 * (M / 2) * DFF, DFF, 0); PH_END
    PH_BEGIN GEMM_RUNM(EpiB16, p.HID + (size_t)0 * (M / 2) * DFF, p.Wt_mlp_out + (size_t)3 * D * DFF, M / 2, D, DFF, p.Ob + (size_t)0 * (M / 2) * D, nullptr, D, 0); __syncthreads();
        GEMM_RUNM(EpiRelu2, p.H + (size_t)1 * (M / 2) * D, p.Wt_mlp_in + (size_t)3 * D * DFF, M / 2, DFF, D, p.HID + (size_t)1 * (M / 2) * DFF, DFF, 0); PH_END
    PH_BEGIN GEMM_RUNM(EpiB16, p.HID + (size_t)1 * (M / 2) * DFF, p.Wt_mlp_out + (size_t)3 * D * DFF, M / 2, D, DFF, p.Ob + (size_t)1 * (M / 2) * D, nullptr, D, 0); PH_END
    PH_BEGIN WAVE(W_thin2, (3 * 8 + 1) | TH_MODE_B, -1); PH_END
}

extern "C" void kernel_launch(void* const* d_in, const int* in_sizes, int n_in, void* d_out, int out_size, void* d_ws, size_t ws_size, hipStream_t stream) {
    static int grid = 0;
    Args a{}; set_inputs(a.p, d_in); a.p.out = (float*)d_out;
    const size_t need = carve(a.p, (unsigned char*)d_ws);
    if (grid == 0) {
        if (n_in != 42 || (size_t)out_size != OUT_END || need > ws_size) { fprintf(stderr, "kernel_launch: unexpected sizes: n_in %d out %d ws %zu (need %zu)\n", n_in, out_size, ws_size, need); grid = -1; return; }
        int dev = 0, cus = 0, per_cu = 0;
        if (hipGetDevice(&dev) != hipSuccess || hipDeviceGetAttribute(&cus, hipDeviceAttributeMultiprocessorCount, dev) != hipSuccess) { grid = -1; return; }
        if (hipFuncSetAttribute((const void*)fwd, hipFuncAttributeMaxDynamicSharedMemorySize, LDS_BYTES) != hipSuccess) { fprintf(stderr, "kernel_launch: hipFuncSetAttribute failed\n"); grid = -1; return; }
        if (hipOccupancyMaxActiveBlocksPerMultiprocessor(&per_cu, (const void*)fwd, 512, LDS_BYTES) != hipSuccess || per_cu < 1) fprintf(stderr, "kernel_launch: occupancy query reports %d workgroups per CU\n", per_cu);
        (void)hipGetLastError();
        grid = cus;
    }
    if (grid < 0) return;
    if (hipMemsetAsync(a.p.CTL, 0, CTL_BYTES, stream) != hipSuccess) return;
    a.ph_lo = 0; a.ph_hi = 36; a.li = 0; a.pad = 0;
    hipLaunchKernelGGL(fwd, dim3(grid), dim3(512), LDS_BYTES, stream, a);
}
#endif
```
